# Optimizing an MI355X kernel written in HIP

```python
import math
import jax, jax.numpy as jnp
from jax import lax
import numpy as np

D_MODEL = 1024
BATCH = 8
SEQ = 4096
DEPTH = 1

D_MIX = D_MODEL
D_SSM = D_MIX // 2
SSM_GROUP = 16
N_SSM_GROUPS = D_SSM // SSM_GROUP
SSM_STATE = 64
D_ATTN = D_MIX - D_SSM
HEAD_DIM = 64
N_HEADS = D_ATTN // HEAD_DIM
N_KV_HEADS = 2
KV_REP = N_HEADS // N_KV_HEADS
D_KV = N_KV_HEADS * HEAD_DIM
D_IN = D_SSM + D_ATTN + 2 * D_KV
WINDOW = 128
BLOCK = WINDOW
ROPE_THETA = 500000.0
ROPE_DIM = HEAD_DIM // 4
D_FF = ((8 * D_MODEL // 3 + 255) // 256) * 256
RES_HALF = 0.5
EPS = 1e-6
NEG_INF = -1e30
DT_MIN = 1e-3
DT_MAX = 1e-1

kernel_name = "hymba_s5_swa_sink_macaron"

F32 = jnp.float32


def rms_norm(x, g):
    xf = x.astype(F32)
    y = xf * lax.rsqrt(jnp.mean(xf * xf, axis=-1, keepdims=True) + EPS)
    return (y * g.astype(F32)).astype(x.dtype)


def swiglu(h, w_gate, w_up, w_down):
    return (jax.nn.silu(h @ w_gate) * (h @ w_up)) @ w_down


def rope_tables(L):
    half = ROPE_DIM // 2
    inv_freq = ROPE_THETA ** (-jnp.arange(half, dtype=F32) * 2.0 / ROPE_DIM)
    ang = jnp.arange(L, dtype=F32)[:, None] * inv_freq[None, :]
    return jnp.cos(ang), jnp.sin(ang)


def partial_rope(t, cos, sin):
    half = ROPE_DIM // 2
    c = cos[None, :, None, :]
    s = sin[None, :, None, :]
    t1 = t[..., :half].astype(F32)
    t2 = t[..., half:ROPE_DIM].astype(F32)
    rot = jnp.concatenate([t1 * c - t2 * s, t2 * c + t1 * s], axis=-1).astype(t.dtype)
    return jnp.concatenate([rot, t[..., ROPE_DIM:]], axis=-1)


def s5_mixer(u, A_re, A_im, log_dt, B_re, B_im, C_re, C_im, D, w_glu, b_glu):
    Bsz, L, _ = u.shape
    uf = u.astype(F32).reshape(Bsz, L, N_SSM_GROUPS, SSM_GROUP)
    lam = lax.complex(A_re.astype(F32), A_im.astype(F32))
    dt = jnp.exp(log_dt.astype(F32))[:, None]
    lam_bar = jnp.exp(lam * dt)
    zoh = (lam_bar - 1.0) / lam
    B_bar = zoh[..., None] * lax.complex(B_re.astype(F32), B_im.astype(F32))
    bu = lax.complex(jnp.einsum('blgc,gpc->blgp', uf, B_bar.real),
                     jnp.einsum('blgc,gpc->blgp', uf, B_bar.imag))
    a = jnp.broadcast_to(lam_bar, (1, L) + lam_bar.shape)

    def combine(left, right):
        a_l, b_l = left
        a_r, b_r = right
        return a_l * a_r, a_r * b_l + b_r

    _, states = lax.associative_scan(combine, (a, bu), axis=1)
    y = (jnp.einsum('blgp,gcp->blgc', states.real, C_re.astype(F32))
         - jnp.einsum('blgp,gcp->blgc', states.imag, C_im.astype(F32)))
    y = y + D.astype(F32).reshape(N_SSM_GROUPS, SSM_GROUP) * uf
    y = jax.nn.gelu(y.reshape(Bsz, L, D_SSM))
    y = y * jax.nn.sigmoid(y @ w_glu.astype(F32) + b_glu.astype(F32))
    return y.astype(u.dtype)


def swa_sink_attention(q, k, v, sinks):
    Bsz, L = q.shape[:2]
    nb = L // BLOCK
    qb = q.reshape(Bsz, nb, BLOCK, N_KV_HEADS, KV_REP, HEAD_DIM)

    def band(t):
        tb = t.reshape(Bsz, nb, BLOCK, N_KV_HEADS, HEAD_DIM)
        prev = jnp.pad(tb[:, :-1], ((0, 0), (1, 0), (0, 0), (0, 0), (0, 0)))
        return jnp.concatenate([prev, tb], axis=2)

    kw, vw = band(k), band(v)
    scale = 1.0 / math.sqrt(HEAD_DIM)
    scores = jnp.einsum('bnqkrd,bnskd->bnkrqs', qb, kw).astype(F32) * scale
    qi = jnp.arange(BLOCK)[:, None]
    sj = jnp.arange(2 * BLOCK)[None, :]
    diff = qi + BLOCK - sj
    in_band = (diff >= 0) & (diff < WINDOW)
    blk = jnp.arange(nb)[:, None, None]
    k_valid = (blk * BLOCK - BLOCK + sj[None]) >= 0
    mask = in_band[None] & k_valid
    scores = jnp.where(mask[None, :, None, None], scores, NEG_INF)
    sink = sinks.astype(F32).reshape(N_KV_HEADS, KV_REP)[None, None, :, :, None, None]
    sink = jnp.broadcast_to(sink, scores.shape[:-1] + (1,))
    probs = jax.nn.softmax(jnp.concatenate([scores, sink], axis=-1), axis=-1)[..., :-1]
    out = jnp.einsum('bnkrqs,bnskd->bnqkrd', probs.astype(v.dtype), vw)
    return out.reshape(Bsz, L, N_HEADS * HEAD_DIM)


def setup_inputs(seed: int = 0) -> dict:
    key = jax.random.key(seed)
    ks = jax.random.split(key, 32)
    nrm = lambda k, shape, s: jax.random.normal(k, shape, F32) * s
    gain = lambda k, n: 1.0 + 0.02 * jax.random.normal(k, (DEPTH, n), F32)
    P, G, C = SSM_STATE, N_SSM_GROUPS, SSM_GROUP
    a_im = math.pi * jnp.broadcast_to(jnp.arange(P, dtype=F32), (DEPTH, G, P))
    return {
        "x": jax.random.normal(ks[0], (BATCH, SEQ, D_MODEL), F32),
        "ffn1_norm": gain(ks[1], D_MODEL),
        "ffn1_w_gate": nrm(ks[2], (DEPTH, D_MODEL, D_FF), D_MODEL ** -0.5),
        "ffn1_w_up": nrm(ks[3], (DEPTH, D_MODEL, D_FF), D_MODEL ** -0.5),
        "ffn1_w_down": nrm(ks[4], (DEPTH, D_FF, D_MODEL), D_FF ** -0.5),
        "mix_norm": gain(ks[5], D_MODEL),
        "w_in": nrm(ks[6], (DEPTH, D_MODEL, D_IN), D_MODEL ** -0.5),
        "ssm_A_re": -0.5 + 0.01 * jax.random.normal(ks[7], (DEPTH, G, P), F32),
        "ssm_A_im": a_im + 0.01 * jax.random.normal(ks[8], (DEPTH, G, P), F32),
        "ssm_log_dt": jax.random.uniform(ks[9], (DEPTH, G), F32, math.log(DT_MIN), math.log(DT_MAX)),
        "ssm_B_re": nrm(ks[10], (DEPTH, G, P, C), (2 * C) ** -0.5),
        "ssm_B_im": nrm(ks[11], (DEPTH, G, P, C), (2 * C) ** -0.5),
        "ssm_C_re": nrm(ks[12], (DEPTH, G, C, P), (2 * P) ** -0.5),
        "ssm_C_im": nrm(ks[13], (DEPTH, G, C, P), (2 * P) ** -0.5),
        "ssm_D": nrm(ks[14], (DEPTH, D_SSM), 1.0),
        "ssm_w_glu": nrm(ks[15], (DEPTH, D_SSM, D_SSM), D_SSM ** -0.5),
        "ssm_b_glu": nrm(ks[16], (DEPTH, D_SSM), 0.01),
        "attn_sinks": nrm(ks[17], (DEPTH, N_HEADS), 1.0),
        "ssm_out_norm": gain(ks[18], D_SSM),
        "attn_out_norm": gain(ks[19], D_ATTN),
        "w_out": nrm(ks[20], (DEPTH, D_MIX, D_MODEL), D_MIX ** -0.5),
        "ffn2_norm": gain(ks[21], D_MODEL),
        "ffn2_w_gate": nrm(ks[22], (DEPTH, D_MODEL, D_FF), D_MODEL ** -0.5),
        "ffn2_w_up": nrm(ks[23], (DEPTH, D_MODEL, D_FF), D_MODEL ** -0.5),
        "ffn2_w_down": nrm(ks[24], (DEPTH, D_FF, D_MODEL), D_FF ** -0.5),
        "final_norm": 1.0 + 0.02 * jax.random.normal(ks[25], (D_MODEL,), F32),
    }


def reference(x, ffn1_norm, ffn1_w_gate, ffn1_w_up, ffn1_w_down, mix_norm, w_in,
              ssm_A_re, ssm_A_im, ssm_log_dt, ssm_B_re, ssm_B_im, ssm_C_re, ssm_C_im,
              ssm_D, ssm_w_glu, ssm_b_glu, attn_sinks, ssm_out_norm, attn_out_norm,
              w_out, ffn2_norm, ffn2_w_gate, ffn2_w_up, ffn2_w_down, final_norm):
    Bsz, L, _ = x.shape
    cos, sin = rope_tables(L)
    for l in range(DEPTH):
        h = rms_norm(x, ffn1_norm[l])
        x = x + RES_HALF * swiglu(h, ffn1_w_gate[l], ffn1_w_up[l], ffn1_w_down[l])
        h = rms_norm(x, mix_norm[l])
        proj = h @ w_in[l]
        u, q, k, v = jnp.split(proj, [D_SSM, D_SSM + D_ATTN, D_SSM + D_ATTN + D_KV], axis=-1)
        q = partial_rope(q.reshape(Bsz, L, N_HEADS, HEAD_DIM), cos, sin)
        k = partial_rope(k.reshape(Bsz, L, N_KV_HEADS, HEAD_DIM), cos, sin)
        v = v.reshape(Bsz, L, N_KV_HEADS, HEAD_DIM)
        y_ssm = s5_mixer(u, ssm_A_re[l], ssm_A_im[l], ssm_log_dt[l], ssm_B_re[l], ssm_B_im[l],
                         ssm_C_re[l], ssm_C_im[l], ssm_D[l], ssm_w_glu[l], ssm_b_glu[l])
        y_attn = swa_sink_attention(q, k, v, attn_sinks[l])
        y = jnp.concatenate([rms_norm(y_ssm, ssm_out_norm[l]),
                             rms_norm(y_attn, attn_out_norm[l])], axis=-1)
        x = x + y @ w_out[l]
        h = rms_norm(x, ffn2_norm[l])
        x = x + RES_HALF * swiglu(h, ffn2_w_gate[l], ffn2_w_up[l], ffn2_w_down[l])
    return rms_norm(x, final_norm)
```

```cpp
#include <hip/hip_runtime.h>
#include <hip/hip_cooperative_groups.h>
#include <cstdio>
#include <cstdint>
namespace cg = cooperative_groups;

#define LAS __attribute__((address_space(3)))
#define GAS __attribute__((address_space(1)))
typedef unsigned short bf16_t;
typedef short bf16x8 __attribute__((ext_vector_type(8)));
typedef float f32x4 __attribute__((ext_vector_type(4)));
typedef float f32x2 __attribute__((ext_vector_type(2)));
typedef unsigned u32x4 __attribute__((ext_vector_type(4)));
typedef unsigned u32x2 __attribute__((ext_vector_type(2)));

constexpr int BATCH = 8, SEQ = 4096, M_TOK = BATCH * SEQ, DM = 1024, DFF = 2816, DIN = 1280, DSSM = 512;
constexpr int NG = 32, NP = 64, NCH = 16;
constexpr int TCH = 32, NCK = SEQ / TCH, NBN = BATCH * NCK;
constexpr int K1 = TCH * NCH;
constexpr int KY = K1 + 2 * NP;
constexpr int PWN = TCH + 1;
constexpr float EPS = 1e-6f;
constexpr int NTHREADS = 512, NWAVES = 8;
constexpr int LDS_BYTES = 147456;
constexpr int RED_OFF = 131072;
constexpr size_t SSQ_STRIDE = 4 * (size_t)32768;

constexpr size_t MiB = 1024 * 1024;
constexpr size_t WS_XB = 0;
constexpr size_t WS_ACT = 64 * MiB;
constexpr size_t WS_APP = WS_ACT;
constexpr size_t WS_QKV = WS_ACT + 40 * MiB;
constexpr size_t WS_YGELU = WS_ACT + 88 * MiB;
constexpr size_t WS_SLOC = WS_ACT + 120 * MiB;
constexpr size_t WS_YCAT = 240 * MiB;
constexpr size_t WS_WGU1 = 304 * MiB, WS_WD1 = 315 * MiB, WS_WGU2 = 321 * MiB, WS_WD2 = 332 * MiB;
constexpr size_t WS_WIN = 338 * MiB, WS_WOUT = 341 * MiB, WS_WGLU = 343 * MiB;
constexpr size_t WS_BTY = 344 * MiB;
constexpr size_t WS_BTS1 = 364 * MiB;
constexpr size_t WS_PW = 372 * MiB;
constexpr size_t WS_BBAR = 373 * MiB;
constexpr size_t WS_KTAB = 374 * MiB;
constexpr size_t WS_SSQ = 380 * MiB;
constexpr size_t WS_ROPE = 377 * MiB;
constexpr size_t WS_BAR = 378 * MiB;
constexpr size_t WS_END = 384 * MiB;


typedef __bf16 bf16x2_t __attribute__((ext_vector_type(2)));
__device__ __forceinline__ unsigned cvt_pk_bf16(float lo, float hi) { const f32x2 v = {lo, hi}; return __builtin_bit_cast(unsigned, __builtin_convertvector(v, bf16x2_t)); }
__device__ __forceinline__ float bf_lo(unsigned w) { return __uint_as_float(w << 16); }
__device__ __forceinline__ float bf_hi(unsigned w) { return __uint_as_float(w & 0xffff0000u); }
__device__ __forceinline__ float bf2f(bf16_t b) { return __uint_as_float(((unsigned)b) << 16); }
__device__ __forceinline__ bf16_t f2bf(float f) { return (bf16_t)(cvt_pk_bf16(f, 0.f) & 0xffffu); }
__device__ __forceinline__ float gelu_tanh(float v) { const float z = -2.3022081198f * (v + 0.044715f * v * v * v); return v * __builtin_amdgcn_rcpf(1.0f + __builtin_amdgcn_exp2f(z)); }
__device__ __forceinline__ float sigmoidf_(float v) { return __builtin_amdgcn_rcpf(1.0f + __builtin_amdgcn_exp2f(-1.4426950409f * v)); }
__device__ __forceinline__ f32x4 bf4_lo(const u32x4 x) { return (f32x4){bf_lo(x.x), bf_hi(x.x), bf_lo(x.y), bf_hi(x.y)}; }
__device__ __forceinline__ f32x4 bf4_hi(const u32x4 x) { return (f32x4){bf_lo(x.z), bf_hi(x.z), bf_lo(x.w), bf_hi(x.w)}; }
__device__ __forceinline__ f32x4 exp2_v(const f32x4 t) { return (f32x4){__builtin_amdgcn_exp2f(t[0]), __builtin_amdgcn_exp2f(t[1]), __builtin_amdgcn_exp2f(t[2]), __builtin_amdgcn_exp2f(t[3])}; }
__device__ __forceinline__ f32x4 rcp_v(const f32x4 t) { return (f32x4){__builtin_amdgcn_rcpf(t[0]), __builtin_amdgcn_rcpf(t[1]), __builtin_amdgcn_rcpf(t[2]), __builtin_amdgcn_rcpf(t[3])}; }
__device__ __forceinline__ f32x4 sigmoid_v(const f32x4 a) { return rcp_v(exp2_v(a * -1.4426950409f) + 1.0f); }
__device__ __forceinline__ f32x4 gelu_tanh_v(const f32x4 v) { const f32x4 z = v * ((v * v) * -0.1029432397f + -2.3022081198f); return v * rcp_v(exp2_v(z) + 1.0f); }
__device__ __forceinline__ u32x4 pack8(const f32x4 a, const f32x4 b) { u32x4 w; w.x = cvt_pk_bf16(a[0], a[1]); w.y = cvt_pk_bf16(a[2], a[3]); w.z = cvt_pk_bf16(b[0], b[1]); w.w = cvt_pk_bf16(b[2], b[3]); return w; }
__device__ __forceinline__ float rs_from_ssq(float ssq, float inv_n) { return __builtin_amdgcn_rsqf(ssq * inv_n + EPS); }

namespace pg8 {
constexpr int BM = 256, BK = 64, HALF = 128, HTB = HALF * BK * 2, STAGE_BYTES = 8 * HTB, NXCD = 8, WGM = 8;
__host__ __device__ __forceinline__ int lds_byte(int r, int c) { const int st = (r >> 4) * 2 + (c >> 5), rr = r & 15, cc = c & 31, ob = rr * 64 + cc * 2; return st * 1024 + (ob ^ (((ob >> 9) & 1) << 5)); }
__host__ __device__ __forceinline__ int perm32(int rho) { const int n = rho >> 4, i = rho & 15; return 8 * (i >> 2) + 4 * n + (i & 3); }
__host__ __device__ __forceinline__ void stage_rc(int b, int& R, int& C) { const int st = b / 1024, sb = b % 1024, swz = sb ^ (((sb >> 9) & 1) << 5); R = (st >> 1) * 16 + swz / 64; C = (st & 1) * 32 + (swz % 64) / 2; }

struct Unit { int pm, pn, ka, kb, part; };
struct Gemm { const bf16_t* A; const bf16_t* Bt; int lda, ldb, K; };

struct StaticOrder {
    int nM, nN, nwg, G, c;
    __device__ void init(int M, int N, int G_, int c_) { nM = M / BM; nN = N / BM; nwg = nM * nN; G = G_; c = c_; }
    __device__ bool next(int i, Unit& u) const {
        const long L = (long)i * G + c; if (L >= nwg) return false;
        int wgid = (int)L; { const int q = nwg / NXCD, r = nwg % NXCD, xcd = wgid % NXCD, off = wgid / NXCD; wgid = (xcd < r ? xcd * (q + 1) : r * (q + 1) + (xcd - r) * q) + off; }
        const int nig = WGM * nN, gid = wgid / nig, fm = gid * WGM, gsz = (nM - fm) < WGM ? (nM - fm) : WGM;
        u.pm = fm + ((wgid % nig) % gsz); u.pn = (wgid % nig) / gsz; u.ka = 0; u.kb = 0; u.part = 0; return true;
    }
};
struct OneUnit { int pm, pn;
    __device__ bool next(int i, Unit& u) const { if (i) return false; u.pm = pm; u.pn = pn; u.ka = 0; u.kb = 0; u.part = 0; return true; } };
struct SplitOrder { StaticOrder so;
    __device__ bool next(int i, Unit& u) const { if (!so.next(i >> 1, u)) return false; u.ka = u.kb = (i & 1) * 512; u.part = (i & 1) ? 0 : 1; return true; } };

template <class Epi, class Sched, bool PERM = false, bool HALF_N = false>
__device__ __forceinline__ void gemm_phase(LAS unsigned char* lds, const Gemm g, const Sched& S, const Epi& E) {
    const int tid = threadIdx.x, wid = __builtin_amdgcn_readfirstlane(tid >> 6), lane = tid & 63, wr = wid >> 2, wc = wid & 3, fr = lane & 15, fq = lane >> 4;
    const int nt = g.K / BK;
    unsigned voffA[2], voffB[2];
#pragma unroll
    for (int i = 0; i < 2; ++i) { int R, C; stage_rc(tid * 16 + i * 8192, R, C); const int Rb = PERM ? ((R & ~31) + perm32(R & 31)) : R; voffA[i] = (unsigned)(R * g.lda + C) * 2u; voffB[i] = (unsigned)(Rb * g.ldb + C) * 2u; }
    const size_t kstep = (size_t)(BK * 2);
    const size_t hA = (size_t)HALF * g.lda * 2, hB = (size_t)HALF * g.ldb * 2, tA = 2 * hA, tB = 2 * hB;
    const unsigned ldsw = (unsigned)wid * 1024u;
    const int aoff = lds_byte(wr * 64 + fr, fq * 8), boff = lds_byte(wc * 32 + fr, fq * 8);
#define PG8_SA(b, h) (((b) * 2 + (h)) * HTB)
#define PG8_SB(b, h) ((4 + (b) * 2 + (h)) * HTB)
#define PG8_STAGE(bufoff, gbase, voff) do { _Pragma("unroll") for (int _i = 0; _i < 2; ++_i) \
        __builtin_amdgcn_global_load_lds((const unsigned*)((const char*)(gbase) + (voff)[_i]), (LAS unsigned*)(lds + (bufoff) + ldsw + _i * 8192), 16, 0, 0); } while (0)
#define PG8_LDA(dst, b, h) do { _Pragma("unroll") for (int m = 0; m < 4; ++m) _Pragma("unroll") for (int k = 0; k < 2; ++k) dst[m][k] = *(const LAS bf16x8*)(lds + PG8_SA(b, h) + aoff + m * 2048 + k * 1024); } while (0)
#define PG8_LDB(dst, b, h) do { _Pragma("unroll") for (int n = 0; n < 2; ++n) _Pragma("unroll") for (int k = 0; k < 2; ++k) dst[n][k] = *(const LAS bf16x8*)(lds + PG8_SB(b, h) + boff + n * 2048 + k * 1024); } while (0)
#define PG8_MMA(ai, bj, At, Bt) do { __builtin_amdgcn_s_setprio(1); _Pragma("unroll") for (int m = 0; m < 4; ++m) _Pragma("unroll") for (int n = 0; n < 2; ++n) _Pragma("unroll") for (int k = 0; k < 2; ++k) \
        acc[ai][bj][m][n] = __builtin_amdgcn_mfma_f32_16x16x32_bf16(Bt[n][k], At[m][k], acc[ai][bj][m][n], 0, 0, 0); __builtin_amdgcn_s_setprio(0); } while (0)
#define PG8_WAIT_V(n) asm volatile("s_waitcnt vmcnt(" #n ")" ::: "memory")
#define PG8_WAIT_L(n) asm volatile("s_waitcnt lgkmcnt(" #n ")" ::: "memory")
#define PG8_BAR __builtin_amdgcn_s_barrier()
#define PG8_SCHED __builtin_amdgcn_sched_barrier(0)
    Unit cur, nxt; int ui = 0;
    if (!S.next(0, cur)) return;
    f32x4 acc[2][2][4][2];
#pragma unroll
    for (int a = 0; a < 2; ++a)
#pragma unroll
        for (int b = 0; b < 2; ++b)
#pragma unroll
            for (int m = 0; m < 4; ++m)
#pragma unroll
                for (int n = 0; n < 2; ++n) acc[a][b][m][n] = (f32x4){0.f, 0.f, 0.f, 0.f};
    bf16x8 At[4][2], B0[2][2], B1[2][2];
    const char* cA = (const char*)g.A + (size_t)cur.pm * tA + (size_t)cur.ka * 2; const char* cB = (const char*)g.Bt + (size_t)cur.pn * tB + (size_t)cur.kb * 2;
    PG8_STAGE(PG8_SB(0, 0), cB, voffB); PG8_STAGE(PG8_SB(0, 1), cB + hB, voffB); PG8_STAGE(PG8_SA(0, 0), cA, voffA); PG8_STAGE(PG8_SA(0, 1), cA + hA, voffA);
    if (wr == 1) PG8_BAR;
    PG8_WAIT_V(2); PG8_BAR;
    PG8_STAGE(PG8_SB(1, 0), cB + kstep, voffB); PG8_STAGE(PG8_SA(1, 0), cA + kstep, voffA); PG8_STAGE(PG8_SB(1, 1), cB + hB + kstep, voffB);
    PG8_WAIT_V(6); PG8_BAR;
    for (;;) {
        const bool has_next = S.next(ui + 1, nxt);
        const char* nA = has_next ? (const char*)g.A + (size_t)nxt.pm * tA + (size_t)nxt.ka * 2 : cA; const char* nB = has_next ? (const char*)g.Bt + (size_t)nxt.pn * tB + (size_t)nxt.kb * 2 : cB;
        for (int t = 0; t < nt; t += 2) {
            const bool last = (t == nt - 2);
            const char* a1 = cA + (size_t)(t + 1) * kstep;
            const char* a2 = last ? nA : cA + (size_t)(t + 2) * kstep; const char* b2 = last ? nB : cB + (size_t)(t + 2) * kstep;
            const char* a3 = a2 + kstep; const char* b3 = b2 + kstep;
            PG8_LDB(B0, 0, 0); if constexpr (!HALF_N) PG8_LDB(B1, 0, 1); PG8_SCHED; PG8_LDA(At, 0, 0); PG8_STAGE(PG8_SA(1, 1), a1 + hA, voffA);
            PG8_WAIT_V(8); PG8_WAIT_L(0); PG8_BAR; PG8_MMA(0, 0, At, B0); if constexpr (!HALF_N) PG8_MMA(0, 1, At, B1); PG8_BAR; PG8_SCHED;
            PG8_LDA(At, 0, 1); PG8_STAGE(PG8_SB(0, 0), b2, voffB); PG8_STAGE(PG8_SB(0, 1), b2 + hB, voffB); PG8_STAGE(PG8_SA(0, 0), a2, voffA);
            PG8_WAIT_V(8); PG8_WAIT_L(0); PG8_BAR; PG8_MMA(1, 0, At, B0); if constexpr (!HALF_N) PG8_MMA(1, 1, At, B1); PG8_BAR; PG8_SCHED;
            PG8_LDB(B0, 1, 0); if constexpr (!HALF_N) PG8_LDB(B1, 1, 1); PG8_SCHED; PG8_LDA(At, 1, 0); PG8_STAGE(PG8_SA(0, 1), a2 + hA, voffA);
            PG8_WAIT_V(8); PG8_WAIT_L(0); PG8_BAR; PG8_MMA(0, 0, At, B0); if constexpr (!HALF_N) PG8_MMA(0, 1, At, B1); PG8_BAR; PG8_SCHED;
            PG8_LDA(At, 1, 1); PG8_STAGE(PG8_SB(1, 0), b3, voffB); PG8_STAGE(PG8_SB(1, 1), b3 + hB, voffB); PG8_STAGE(PG8_SA(1, 0), a3, voffA);
            PG8_WAIT_V(8); PG8_WAIT_L(0); PG8_BAR; PG8_MMA(1, 0, At, B0); if constexpr (!HALF_N) PG8_MMA(1, 1, At, B1); PG8_BAR; PG8_SCHED;
        }
        if (wr == 0) PG8_BAR;
        if (cur.part) { E.mid(acc, cur, wr, wc, fr, fq); }
        else {
            E(acc, cur, wr, wc, fr, fq);
            if (has_next) {
#pragma unroll
                for (int a = 0; a < 2; ++a)
#pragma unroll
                    for (int b = 0; b < 2; ++b)
#pragma unroll
                        for (int m = 0; m < 4; ++m)
#pragma unroll
                            for (int n = 0; n < 2; ++n) acc[a][b][m][n] = (f32x4){0.f, 0.f, 0.f, 0.f};
            }
        }
        if (!has_next) break;
        cur = nxt; cA = nA; cB = nB; ++ui;
        if (wr == 1) PG8_BAR;
    }
    PG8_WAIT_V(0);
    PG8_BAR;
#undef PG8_SA
#undef PG8_SB
#undef PG8_STAGE
#undef PG8_LDA
#undef PG8_LDB
#undef PG8_MMA
#undef PG8_WAIT_V
#undef PG8_WAIT_L
#undef PG8_BAR
#undef PG8_SCHED
}
}
using pg8::Unit; using pg8::HALF; using pg8::BM;

typedef f32x4 AccT[2][2][4][2];

__device__ __forceinline__ void red_put(LAS float* red, int ai, int wr, int m, int fr, int wc, int fq, float s) { if (fq == 0) red[(ai * HALF + wr * 64 + m * 16 + fr) * 4 + wc] = s; }
template <bool WT>
__device__ __forceinline__ void red_flush(LAS float* red, float* part, const Unit& u) {
    asm volatile("s_waitcnt lgkmcnt(0)" ::: "memory"); __builtin_amdgcn_s_barrier(); asm volatile("" ::: "memory");
    const int t = threadIdx.x;
    if (t < 256) { const f32x4 v = *(const LAS f32x4*)(red + t * 4); const float sum = (v[0] + v[1]) + (v[2] + v[3]); float* p = part + (size_t)(u.pm * BM + t) * 4 + u.pn;
        if (WT) __hip_atomic_store(p, sum, __ATOMIC_RELAXED, __HIP_MEMORY_SCOPE_AGENT); else *p = sum; }
}
__device__ __forceinline__ float sum4(const f32x4 v) { return (v[0] + v[1]) + (v[2] + v[3]); }
struct EpiGateUp {
    const float* ssq; bf16_t* act;
    __device__ __forceinline__ void mid(AccT&, const Unit&, int, int, int, int) const {}
    __device__ __forceinline__ void operator()(const AccT& acc, const Unit& u, int wr, int wc, int fr, int fq) const {
        const int row0 = u.pm * BM + wr * 64 + fr, col0 = u.pn * 128 + wc * 32 + 8 * fq;
        float rsv[2][4];
#pragma unroll
        for (int ai = 0; ai < 2; ++ai)
#pragma unroll
            for (int m = 0; m < 4; ++m) rsv[ai][m] = sum4(*(const f32x4*)(ssq + (size_t)(row0 + ai * HALF + m * 16) * 4));
#pragma unroll
        for (int ai = 0; ai < 2; ++ai)
#pragma unroll
            for (int m = 0; m < 4; ++m) {
                const int row = row0 + ai * HALF + m * 16; const float rs = rs_from_ssq(rsv[ai][m], 1.0f / DM), rs2 = rs * rs, nl = -1.4426950409f * rs;
                f32x4 a[2];
#pragma unroll
                for (int n = 0; n < 2; ++n) { const f32x4 ga = acc[ai][0][m][n], ua = acc[ai][1][m][n]; const f32x4 pr = (ga * ua) * rs2, tt = ga * nl; f32x4 e;
#pragma unroll
                    for (int j = 0; j < 4; ++j) e[j] = __builtin_amdgcn_exp2f(tt[j]);
                    e = e + 1.0f; f32x4 r;
#pragma unroll
                    for (int j = 0; j < 4; ++j) r[j] = __builtin_amdgcn_rcpf(e[j]);
                    a[n] = pr * r; }
                u32x4 w; w.x = cvt_pk_bf16(a[0][0], a[0][1]); w.y = cvt_pk_bf16(a[0][2], a[0][3]); w.z = cvt_pk_bf16(a[1][0], a[1][1]); w.w = cvt_pk_bf16(a[1][2], a[1][3]);
                *(u32x4*)(act + (size_t)row * DFF + col0) = w;
            }
    }
};
struct EpiResid {
    bf16_t* xb; float* ssq_out; float scale; const float* ssq_row; LAS float* red;
    __device__ __forceinline__ void mid(AccT&, const Unit&, int, int, int, int) const {}
    __device__ __forceinline__ void operator()(const AccT& acc, const Unit& u, int wr, int wc, int fr, int fq) const {
        const int row0 = u.pm * BM + wr * 64 + fr, col0 = u.pn * BM + wc * 32 + 8 * fq;
        float scv[2][4];
#pragma unroll
        for (int ai = 0; ai < 2; ++ai)
#pragma unroll
            for (int m = 0; m < 4; ++m) { f32x2 t = (f32x2){0.f, 0.f}; if (ssq_row) t = *(const f32x2*)(ssq_row + (size_t)(row0 + ai * HALF + m * 16) * 4); scv[ai][m] = t[0] + t[1]; }
#pragma unroll
        for (int ai = 0; ai < 2; ++ai) {
            u32x4 xi[4][2];
#pragma unroll
            for (int m = 0; m < 4; ++m)
#pragma unroll
                for (int bj = 0; bj < 2; ++bj) xi[m][bj] = *(const u32x4*)(xb + (size_t)(row0 + ai * HALF + m * 16) * DM + col0 + bj * HALF);
#pragma unroll
            for (int m = 0; m < 4; ++m) {
                const int row = row0 + ai * HALF + m * 16; const size_t off = (size_t)row * DM + col0; float s = 0.f;
                const float sc = ssq_row ? scale * rs_from_ssq(scv[ai][m], 1.0f / DSSM) : scale;
#pragma unroll
                for (int bj = 0; bj < 2; ++bj) { const u32x4 x = xi[m][bj]; const f32x4 o0 = bf4_lo(x) + acc[ai][bj][m][0] * sc, o1 = bf4_hi(x) + acc[ai][bj][m][1] * sc;
                    const f32x4 q = o0 * o0 + o1 * o1; s += (q[0] + q[1]) + (q[2] + q[3]);
                    *(u32x4*)(xb + off + bj * HALF) = pack8(o0, o1); }
                s += __shfl_xor(s, 16); s += __shfl_xor(s, 32);
                red_put(red, ai, wr, m, fr, wc, fq, s);
            }
        }
        red_flush<false>(red, ssq_out, u);
    }
};
struct EpiFinal {
    const bf16_t* xb; float* ssq_out; unsigned* cnt; const float* gn; float* out; LAS float* red;
    __device__ __forceinline__ void mid(AccT&, const Unit&, int, int, int, int) const {}
    __device__ __forceinline__ void operator()(const AccT& acc, const Unit& u, int wr, int wc, int fr, int fq) const {
        const int row0 = u.pm * BM + wr * 64 + fr, col0 = u.pn * BM + wc * 32 + 8 * fq;
#pragma unroll
        for (int ai = 0; ai < 2; ++ai) {
            u32x4 xi[4][2];
#pragma unroll
            for (int m = 0; m < 4; ++m)
#pragma unroll
                for (int bj = 0; bj < 2; ++bj) xi[m][bj] = *(const u32x4*)(xb + (size_t)(row0 + ai * HALF + m * 16) * DM + col0 + bj * HALF);
#pragma unroll
            for (int m = 0; m < 4; ++m) { float s = 0.f;
#pragma unroll
                for (int bj = 0; bj < 2; ++bj) { const u32x4 x = xi[m][bj]; const f32x4 o0 = bf4_lo(x) + acc[ai][bj][m][0] * 0.5f, o1 = bf4_hi(x) + acc[ai][bj][m][1] * 0.5f;
                    const f32x4 q = o0 * o0 + o1 * o1; s += (q[0] + q[1]) + (q[2] + q[3]); }
                s += __shfl_xor(s, 16); s += __shfl_xor(s, 32);
                red_put(red, ai, wr, m, fr, wc, fq, s);
            }
        }
        red_flush<true>(red, ssq_out, u);
        asm volatile("s_waitcnt vmcnt(0)" ::: "memory");
        unsigned* cw = cnt + 64 * u.pm;
        if ((threadIdx.x & 63) == 0 && threadIdx.x < 256) __hip_atomic_fetch_add(cw, 1u, __ATOMIC_RELAXED, __HIP_MEMORY_SCOPE_AGENT);
        { unsigned sp = 0;
          while ((unsigned)__builtin_amdgcn_readfirstlane(__hip_atomic_load(cw, __ATOMIC_RELAXED, __HIP_MEMORY_SCOPE_AGENT)) < 16u) { __builtin_amdgcn_s_sleep(2); if (++sp > (1u << 20)) break; } }
        __builtin_amdgcn_fence(__ATOMIC_ACQUIRE, "agent");
        f32x4 gv[2][2];
#pragma unroll
        for (int bj = 0; bj < 2; ++bj)
#pragma unroll
            for (int n = 0; n < 2; ++n) gv[bj][n] = *(const f32x4*)(gn + col0 + bj * HALF + n * 4);
#pragma unroll
        for (int ai = 0; ai < 2; ++ai) {
            u32x4 xi[4][2]; float sq[4];
#pragma unroll
            for (int m = 0; m < 4; ++m) { const float* pp = ssq_out + (size_t)(row0 + ai * HALF + m * 16) * 4;
                sq[m] = (__hip_atomic_load(pp, __ATOMIC_RELAXED, __HIP_MEMORY_SCOPE_AGENT) + __hip_atomic_load(pp + 1, __ATOMIC_RELAXED, __HIP_MEMORY_SCOPE_AGENT)) + (__hip_atomic_load(pp + 2, __ATOMIC_RELAXED, __HIP_MEMORY_SCOPE_AGENT) + __hip_atomic_load(pp + 3, __ATOMIC_RELAXED, __HIP_MEMORY_SCOPE_AGENT));
#pragma unroll
                for (int bj = 0; bj < 2; ++bj) xi[m][bj] = *(const u32x4*)(xb + (size_t)(row0 + ai * HALF + m * 16) * DM + col0 + bj * HALF); }
#pragma unroll
            for (int m = 0; m < 4; ++m) { const float rs = rs_from_ssq(sq[m], 1.0f / DM); float* orow = out + (size_t)(row0 + ai * HALF + m * 16) * DM + col0;
#pragma unroll
                for (int bj = 0; bj < 2; ++bj) { const u32x4 x = xi[m][bj];
                    *(f32x4*)(orow + bj * HALF) = (bf4_lo(x) + acc[ai][bj][m][0] * 0.5f) * (gv[bj][0] * rs); *(f32x4*)(orow + bj * HALF + 4) = (bf4_hi(x) + acc[ai][bj][m][1] * 0.5f) * (gv[bj][1] * rs); }
            }
        }
    }
};
struct EpiWin {
    const float* ssq; bf16_t* app; bf16_t* qkv; const float* ropec; const float* ropes;
    __device__ __forceinline__ void mid(AccT&, const Unit&, int, int, int, int) const {}
    __device__ __forceinline__ void operator()(const AccT& acc, const Unit& u, int wr, int wc, int fr, int fq) const {
        const int row0 = u.pm * BM + wr * 64 + fr;
        const bool rope_w = (u.pn >= 2) && ((wc & 1) == 0);
        float rsv[2][4];
#pragma unroll
        for (int ai = 0; ai < 2; ++ai)
#pragma unroll
            for (int m = 0; m < 4; ++m) rsv[ai][m] = sum4(*(const f32x4*)(ssq + (size_t)(row0 + ai * HALF + m * 16) * 4));
#pragma unroll
        for (int ai = 0; ai < 2; ++ai)
#pragma unroll
            for (int mh = 0; mh < 2; ++mh) {
                f32x4 csv[2][2], snv[2][2];
                if (rope_w) {
#pragma unroll
                    for (int mm = 0; mm < 2; ++mm) { const int pos = (row0 + ai * HALF + (2 * mh + mm) * 16) & (SEQ - 1);
#pragma unroll
                        for (int n = 0; n < 2; ++n) { csv[mm][n] = *(const f32x4*)(ropec + pos * 8 + 4 * n); snv[mm][n] = *(const f32x4*)(ropes + pos * 8 + 4 * n); } }
                } else {
#pragma unroll
                    for (int mm = 0; mm < 2; ++mm)
#pragma unroll
                        for (int n = 0; n < 2; ++n) { csv[mm][n] = (f32x4){1.f, 1.f, 1.f, 1.f}; snv[mm][n] = (f32x4){0.f, 0.f, 0.f, 0.f}; }
                }
#pragma unroll
                for (int mm = 0; mm < 2; ++mm) {
                    const int m = 2 * mh + mm, row = row0 + ai * HALF + m * 16; const float rs = rs_from_ssq(rsv[ai][m], 1.0f / DM);
#pragma unroll
                    for (int bj = 0; bj < 2; ++bj) {
                        const int col = u.pn * BM + bj * HALF + wc * 32 + 8 * fq; f32x4 v0 = acc[ai][bj][m][0] * rs, v1 = acc[ai][bj][m][1] * rs;
                        bf16_t* p;
                        if (u.pn < 2) { const int g = col >> 4, c = col & 15; p = app + ((size_t)(g * NBN + (row >> 5)) * KY + (row & 31) * NCH + c); }
                        else {
                            const bool is_v = (u.pn == 4 && bj == 1);
                            if (!is_v && rope_w) {
                                f32x4 p0, p1;
#pragma unroll
                                for (int j = 0; j < 4; ++j) { p0[j] = __shfl_xor(v0[j], 16); p1[j] = __shfl_xor(v1[j], 16); }
                                if (fq == 0) { v0 = v0 * csv[mm][0] - p0 * snv[mm][0]; v1 = v1 * csv[mm][1] - p1 * snv[mm][1]; }
                                else if (fq == 1) { v0 = v0 * csv[mm][0] + p0 * snv[mm][0]; v1 = v1 * csv[mm][1] + p1 * snv[mm][1]; }
                            }
                            p = qkv + (size_t)row * 768 + (col - 512);
                        }
                        u32x4 w; w.x = cvt_pk_bf16(v0[0], v0[1]); w.y = cvt_pk_bf16(v0[2], v0[3]); w.z = cvt_pk_bf16(v1[0], v1[1]); w.w = cvt_pk_bf16(v1[2], v1[3]); *(u32x4*)p = w;
                    }
                }
            }
    }
};
struct EpiS1 {
    float* sloc;
    __device__ __forceinline__ void mid(AccT&, const Unit&, int, int, int, int) const {}
    __device__ __forceinline__ void operator()(const AccT& acc, const Unit& u, int wr, int wc, int fr, int fq) const {
        const int row0 = u.pm * BM + wr * 64 + fr, col0 = wc * 32 + 8 * fq;
#pragma unroll
        for (int ai = 0; ai < 2; ++ai)
#pragma unroll
            for (int m = 0; m < 4; ++m) { float* rowp = sloc + (size_t)(row0 + ai * HALF + m * 16) * 128 + col0;
#pragma unroll
                for (int n = 0; n < 2; ++n) *(f32x4*)(rowp + n * 4) = acc[ai][0][m][n]; }
    }
};
struct EpiY {
    const bf16_t* app; const float* Dv; bf16_t* ygelu;
    __device__ __forceinline__ void mid(AccT&, const Unit&, int, int, int, int) const {}
    __device__ __forceinline__ void operator()(const AccT& acc, const Unit& u, int wr, int wc, int fr, int fq) const {
        const int row0 = u.pm * BM + wr * 64 + fr, g = u.pm >> 2, colb = (u.pn & 1) * BM + wc * 32 + 8 * fq, c0 = 8 * (fq & 1);
        const f32x4 d0 = *(const f32x4*)(Dv + g * NCH + c0), d1 = *(const f32x4*)(Dv + g * NCH + c0 + 4);
#pragma unroll
        for (int ai = 0; ai < 2; ++ai) {
            u32x4 uw[4][2];
#pragma unroll
            for (int m = 0; m < 4; ++m)
#pragma unroll
                for (int bj = 0; bj < 2; ++bj) uw[m][bj] = *(const u32x4*)(app + (size_t)(row0 + ai * HALF + m * 16) * KY + colb + bj * HALF);
#pragma unroll
            for (int m = 0; m < 4; ++m) {
                const int row = row0 + ai * HALF + m * 16, nidx = row & (NBN - 1);
#pragma unroll
                for (int bj = 0; bj < 2; ++bj) {
                    const int colg = colb + bj * HALF, t = colg >> 4; const u32x4 w0 = uw[m][bj];
                    const f32x4 y0 = gelu_tanh_v(acc[ai][bj][m][0] + d0 * bf4_lo(w0)), y1 = gelu_tanh_v(acc[ai][bj][m][1] + d1 * bf4_hi(w0));
                    *(u32x4*)(ygelu + (size_t)(nidx * TCH + t) * DSSM + g * NCH + c0) = pack8(y0, y1);
                }
            }
        }
    }
};
struct EpiGlu {
    const bf16_t* ygelu; const float* bias; bf16_t* ycat; float* ssq_out; LAS float* red;
    __device__ __forceinline__ void mid(AccT&, const Unit&, int, int, int, int) const {}
    __device__ __forceinline__ void operator()(const AccT& acc, const Unit& u, int wr, int wc, int fr, int fq) const {
        const int row0 = u.pm * BM + wr * 64 + fr, col0 = u.pn * BM + wc * 32 + 8 * fq;
        f32x4 bv[2][2];
#pragma unroll
        for (int bj = 0; bj < 2; ++bj)
#pragma unroll
            for (int n = 0; n < 2; ++n) bv[bj][n] = *(const f32x4*)(bias + col0 + bj * HALF + n * 4);
#pragma unroll
        for (int ai = 0; ai < 2; ++ai) {
            u32x4 yv[4][2];
#pragma unroll
            for (int m = 0; m < 4; ++m)
#pragma unroll
                for (int bj = 0; bj < 2; ++bj) yv[m][bj] = *(const u32x4*)(ygelu + (size_t)(row0 + ai * HALF + m * 16) * DSSM + col0 + bj * HALF);
#pragma unroll
            for (int m = 0; m < 4; ++m) {
                const int row = row0 + ai * HALF + m * 16; float s = 0.f;
#pragma unroll
                for (int bj = 0; bj < 2; ++bj) { const u32x4 yw = yv[m][bj];
                    const f32x4 z0 = bf4_lo(yw) * sigmoid_v(acc[ai][bj][m][0] + bv[bj][0]), z1 = bf4_hi(yw) * sigmoid_v(acc[ai][bj][m][1] + bv[bj][1]);
                    const f32x4 q = z0 * z0 + z1 * z1; s += (q[0] + q[1]) + (q[2] + q[3]);
                    *(u32x4*)(ycat + (size_t)row * DM + col0 + bj * HALF) = pack8(z0, z1); }
                s += __shfl_xor(s, 16); s += __shfl_xor(s, 32);
                red_put(red, ai, wr, m, fr, wc, fq, s);
            }
        }
        red_flush<false>(red, ssq_out, u);
    }
};

#define XB_TMO      128
#define XB_XCNT(j)  (256  + 64 * (j))
#define XB_XSUB(j)  (1280 + 64 * (j))
#define XB_XGEN(j)  (2304 + 64 * (j))
#define XB_TOP      3328
#define XB_TOPGEN   3392
#define XCD_BAR_WORDS 3456
#define XB_SPIN_CAP (1u << 18)
__device__ __forceinline__ unsigned xb_ld(unsigned* p)              { return __hip_atomic_load(p, __ATOMIC_RELAXED, __HIP_MEMORY_SCOPE_AGENT); }
__device__ __forceinline__ unsigned xb_add(unsigned* p, unsigned v) { return __hip_atomic_fetch_add(p, v, __ATOMIC_RELAXED, __HIP_MEMORY_SCOPE_AGENT); }
__device__ __forceinline__ unsigned xb_xcc_id() { return (unsigned)__builtin_amdgcn_s_getreg((3 << 11) | 20) & 0xFu; }
#define XB_SPIN(cond, bar) do { unsigned _sp = 0; while (cond) { __builtin_amdgcn_s_sleep(1); \
    if ((++_sp & 255u) == 0u) { if (xb_ld(&(bar)[XB_TMO])) break; if (_sp > XB_SPIN_CAP) { atomicAdd(&(bar)[XB_TMO], 1u); break; } } } } while (0)
struct XcdBarrier { unsigned* bar; unsigned x; volatile LAS unsigned* st; };
__device__ __forceinline__ XcdBarrier xcd_barrier_post(unsigned* bar, volatile LAS unsigned* st) {
    XcdBarrier b; b.bar = bar; b.x = xb_xcc_id(); b.st = st;
    if (threadIdx.x == 0) (void)xb_add(&bar[XB_XCNT(b.x)], 1u);
    return b;
}
__device__ __forceinline__ void xcd_barrier_complete(unsigned* bar, unsigned x, unsigned& nloc, unsigned& nx) {
    const unsigned G = gridDim.x * gridDim.y * gridDim.z;
    unsigned sum, cnt, mine, sp = 0u;
    for (;;) {
        sum = 0u; cnt = 0u; mine = 0u;
#pragma unroll
        for (unsigned j = 0; j < 16; ++j) { const unsigned c = xb_ld(&bar[XB_XCNT(j)]); sum += c; cnt += (c > 0u) ? 1u : 0u; mine = (j == x) ? c : mine; }
        if (sum == G) break;
        __builtin_amdgcn_s_sleep(1);
        if ((++sp & 255u) == 0u) { if (xb_ld(&bar[XB_TMO])) break; if (sp > XB_SPIN_CAP) { atomicAdd(&bar[XB_TMO], 1u); break; } }
    }
    nloc = mine > 0u ? mine : 1u; nx = cnt > 0u ? cnt : 1u;
}
__device__ __forceinline__ void xcd_barrier(const XcdBarrier& b) {
    asm volatile("s_waitcnt vmcnt(0)" ::: "memory");
    __syncthreads();
    if (threadIdx.x == 0) {
        unsigned* bar = b.bar;
        __builtin_amdgcn_s_waitcnt(0);
        unsigned nloc = b.st[0], nx = b.st[1];
        if (nloc == 0u) { xcd_barrier_complete(bar, b.x, nloc, nx); b.st[0] = nloc; b.st[1] = nx; }
        const unsigned old = xb_add(&bar[XB_XSUB(b.x)], 1u);
        const unsigned gen = old / nloc;
        if (old + 1u == (gen + 1u) * nloc) {
            __builtin_amdgcn_fence(__ATOMIC_RELEASE, "agent");
            asm volatile("s_waitcnt vmcnt(0)" ::: "memory");
            const unsigned og = xb_add(&bar[XB_TOP], 1u);
            const unsigned tg = og / nx;
            if (og + 1u == (tg + 1u) * nx) xb_add(&bar[XB_TOPGEN], 1u);
            else XB_SPIN(xb_ld(&bar[XB_TOPGEN]) == tg, bar);
            __builtin_amdgcn_fence(__ATOMIC_ACQUIRE, "agent");
            xb_add(&bar[XB_XGEN(b.x)], 1u);
            asm volatile("s_waitcnt vmcnt(0)" ::: "memory");
        } else {
            XB_SPIN(xb_ld(&bar[XB_XGEN(b.x)]) == gen, bar);
            __builtin_amdgcn_fence(__ATOMIC_ACQUIRE, "agent");
            asm volatile("s_waitcnt vmcnt(0)" ::: "memory");
        }
    }
    __syncthreads();
}

struct Ctx {
    const float* in[26]; float* out; unsigned char* ws; LAS unsigned char* lds; int tid, lane, wave, G, bx;
    __device__ __forceinline__ const float* inp(int i) const { return in[i]; }
};
#define WSP(T, off) ((T*)(C.ws + (off)))

__device__ __forceinline__ void transpose_item(const float* W, int K, int N, bf16_t* WT, const float* g0, const float* g1, int ksplit, int mode, LAS float* scr, int item, int lane) {
    const int nblk = N / 32, kb = item / nblk, nb = item % nblk, k0 = 64 * kb, n0 = 32 * nb;
#pragma unroll
    for (int i = 0; i < 8; ++i) { const int kk = 8 * i + (lane >> 3), k = k0 + kk, n4 = (lane & 7) * 4; const float gs = g0 ? (k < ksplit ? g0[k] : g1[k - ksplit]) : 1.0f;
        const f32x4 v = __builtin_nontemporal_load((const f32x4*)(W + (size_t)k * N + n0 + n4)); LAS float* d = scr + kk * 33 + n4; d[0] = v[0] * gs; d[1] = v[1] * gs; d[2] = v[2] * gs; d[3] = v[3] * gs; }
    asm volatile("s_waitcnt lgkmcnt(0)" ::: "memory");
    const int c = lane & 7;
#pragma unroll
    for (int j = 0; j < 4; ++j) { const int n = (lane >> 3) + 8 * j, ncol = n0 + n; const LAS float* s = scr + (8 * c) * 33 + n;
        const int drow = (mode == 0) ? ncol : (((ncol >> 7) << 8) + (ncol & 127) + (mode == 2 ? 128 : 0));
        u32x4 o; o.x = cvt_pk_bf16(s[0 * 33], s[1 * 33]); o.y = cvt_pk_bf16(s[2 * 33], s[3 * 33]); o.z = cvt_pk_bf16(s[4 * 33], s[5 * 33]); o.w = cvt_pk_bf16(s[6 * 33], s[7 * 33]);
        *(u32x4*)(WT + (size_t)drow * K + k0 + 8 * c) = o; }
    asm volatile("s_waitcnt lgkmcnt(0)" ::: "memory");
}

__device__ __forceinline__ float wave_sum(float v) {
#pragma unroll
    for (int o = 1; o < 64; o <<= 1) v += __shfl_xor(v, o);
    return v;
}

__device__ __forceinline__ void phase_prep0(const Ctx& C) {
    const int gw = C.wave * C.G + C.bx, NGW = C.G * NWAVES;
    const int gt = C.bx * NTHREADS + C.tid, NGT = C.G * NTHREADS;
    float* ssq = WSP(float, WS_SSQ);
    {
        const float* x = C.inp(0); bf16_t* xb = WSP(bf16_t, WS_XB);
        for (int row = gw; row < M_TOK; row += NGW) {
            const f32x4* xr = (const f32x4*)(x + (size_t)row * DM) + C.lane; f32x4 v[4]; float s = 0.f;
#pragma unroll
            for (int j = 0; j < 4; ++j) { v[j] = __builtin_nontemporal_load(xr + 64 * j); s += (v[j][0] * v[j][0] + v[j][1] * v[j][1]) + (v[j][2] * v[j][2] + v[j][3] * v[j][3]); }
            s = wave_sum(s);
            u32x2* o8 = (u32x2*)(xb + (size_t)row * DM) + C.lane;
#pragma unroll
            for (int j = 0; j < 4; ++j) { u32x2 w; w.x = cvt_pk_bf16(v[j][0], v[j][1]); w.y = cvt_pk_bf16(v[j][2], v[j][3]); o8[64 * j] = w; }
            if (C.lane == 0) *(f32x4*)(ssq + (size_t)row * 4) = (f32x4){s, 0.f, 0.f, 0.f};
        }
    }
    for (int i = gt; i < 128 * 64; i += NGT) ssq[5 * SSQ_STRIDE + i] = 0.f;
    {
        LAS float* scr = (LAS float*)(C.lds + C.wave * 16384);
        constexpr int I_GU = (DM / 64) * (DFF / 32), I_DN = (DFF / 64) * (DM / 32), I_IN = (DM / 64) * (DIN / 32), I_OUT = (DM / 64) * (DM / 32), I_GLU = (DSSM / 64) * (DSSM / 32);
        constexpr int NITEMS = 2 * I_GU + I_DN + I_IN;
        for (int it = gw; it < NITEMS; it += NGW) {
            int r = it;
            if (r < I_GU) { transpose_item(C.inp(2), DM, DFF, WSP(bf16_t, WS_WGU1), C.inp(1), C.inp(1), DM, 1, scr, r, C.lane); continue; } r -= I_GU;
            if (r < I_GU) { transpose_item(C.inp(3), DM, DFF, WSP(bf16_t, WS_WGU1), C.inp(1), C.inp(1), DM, 2, scr, r, C.lane); continue; } r -= I_GU;
            if (r < I_DN) { transpose_item(C.inp(4), DFF, DM, WSP(bf16_t, WS_WD1), nullptr, nullptr, 0, 0, scr, r, C.lane); continue; } r -= I_DN;
            transpose_item(C.inp(6), DM, DIN, WSP(bf16_t, WS_WIN), C.inp(5), C.inp(5), DM, 0, scr, r, C.lane);
        }
    }
    {
        float* rc = WSP(float, WS_ROPE); float* rsn = rc + SEQ * 8;
        for (int i = gt; i < SEQ * 8; i += NGT) {
            const int pos = i >> 3, k = i & 7;
            const double f = (k == 0) ? 1.0 : (k == 1) ? 0.19392274474868576 : (k == 2) ? 0.03760603093086393 : (k == 3) ? 0.007292664737217109 : (k == 4) ? 0.001414213562373095 : (k == 5) ? 0.0002742481756762073 : (k == 6) ? 5.318295896944988e-05 : 1.031338537721246e-05;
            const double xx = (double)pos * f; const double kk = __builtin_rint(xx * 0.15915494309189535); const float r = (float)(xx - kk * 6.283185307179586);
            rc[i] = cosf(r); rsn[i] = sinf(r);
        }
    }
    {
        f32x2* pw = WSP(f32x2, WS_PW); f32x2* bbar = WSP(f32x2, WS_BBAR);
        for (int i = gt; i < NG * NP * PWN; i += NGT) {
            const int gp = i / PWN, d = i - gp * PWN, g = gp >> 6; const float are = C.inp(7)[gp], aim = C.inp(8)[gp], dt = expf(C.inp(9)[g]);
            const double xx = (double)aim * (double)dt * (double)d; const double kk = __builtin_rint(xx * 0.15915494309189535); const float r = (float)(xx - kk * 6.283185307179586);
            const float mag = expf(are * dt * (float)d); pw[i] = (f32x2){mag * cosf(r), mag * sinf(r)};
        }
        for (int i = gt; i < NG * NP * NCH; i += NGT) {
            const int gp = i >> 4, g = gp >> 6; const float are = C.inp(7)[gp], aim = C.inp(8)[gp], dt = expf(C.inp(9)[g]);
            const double xx = (double)aim * (double)dt; const double kk = __builtin_rint(xx * 0.15915494309189535); const float r = (float)(xx - kk * 6.283185307179586);
            const float mag = expf(are * dt), l1r = mag * cosf(r), l1i = mag * sinf(r);
            const float nr = l1r - 1.0f, ni = l1i, den = 1.0f / (are * are + aim * aim); const float zr = (nr * are + ni * aim) * den, zi = (ni * are - nr * aim) * den;
            const float br = C.inp(10)[i], bi = C.inp(11)[i]; bbar[i] = (f32x2){zr * br - zi * bi, zr * bi + zi * br};
        }
    }
}
__device__ __forceinline__ void weights_late_item(const Ctx& C, int it) {
    LAS float* scr = (LAS float*)(C.lds + C.wave * 16384);
    constexpr int I_GU = (DM / 64) * (DFF / 32), I_DN = (DFF / 64) * (DM / 32), I_OUT = (DM / 64) * (DM / 32), I_GLU = (DSSM / 64) * (DSSM / 32);
    static_assert(2 * I_GU + I_DN + I_OUT + I_GLU == 256 * 19, "late weight items: 19 per workgroup");
    int r = it;
    if (r < I_GU) { transpose_item(C.inp(22), DM, DFF, WSP(bf16_t, WS_WGU2), C.inp(21), C.inp(21), DM, 1, scr, r, C.lane); return; } r -= I_GU;
    if (r < I_GU) { transpose_item(C.inp(23), DM, DFF, WSP(bf16_t, WS_WGU2), C.inp(21), C.inp(21), DM, 2, scr, r, C.lane); return; } r -= I_GU;
    if (r < I_DN) { transpose_item(C.inp(24), DFF, DM, WSP(bf16_t, WS_WD2), nullptr, nullptr, 0, 0, scr, r, C.lane); return; } r -= I_DN;
    if (r < I_OUT) { transpose_item(C.inp(20), DM, DM, WSP(bf16_t, WS_WOUT), C.inp(18), C.inp(19), DSSM, 0, scr, r, C.lane); return; } r -= I_OUT;
    transpose_item(C.inp(15), DSSM, DSSM, WSP(bf16_t, WS_WGLU), nullptr, nullptr, 0, 0, scr, r, C.lane);
}
__device__ __forceinline__ void phase_prep1(const Ctx& C) {
    LAS float* L = (LAS float*)C.lds;
    LAS float* Cr = L; LAS float* Ci = L + 1024; LAS f32x2* Bb = (LAS f32x2*)(L + 2048); LAS f32x2* Pw = (LAS f32x2*)(L + 4096);
    const f32x2* pw = WSP(f32x2, WS_PW); const f32x2* bbar = WSP(f32x2, WS_BBAR); float* ktab = WSP(float, WS_KTAB);
    constexpr int per = 4;
    const int base = (C.bx & 255) * per, g = base >> 5, d0 = base & 31;
    __syncthreads();
    for (int i = C.tid; i < 1024; i += NTHREADS) { Cr[i] = C.inp(12)[g * 1024 + i]; Ci[i] = C.inp(13)[g * 1024 + i]; Bb[i] = bbar[g * 1024 + i]; }
    for (int i = C.tid; i < per * 64; i += NTHREADS) { const int k = i >> 6, p = i & 63; Pw[i] = pw[(size_t)(g * 64 + p) * PWN + d0 + k]; }
    __syncthreads();
    const int half = C.tid >> 8, t = C.tid & 255, cp = t >> 4, c = t & 15;
#pragma unroll 1
    for (int k = half; k < per; k += 2) {
        float s = 0.f;
#pragma unroll 4
        for (int p = 0; p < NP; ++p) { const float cr = Cr[cp * 64 + p], ci = Ci[cp * 64 + p]; const f32x2 w = Pw[k * 64 + p], b = Bb[p * 16 + c];
            const float xr = cr * w.x - ci * w.y, xi = cr * w.y + ci * w.x; s += xr * b.x - xi * b.y; }
        ktab[(size_t)(base + k) * 256 + t] = s;
    }
    __syncthreads();
}
__device__ __forceinline__ void phase_prep2(const Ctx& C, int gt, int NGT) {
    const f32x2* pw = WSP(f32x2, WS_PW); const f32x2* bbar = WSP(f32x2, WS_BBAR); const float* ktab = WSP(float, WS_KTAB);
    bf16_t* bty = WSP(bf16_t, WS_BTY); bf16_t* bts1 = WSP(bf16_t, WS_BTS1);
    for (int q = gt; q < NG * K1 * (KY / 8); q += NGT) {
        const int row = q / (KY / 8), ck = q % (KY / 8), g = row >> 9, t = (row >> 4) & 31, cp = row & 15, k0 = ck * 8; float v[8];
        if (k0 < K1) { const int tau = k0 >> 4, c0 = k0 & 15;
            if (t >= tau) { const f32x4* kp = (const f32x4*)(ktab + ((size_t)((g * TCH + (t - tau)) * 16 + cp) * 16 + c0)); const f32x4 a = kp[0], b = kp[1];
                v[0] = a[0]; v[1] = a[1]; v[2] = a[2]; v[3] = a[3]; v[4] = b[0]; v[5] = b[1]; v[6] = b[2]; v[7] = b[3]; }
            else {
#pragma unroll
                for (int e = 0; e < 8; ++e) v[e] = 0.f; }
        } else { const int p0 = (k0 - K1) >> 1;
#pragma unroll
            for (int e = 0; e < 4; ++e) { const int p = p0 + e; const float cr = C.inp(12)[(g * 16 + cp) * 64 + p], ci = C.inp(13)[(g * 16 + cp) * 64 + p]; const f32x2 w = pw[(size_t)(g * 64 + p) * PWN + t + 1];
                v[2 * e] = cr * w.x - ci * w.y; v[2 * e + 1] = -(cr * w.y + ci * w.x); }
        }
        u32x4 o; o.x = cvt_pk_bf16(v[0], v[1]); o.y = cvt_pk_bf16(v[2], v[3]); o.z = cvt_pk_bf16(v[4], v[5]); o.w = cvt_pk_bf16(v[6], v[7]);
        *(u32x4*)(bty + (size_t)row * KY + k0) = o;
    }
    for (int q = gt; q < NG * 128 * (K1 / 8); q += NGT) {
        const int g = q / (128 * 64), p2 = (q >> 6) & 127, ck = q & 63, k0 = ck * 8, tau = k0 >> 4, c0 = k0 & 15, part = p2 & 1, p = p2 >> 1;
        const f32x2 w = pw[(size_t)(g * 64 + p) * PWN + (TCH - 1 - tau)]; float v[8];
#pragma unroll
        for (int e = 0; e < 8; ++e) { const f32x2 b = bbar[(g * 64 + p) * 16 + c0 + e]; v[e] = part == 0 ? (w.x * b.x - w.y * b.y) : (w.x * b.y + w.y * b.x); }
        u32x4 o; o.x = cvt_pk_bf16(v[0], v[1]); o.y = cvt_pk_bf16(v[2], v[3]); o.z = cvt_pk_bf16(v[4], v[5]); o.w = cvt_pk_bf16(v[6], v[7]);
        *(u32x4*)(bts1 + (size_t)(g * 256 + p2) * K1 + k0) = o;
    }
}
__device__ __forceinline__ void carry_task(const Ctx& C, int b, int g) {
    const f32x2* pw = WSP(f32x2, WS_PW); const float* sloc = WSP(float, WS_SLOC); bf16_t* app = WSP(bf16_t, WS_APP);
    const int p = C.lane; const f32x2 lt = pw[(size_t)(g * 64 + p) * PWN + TCH];
    float sr = 0.f, si = 0.f;
    const size_t row0 = (size_t)g * NBN + b * NCK;
#pragma unroll 1
    for (int c0 = 0; c0 < NCK; c0 += 16) {
        f32x2 l[16];
#pragma unroll
        for (int j = 0; j < 16; ++j) l[j] = *(const f32x2*)(sloc + (row0 + c0 + j) * 128 + 2 * p);
#pragma unroll
        for (int j = 0; j < 16; ++j) {
            const size_t row = row0 + c0 + j;
            *(unsigned*)(app + row * KY + K1 + 2 * p) = cvt_pk_bf16(sr, si);
            const float nr = lt.x * sr - lt.y * si + l[j].x, ni = lt.x * si + lt.y * sr + l[j].y; sr = nr; si = ni;
        }
    }
}
typedef float f32x16 __attribute__((ext_vector_type(16)));
#define MFMA32(a, b, c) __builtin_amdgcn_mfma_f32_32x32x16_bf16((a), (b), (c), 0, 0, 0)
__device__ __forceinline__ bf16x8 pack8_mfma(const f32x16& x, int s) {
    u32x4 p; p[0] = cvt_pk_bf16(x[8 * s], x[8 * s + 1]); p[1] = cvt_pk_bf16(x[8 * s + 2], x[8 * s + 3]); p[2] = cvt_pk_bf16(x[8 * s + 4], x[8 * s + 5]); p[3] = cvt_pk_bf16(x[8 * s + 6], x[8 * s + 7]);
    return __builtin_bit_cast(bf16x8, p);
}
__device__ __forceinline__ void phase_attn(const Ctx& C) {
    constexpr int KROW = 144, KSZ = 256 * KROW, VROW = 528, VSZ = 64 * VROW, V_OFF = 2 * KSZ;
    static_assert(V_OFF + 2 * VSZ <= LDS_BYTES, "attention LDS");
    const bf16_t* qkv = WSP(bf16_t, WS_QKV); bf16_t* ycat = WSP(bf16_t, WS_YCAT); const float* ssq_ssm = WSP(float, WS_SSQ) + 2 * SSQ_STRIDE;
    LAS unsigned char* lds = C.lds; const int tid = C.tid, lane = C.lane, wave = C.wave;
    for (int item = C.bx; item < BATCH * 32; item += C.G) {
        const int b = item >> 5, nb = item & 31, tok0 = b * SEQ + nb * 128; const long kbase = (long)tok0 - 128;
        __syncthreads();
#pragma unroll
        for (int i = 0; i < 8; ++i) { const int c = tid + NTHREADS * i, part = c & 7, sk = (c >> 3) & 255, kvh = c >> 11;
            if (nb > 0 || sk >= 128) { const u32x4 v = *(const u32x4*)(qkv + (size_t)(kbase + sk) * 768 + 512 + kvh * 64 + part * 8); *(LAS u32x4*)(lds + kvh * KSZ + sk * KROW + part * 16) = v; } }
#pragma unroll
        for (int i = 0; i < 4; ++i) { const int c = tid + NTHREADS * i, sp = c & 127, part = (c >> 7) & 7, kvh = c >> 10, sk = 2 * sp;
            if (nb > 0 || sk >= 128) { const bf16_t* vp = qkv + (size_t)(kbase + sk) * 768 + 640 + kvh * 64 + part * 8; const u32x4 v0 = *(const u32x4*)vp, v1 = *(const u32x4*)(vp + 768);
                LAS unsigned char* dst = lds + V_OFF + kvh * VSZ + (part * 8) * VROW + sp * 4;
#pragma unroll
                for (int e = 0; e < 4; ++e) { const unsigned a0 = v0[e], a1 = v1[e];
                    *(LAS unsigned*)(dst + (2 * e) * VROW) = (a0 & 0xffffu) | (a1 << 16); *(LAS unsigned*)(dst + (2 * e + 1) * VROW) = (a0 >> 16) | (a1 & 0xffff0000u); } } }
        __syncthreads();
        const int q0 = wave * 16, ql = lane & 15, hl = (lane >> 4) & 1, h = lane >> 5, a = q0 >> 5, qrel = (q0 & 31) + ql, l31 = lane & 31;
        const int tok = tok0 + q0 + ql;
        float ssq_acc = 0.f;
#pragma unroll 1
        for (int hp = 0; hp < 4; ++hp) {
            const int kvh = hp >> 1, head = 2 * hp + hl;
            bf16x8 qf[4];
#pragma unroll
            for (int ks = 0; ks < 4; ++ks) qf[ks] = *(const bf16x8*)(qkv + (size_t)tok * 768 + head * 64 + 16 * ks + 8 * h);
            f32x16 sc[5];
#pragma unroll
            for (int j = 0; j < 5; ++j) {
#pragma unroll
                for (int r = 0; r < 16; ++r) sc[j][r] = 0.f;
                const int st = a + j;
                if (nb > 0 || st >= 4) {
#pragma unroll
                    for (int ks = 0; ks < 4; ++ks) { const bf16x8 kf = *(const LAS bf16x8*)(lds + kvh * KSZ + (32 * st + l31) * KROW + (16 * ks + 8 * h) * 2); sc[j] = MFMA32(kf, qf[ks], sc[j]); }
                }
            }
            const float sink = C.inp(17)[head] * 1.4426950409f; float mx = sink;
#pragma unroll
            for (int j = 0; j < 5; ++j) { const bool tv = (nb > 0) || (a + j >= 4);
#pragma unroll
                for (int r = 0; r < 16; ++r) { const int cr = (r & 3) + 8 * (r >> 2) + 4 * h; bool ok = tv; if (j == 0) ok = ok && (cr > qrel); if (j == 4) ok = ok && (cr <= qrel);
                    const float t = ok ? sc[j][r] * 0.18033688011f : -1e30f; sc[j][r] = t; mx = fmaxf(mx, t); } }
            mx = fmaxf(mx, __shfl_xor(mx, 32));
            float lsum = 0.f;
#pragma unroll
            for (int j = 0; j < 5; ++j)
#pragma unroll
                for (int r = 0; r < 16; ++r) { const float p = __builtin_amdgcn_exp2f(sc[j][r] - mx); sc[j][r] = p; lsum += p; }
            lsum += __shfl_xor(lsum, 32); lsum += __builtin_amdgcn_exp2f(sink - mx);
            f32x16 o[2];
#pragma unroll
            for (int r = 0; r < 16; ++r) { o[0][r] = 0.f; o[1][r] = 0.f; }
#pragma unroll
            for (int j = 0; j < 5; ++j) { const int st = a + j;
                if (nb > 0 || st >= 4) {
#pragma unroll
                    for (int ks = 0; ks < 2; ++ks) { const bf16x8 pb = pack8_mfma(sc[j], ks);
#pragma unroll
                        for (int dt = 0; dt < 2; ++dt) { const LAS unsigned char* vp = lds + V_OFF + kvh * VSZ + (32 * dt + l31) * VROW + (32 * st + 16 * ks + 4 * h) * 2;
                            const u32x2 x0 = *(const LAS u32x2*)vp, x1 = *(const LAS u32x2*)(vp + 16); u32x4 xv; xv.x = x0.x; xv.y = x0.y; xv.z = x1.x; xv.w = x1.y;
                            o[dt] = MFMA32(__builtin_bit_cast(bf16x8, xv), pb, o[dt]); } }
                }
            }
            const float inv = __builtin_amdgcn_rcpf(lsum);
#pragma unroll
            for (int dt = 0; dt < 2; ++dt) {
                u32x2 w[4];
#pragma unroll
                for (int g4 = 0; g4 < 4; ++g4) { const float v0 = o[dt][4 * g4] * inv, v1 = o[dt][4 * g4 + 1] * inv, v2 = o[dt][4 * g4 + 2] * inv, v3 = o[dt][4 * g4 + 3] * inv;
                    ssq_acc += (v0 * v0 + v1 * v1) + (v2 * v2 + v3 * v3);
                    w[g4].x = cvt_pk_bf16(v0, v1); w[g4].y = cvt_pk_bf16(v2, v3); }
#pragma unroll
                for (int k = 0; k < 4; k += 2) {
                    const auto rx = __builtin_amdgcn_permlane32_swap(w[k].x, w[k + 1].x, false, false); const auto ry = __builtin_amdgcn_permlane32_swap(w[k].y, w[k + 1].y, false, false);
                    u32x4 q; q.x = rx[0]; q.y = ry[0]; q.z = rx[1]; q.w = ry[1];
                    *(u32x4*)(ycat + (size_t)tok * DM + 512 + head * 64 + 32 * dt + 8 * k + 8 * h) = q; }
            }
        }
        ssq_acc += __shfl_xor(ssq_acc, 16); ssq_acc += __shfl_xor(ssq_acc, 32);
        const float rs = rsqrtf(ssq_acc * (1.0f / 512.0f) + EPS) * sqrtf((ssq_ssm[(size_t)tok * 4] + ssq_ssm[(size_t)tok * 4 + 1]) * (1.0f / 512.0f) + EPS);
#pragma unroll 1
        for (int hp = 0; hp < 4; ++hp)
#pragma unroll
            for (int dt = 0; dt < 2; ++dt)
#pragma unroll
                for (int k = 0; k < 4; k += 2) { u32x4* p = (u32x4*)(ycat + (size_t)tok * DM + 512 + (2 * hp + hl) * 64 + 32 * dt + 8 * k + 8 * h); const u32x4 w0 = *p;
                    u32x4 w; w.x = cvt_pk_bf16(bf_lo(w0.x) * rs, bf_hi(w0.x) * rs); w.y = cvt_pk_bf16(bf_lo(w0.y) * rs, bf_hi(w0.y) * rs); w.z = cvt_pk_bf16(bf_lo(w0.z) * rs, bf_hi(w0.z) * rs); w.w = cvt_pk_bf16(bf_lo(w0.w) * rs, bf_hi(w0.w) * rs); *p = w; }
    }
    __syncthreads();
}

constexpr int N_PHASES = 12;
__global__ void __launch_bounds__(NTHREADS, 2) mk_fwd(const float* p0, const float* p1, const float* p2, const float* p3, const float* p4, const float* p5, const float* p6, const float* p7, const float* p8, const float* p9, const float* p10, const float* p11, const float* p12, const float* p13, const float* p14, const float* p15, const float* p16, const float* p17, const float* p18, const float* p19, const float* p20, const float* p21, const float* p22, const float* p23, const float* p24, const float* p25, float* out_p, unsigned char* ws_p, int ph_lo, int ph_hi) {
    extern __shared__ __attribute__((aligned(16))) unsigned char lds_raw[];
    Ctx C; C.in[0] = p0; C.in[1] = p1; C.in[2] = p2; C.in[3] = p3; C.in[4] = p4; C.in[5] = p5; C.in[6] = p6; C.in[7] = p7; C.in[8] = p8; C.in[9] = p9; C.in[10] = p10; C.in[11] = p11; C.in[12] = p12; C.in[13] = p13; C.in[14] = p14; C.in[15] = p15; C.in[16] = p16; C.in[17] = p17; C.in[18] = p18; C.in[19] = p19; C.in[20] = p20; C.in[21] = p21; C.in[22] = p22; C.in[23] = p23; C.in[24] = p24; C.in[25] = p25; C.out = out_p; C.ws = ws_p; C.lds = (LAS unsigned char*)lds_raw;
    C.tid = threadIdx.x; C.lane = C.tid & 63; C.wave = __builtin_amdgcn_readfirstlane(C.tid >> 6); C.G = gridDim.x; C.bx = blockIdx.x;
    const int lo = ph_lo, hi = ph_hi;
#define IN(k) (lo <= (k) && (k) < hi)
#define SEAM(k) do { if (IN(k) && IN((k) + 1)) { xcd_barrier(xbar); } } while (0)
    volatile LAS unsigned* xst = (volatile LAS unsigned*)(C.lds + LDS_BYTES - 16);
    if (C.tid == 0) { xst[0] = 0u; xst[1] = 0u; }
    __syncthreads();
    const XcdBarrier xbar = xcd_barrier_post(WSP(unsigned, WS_BAR), xst);
    float* ssq = WSP(float, WS_SSQ); LAS float* red = (LAS float*)(C.lds + RED_OFF);
    if (IN(0)) { phase_prep0(C); __syncthreads(); }
    SEAM(0);
    if (IN(1)) {
        phase_prep1(C);
        pg8::Gemm g{WSP(bf16_t, WS_XB), WSP(bf16_t, WS_WGU1), DM, DM, DM}; pg8::StaticOrder S; S.init(M_TOK, 2 * DFF, C.G, C.bx);
        EpiGateUp E{ssq, WSP(bf16_t, WS_ACT)}; pg8::gemm_phase<EpiGateUp, pg8::StaticOrder, true>(C.lds, g, S, E);
    }
    SEAM(1);
    if (IN(2)) {
        pg8::Gemm g{WSP(bf16_t, WS_ACT), WSP(bf16_t, WS_WD1), DFF, DFF, DFF}; pg8::StaticOrder S; S.init(M_TOK, DM, C.G, C.bx);
        EpiResid E{WSP(bf16_t, WS_XB), ssq + SSQ_STRIDE, 0.5f, nullptr, red}; pg8::gemm_phase<EpiResid, pg8::StaticOrder, true>(C.lds, g, S, E);
    }
    SEAM(2);
    if (IN(3)) {
        pg8::Gemm g{WSP(bf16_t, WS_XB), WSP(bf16_t, WS_WIN), DM, DM, DM}; pg8::StaticOrder S; S.init(M_TOK, DIN, C.G, C.bx);
        EpiWin E{ssq + SSQ_STRIDE, WSP(bf16_t, WS_APP), WSP(bf16_t, WS_QKV), WSP(float, WS_ROPE), WSP(float, WS_ROPE) + SEQ * 8}; pg8::gemm_phase<EpiWin, pg8::StaticOrder, true>(C.lds, g, S, E);
        if (C.G <= 128) phase_prep2(C, C.bx * NTHREADS + C.tid, C.G * NTHREADS);
        else if (C.bx >= 128) phase_prep2(C, (C.bx - 128) * NTHREADS + C.tid, (C.G - 128) * NTHREADS);
    }
    SEAM(3);
    if (IN(4)) {
        { const int it = C.bx & 255;
            const int pm = it >> 1, g = pm >> 2;
            __syncthreads();
            { pg8::Gemm g1{WSP(bf16_t, WS_APP), WSP(bf16_t, WS_BTS1), KY, K1, K1}; pg8::OneUnit S{pm, g}; EpiS1 E{WSP(float, WS_SLOC)}; pg8::gemm_phase<EpiS1, pg8::OneUnit, true, true>(C.lds, g1, S, E); }
            asm volatile("s_waitcnt vmcnt(0)" ::: "memory"); __syncthreads();
            if (C.wave < 2) carry_task(C, 2 * (pm & 3) + C.wave, g);
            if (C.wave >= 2) {
#pragma unroll 1
                for (int j = C.wave - 2; j < 18; j += 6) weights_late_item(C, it * 19 + j);
            } else if (C.wave == 0) weights_late_item(C, it * 19 + 18);
            asm volatile("s_waitcnt vmcnt(0)" ::: "memory"); __syncthreads();
            { pg8::Gemm gy{WSP(bf16_t, WS_APP), WSP(bf16_t, WS_BTY), KY, KY, KY}; pg8::OneUnit S{pm, 2 * g + (it & 1)}; EpiY E{WSP(bf16_t, WS_APP), C.inp(14), WSP(bf16_t, WS_YGELU)}; pg8::gemm_phase<EpiY, pg8::OneUnit, true>(C.lds, gy, S, E); }
        }
    }
    SEAM(4);
    if (IN(7)) {
        pg8::Gemm g{WSP(bf16_t, WS_YGELU), WSP(bf16_t, WS_WGLU), DSSM, DSSM, DSSM}; pg8::StaticOrder S; S.init(M_TOK, DSSM, C.G, C.bx);
        EpiGlu E{WSP(bf16_t, WS_YGELU), C.inp(16), WSP(bf16_t, WS_YCAT), ssq + 2 * SSQ_STRIDE, red}; pg8::gemm_phase<EpiGlu, pg8::StaticOrder, true>(C.lds, g, S, E);
    }
    SEAM(7);
    if (IN(8)) { phase_attn(C); }
    SEAM(8);
    if (IN(9)) {
        pg8::Gemm g{WSP(bf16_t, WS_YCAT), WSP(bf16_t, WS_WOUT), DM, DM, DM}; pg8::StaticOrder S; S.init(M_TOK, DM, C.G, C.bx);
        EpiResid E{WSP(bf16_t, WS_XB), ssq + 3 * SSQ_STRIDE, 1.0f, ssq + 2 * SSQ_STRIDE, red}; pg8::gemm_phase<EpiResid, pg8::StaticOrder, true>(C.lds, g, S, E);
    }
    SEAM(9);
    if (IN(10)) {
        pg8::Gemm g{WSP(bf16_t, WS_XB), WSP(bf16_t, WS_WGU2), DM, DM, DM}; pg8::StaticOrder S; S.init(M_TOK, 2 * DFF, C.G, C.bx);
        EpiGateUp E{ssq + 3 * SSQ_STRIDE, WSP(bf16_t, WS_ACT)}; pg8::gemm_phase<EpiGateUp, pg8::StaticOrder, true>(C.lds, g, S, E);
    }
    SEAM(10);
    if (IN(11)) {
        pg8::Gemm g{WSP(bf16_t, WS_ACT), WSP(bf16_t, WS_WD2), DFF, DFF, DFF}; pg8::StaticOrder S; S.init(M_TOK, DM, C.G, C.bx);
        EpiFinal E{WSP(bf16_t, WS_XB), ssq + 4 * SSQ_STRIDE, (unsigned*)(ssq + 5 * SSQ_STRIDE), C.inp(25), C.out, red}; pg8::gemm_phase<EpiFinal, pg8::StaticOrder, true>(C.lds, g, S, E);
    }
#undef IN
#undef SEAM
}

extern "C" void kernel_launch(void* const* d_in, const int* in_sizes, int n_in, void* d_out, int out_size, void* d_ws, size_t ws_size, hipStream_t stream) {
    static int grid = 0;
    if (grid == 0) {
        if (n_in != 26 || out_size != M_TOK * DM || ws_size < WS_END) { fprintf(stderr, "kernel_launch: unexpected shapes (n_in %d out %d ws %zu)\n", n_in, out_size, ws_size); grid = -1; return; }
        int dev = 0, cus = 0, per_cu = 0;
        hipGetDevice(&dev); hipDeviceGetAttribute(&cus, hipDeviceAttributeMultiprocessorCount, dev);
        if (hipFuncSetAttribute((const void*)mk_fwd, hipFuncAttributeMaxDynamicSharedMemorySize, LDS_BYTES) != hipSuccess) { fprintf(stderr, "kernel_launch: hipFuncSetAttribute failed\n"); grid = -1; return; }
        hipOccupancyMaxActiveBlocksPerMultiprocessor(&per_cu, (const void*)mk_fwd, NTHREADS, LDS_BYTES);
        if (per_cu < 1) { fprintf(stderr, "kernel_launch: occupancy query says %d blocks/CU\n", per_cu); per_cu = 1; }
        (void)hipGetLastError();
        grid = cus;
    }
    if (grid < 0) return;
    const float* ip[26]; for (int i = 0; i < 26; ++i) ip[i] = (const float*)d_in[i];
    float* outp = (float*)d_out; unsigned char* wsp = (unsigned char*)d_ws; int lo = 0, hi = N_PHASES;
    (void)hipMemsetAsync((unsigned char*)d_ws + WS_BAR, 0, XCD_BAR_WORDS * sizeof(unsigned), stream);
    void* kargs[30]; for (int i = 0; i < 26; ++i) kargs[i] = (void*)&ip[i];
    kargs[26] = (void*)&outp; kargs[27] = (void*)&wsp; kargs[28] = (void*)&lo; kargs[29] = (void*)&hi;
    hipError_t e = hipLaunchCooperativeKernel((const void*)mk_fwd, dim3(grid), dim3(NTHREADS), kargs, LDS_BYTES, stream);
    if (e != hipSuccess) fprintf(stderr, "kernel_launch: cooperative launch failed: %s (grid %d)\n", hipGetErrorString(e), grid);
}
```

```cpp
#include <hip/hip_runtime.h>
#include <hip/hip_cooperative_groups.h>
#include <cstdio>
#include <cstdint>
namespace cg = cooperative_groups;

#define LAS __attribute__((address_space(3)))
#define GAS __attribute__((address_space(1)))
typedef unsigned short bf16_t;
typedef short bf16x8 __attribute__((ext_vector_type(8)));
typedef float f32x4 __attribute__((ext_vector_type(4)));
typedef float f32x2 __attribute__((ext_vector_type(2)));
typedef unsigned u32x4 __attribute__((ext_vector_type(4)));
typedef unsigned u32x2 __attribute__((ext_vector_type(2)));

constexpr int BATCH = 8, SEQ = 4096, M_TOK = BATCH * SEQ, DM = 1024, DFF = 2816, DIN = 1280, DSSM = 512;
constexpr int NG = 32, NP = 64, NCH = 16;
constexpr int TCH = 32, NCK = SEQ / TCH, NBN = BATCH * NCK;
constexpr int K1 = TCH * NCH;
constexpr int KY = K1 + 2 * NP;
constexpr int PWN = TCH + 1;
constexpr float EPS = 1e-6f;
constexpr int NTHREADS = 512, NWAVES = 8;
constexpr int LDS_BYTES = 147456;
constexpr int RED_OFF = 131072;
constexpr size_t SSQ_STRIDE = 4 * (size_t)32768;

constexpr size_t MiB = 1024 * 1024;
constexpr size_t WS_XB = 0;
constexpr size_t WS_ACT = 64 * MiB;
constexpr size_t WS_APP = WS_ACT;
constexpr size_t WS_QKV = WS_ACT + 40 * MiB;
constexpr size_t WS_YGELU = WS_ACT + 88 * MiB;
constexpr size_t WS_SLOC = WS_ACT + 120 * MiB;
constexpr size_t WS_YCAT = 240 * MiB;
constexpr size_t WS_WGU1 = 304 * MiB, WS_WD1 = 315 * MiB, WS_WGU2 = 321 * MiB, WS_WD2 = 332 * MiB;
constexpr size_t WS_WIN = 338 * MiB, WS_WOUT = 341 * MiB, WS_WGLU = 343 * MiB;
constexpr size_t WS_BTY = 344 * MiB;
constexpr size_t WS_BTS1 = 364 * MiB;
constexpr size_t WS_PW = 372 * MiB;
constexpr size_t WS_BBAR = 373 * MiB;
constexpr size_t WS_KTAB = 374 * MiB;
constexpr size_t WS_SSQ = 380 * MiB;
constexpr size_t WS_ROPE = 377 * MiB;
constexpr size_t WS_BAR = 378 * MiB;
constexpr size_t WS_END = 384 * MiB;


typedef __bf16 bf16x2_t __attribute__((ext_vector_type(2)));
__device__ __forceinline__ unsigned cvt_pk_bf16(float lo, float hi) { const f32x2 v = {lo, hi}; return __builtin_bit_cast(unsigned, __builtin_convertvector(v, bf16x2_t)); }
__device__ __forceinline__ float bf_lo(unsigned w) { return __uint_as_float(w << 16); }
__device__ __forceinline__ float bf_hi(unsigned w) { return __uint_as_float(w & 0xffff0000u); }
__device__ __forceinline__ float bf2f(bf16_t b) { return __uint_as_float(((unsigned)b) << 16); }
__device__ __forceinline__ bf16_t f2bf(float f) { return (bf16_t)(cvt_pk_bf16(f, 0.f) & 0xffffu); }
__device__ __forceinline__ float gelu_tanh(float v) { const float z = -2.3022081198f * (v + 0.044715f * v * v * v); return v * __builtin_amdgcn_rcpf(1.0f + __builtin_amdgcn_exp2f(z)); }
__device__ __forceinline__ float sigmoidf_(float v) { return __builtin_amdgcn_rcpf(1.0f + __builtin_amdgcn_exp2f(-1.4426950409f * v)); }
__device__ __forceinline__ f32x4 bf4_lo(const u32x4 x) { return (f32x4){bf_lo(x.x), bf_hi(x.x), bf_lo(x.y), bf_hi(x.y)}; }
__device__ __forceinline__ f32x4 bf4_hi(const u32x4 x) { return (f32x4){bf_lo(x.z), bf_hi(x.z), bf_lo(x.w), bf_hi(x.w)}; }
__device__ __forceinline__ f32x4 exp2_v(const f32x4 t) { return (f32x4){__builtin_amdgcn_exp2f(t[0]), __builtin_amdgcn_exp2f(t[1]), __builtin_amdgcn_exp2f(t[2]), __builtin_amdgcn_exp2f(t[3])}; }
__device__ __forceinline__ f32x4 rcp_v(const f32x4 t) { return (f32x4){__builtin_amdgcn_rcpf(t[0]), __builtin_amdgcn_rcpf(t[1]), __builtin_amdgcn_rcpf(t[2]), __builtin_amdgcn_rcpf(t[3])}; }
__device__ __forceinline__ f32x4 sigmoid_v(const f32x4 a) { return rcp_v(exp2_v(a * -1.4426950409f) + 1.0f); }
__device__ __forceinline__ f32x4 gelu_tanh_v(const f32x4 v) { const f32x4 z = v * ((v * v) * -0.1029432397f + -2.3022081198f); return v * rcp_v(exp2_v(z) + 1.0f); }
__device__ __forceinline__ u32x4 pack8(const f32x4 a, const f32x4 b) { u32x4 w; w.x = cvt_pk_bf16(a[0], a[1]); w.y = cvt_pk_bf16(a[2], a[3]); w.z = cvt_pk_bf16(b[0], b[1]); w.w = cvt_pk_bf16(b[2], b[3]); return w; }
__device__ __forceinline__ float rs_from_ssq(float ssq, float inv_n) { return __builtin_amdgcn_rsqf(ssq * inv_n + EPS); }

namespace pg8 {
constexpr int BM = 256, BK = 64, HALF = 128, HTB = HALF * BK * 2, STAGE_BYTES = 8 * HTB, NXCD = 8, WGM = 8;
__host__ __device__ __forceinline__ int lds_byte(int r, int c) { const int st = (r >> 4) * 2 + (c >> 5), rr = r & 15, cc = c & 31, ob = rr * 64 + cc * 2; return st * 1024 + (ob ^ (((ob >> 9) & 1) << 5)); }
__host__ __device__ __forceinline__ int perm32(int rho) { const int n = rho >> 4, i = rho & 15; return 8 * (i >> 2) + 4 * n + (i & 3); }
__host__ __device__ __forceinline__ void stage_rc(int b, int& R, int& C) { const int st = b / 1024, sb = b % 1024, swz = sb ^ (((sb >> 9) & 1) << 5); R = (st >> 1) * 16 + swz / 64; C = (st & 1) * 32 + (swz % 64) / 2; }

struct Unit { int pm, pn, ka, kb, part; };
struct Gemm { const bf16_t* A; const bf16_t* Bt; int lda, ldb, K; };

struct StaticOrder {
    int nM, nN, nwg, G, c;
    __device__ void init(int M, int N, int G_, int c_) { nM = M / BM; nN = N / BM; nwg = nM * nN; G = G_; c = c_; }
    __device__ bool next(int i, Unit& u) const {
        const long L = (long)i * G + c; if (L >= nwg) return false;
        int wgid = (int)L; { const int q = nwg / NXCD, r = nwg % NXCD, xcd = wgid % NXCD, off = wgid / NXCD; wgid = (xcd < r ? xcd * (q + 1) : r * (q + 1) + (xcd - r) * q) + off; }
        const int nig = WGM * nN, gid = wgid / nig, fm = gid * WGM, gsz = (nM - fm) < WGM ? (nM - fm) : WGM;
        u.pm = fm + ((wgid % nig) % gsz); u.pn = (wgid % nig) / gsz; u.ka = 0; u.kb = 0; u.part = 0; return true;
    }
};
struct OneUnit { int pm, pn;
    __device__ bool next(int i, Unit& u) const { if (i) return false; u.pm = pm; u.pn = pn; u.ka = 0; u.kb = 0; u.part = 0; return true; } };
struct SplitOrder { StaticOrder so;
    __device__ bool next(int i, Unit& u) const { if (!so.next(i >> 1, u)) return false; u.ka = u.kb = (i & 1) * 512; u.part = (i & 1) ? 0 : 1; return true; } };

template <class Epi, class Sched, bool PERM = false, bool HALF_N = false>
__device__ __forceinline__ void gemm_phase(LAS unsigned char* lds, const Gemm g, const Sched& S, const Epi& E) {
    const int tid = threadIdx.x, wid = __builtin_amdgcn_readfirstlane(tid >> 6), lane = tid & 63, wr = wid >> 2, wc = wid & 3, fr = lane & 15, fq = lane >> 4;
    const int nt = g.K / BK;
    unsigned voffA[2], voffB[2];
#pragma unroll
    for (int i = 0; i < 2; ++i) { int R, C; stage_rc(tid * 16 + i * 8192, R, C); const int Rb = PERM ? ((R & ~31) + perm32(R & 31)) : R; voffA[i] = (unsigned)(R * g.lda + C) * 2u; voffB[i] = (unsigned)(Rb * g.ldb + C) * 2u; }
    const size_t kstep = (size_t)(BK * 2);
    const size_t hA = (size_t)HALF * g.lda * 2, hB = (size_t)HALF * g.ldb * 2, tA = 2 * hA, tB = 2 * hB;
    const unsigned ldsw = (unsigned)wid * 1024u;
    const int aoff = lds_byte(wr * 64 + fr, fq * 8), boff = lds_byte(wc * 32 + fr, fq * 8);
#define PG8_SA(b, h) (((b) * 2 + (h)) * HTB)
#define PG8_SB(b, h) ((4 + (b) * 2 + (h)) * HTB)
#define PG8_STAGE(bufoff, gbase, voff) do { _Pragma("unroll") for (int _i = 0; _i < 2; ++_i) \
        __builtin_amdgcn_global_load_lds((const unsigned*)((const char*)(gbase) + (voff)[_i]), (LAS unsigned*)(lds + (bufoff) + ldsw + _i * 8192), 16, 0, 0); } while (0)
#define PG8_LDA(dst, b, h) do { _Pragma("unroll") for (int m = 0; m < 4; ++m) _Pragma("unroll") for (int k = 0; k < 2; ++k) dst[m][k] = *(const LAS bf16x8*)(lds + PG8_SA(b, h) + aoff + m * 2048 + k * 1024); } while (0)
#define PG8_LDB(dst, b, h) do { _Pragma("unroll") for (int n = 0; n < 2; ++n) _Pragma("unroll") for (int k = 0; k < 2; ++k) dst[n][k] = *(const LAS bf16x8*)(lds + PG8_SB(b, h) + boff + n * 2048 + k * 1024); } while (0)
#define PG8_MMA(ai, bj, At, Bt) do { __builtin_amdgcn_s_setprio(1); _Pragma("unroll") for (int m = 0; m < 4; ++m) _Pragma("unroll") for (int n = 0; n < 2; ++n) _Pragma("unroll") for (int k = 0; k < 2; ++k) \
        acc[ai][bj][m][n] = __builtin_amdgcn_mfma_f32_16x16x32_bf16(Bt[n][k], At[m][k], acc[ai][bj][m][n], 0, 0, 0); __builtin_amdgcn_s_setprio(0); } while (0)
#define PG8_WAIT_V(n) asm volatile("s_waitcnt vmcnt(" #n ")" ::: "memory")
#define PG8_WAIT_L(n) asm volatile("s_waitcnt lgkmcnt(" #n ")" ::: "memory")
#define PG8_BAR __builtin_amdgcn_s_barrier()
#define PG8_SCHED __builtin_amdgcn_sched_barrier(0)
    Unit cur, nxt; int ui = 0;
    if (!S.next(0, cur)) return;
    f32x4 acc[2][2][4][2];
#pragma unroll
    for (int a = 0; a < 2; ++a)
#pragma unroll
        for (int b = 0; b < 2; ++b)
#pragma unroll
            for (int m = 0; m < 4; ++m)
#pragma unroll
                for (int n = 0; n < 2; ++n) acc[a][b][m][n] = (f32x4){0.f, 0.f, 0.f, 0.f};
    bf16x8 At[4][2], B0[2][2], B1[2][2];
    const char* cA = (const char*)g.A + (size_t)cur.pm * tA + (size_t)cur.ka * 2; const char* cB = (const char*)g.Bt + (size_t)cur.pn * tB + (size_t)cur.kb * 2;
    PG8_STAGE(PG8_SB(0, 0), cB, voffB); PG8_STAGE(PG8_SB(0, 1), cB + hB, voffB); PG8_STAGE(PG8_SA(0, 0), cA, voffA); PG8_STAGE(PG8_SA(0, 1), cA + hA, voffA);
    if (wr == 1) PG8_BAR;
    PG8_WAIT_V(2); PG8_BAR;
    PG8_STAGE(PG8_SB(1, 0), cB + kstep, voffB); PG8_STAGE(PG8_SA(1, 0), cA + kstep, voffA); PG8_STAGE(PG8_SB(1, 1), cB + hB + kstep, voffB);
    PG8_WAIT_V(6); PG8_BAR;
    for (;;) {
        const bool has_next = S.next(ui + 1, nxt);
        const char* nA = has_next ? (const char*)g.A + (size_t)nxt.pm * tA + (size_t)nxt.ka * 2 : cA; const char* nB = has_next ? (const char*)g.Bt + (size_t)nxt.pn * tB + (size_t)nxt.kb * 2 : cB;
        for (int t = 0; t < nt; t += 2) {
            const bool last = (t == nt - 2);
            const char* a1 = cA + (size_t)(t + 1) * kstep;
            const char* a2 = last ? nA : cA + (size_t)(t + 2) * kstep; const char* b2 = last ? nB : cB + (size_t)(t + 2) * kstep;
            const char* a3 = a2 + kstep; const char* b3 = b2 + kstep;
            PG8_LDB(B0, 0, 0); if constexpr (!HALF_N) PG8_LDB(B1, 0, 1); PG8_SCHED; PG8_LDA(At, 0, 0); PG8_STAGE(PG8_SA(1, 1), a1 + hA, voffA);
            PG8_WAIT_V(8); PG8_WAIT_L(0); PG8_BAR; PG8_MMA(0, 0, At, B0); if constexpr (!HALF_N) PG8_MMA(0, 1, At, B1); PG8_BAR; PG8_SCHED;
            PG8_LDA(At, 0, 1); PG8_STAGE(PG8_SB(0, 0), b2, voffB); PG8_STAGE(PG8_SB(0, 1), b2 + hB, voffB); PG8_STAGE(PG8_SA(0, 0), a2, voffA);
            PG8_WAIT_V(8); PG8_WAIT_L(0); PG8_BAR; PG8_MMA(1, 0, At, B0); if constexpr (!HALF_N) PG8_MMA(1, 1, At, B1); PG8_BAR; PG8_SCHED;
            PG8_LDB(B0, 1, 0); if constexpr (!HALF_N) PG8_LDB(B1, 1, 1); PG8_SCHED; PG8_LDA(At, 1, 0); PG8_STAGE(PG8_SA(0, 1), a2 + hA, voffA);
            PG8_WAIT_V(8); PG8_WAIT_L(0); PG8_BAR; PG8_MMA(0, 0, At, B0); if constexpr (!HALF_N) PG8_MMA(0, 1, At, B1); PG8_BAR; PG8_SCHED;
            PG8_LDA(At, 1, 1); PG8_STAGE(PG8_SB(1, 0), b3, voffB); PG8_STAGE(PG8_SB(1, 1), b3 + hB, voffB); PG8_STAGE(PG8_SA(1, 0), a3, voffA);
            PG8_WAIT_V(8); PG8_WAIT_L(0); PG8_BAR; PG8_MMA(1, 0, At, B0); if constexpr (!HALF_N) PG8_MMA(1, 1, At, B1); PG8_BAR; PG8_SCHED;
        }
        if (wr == 0) PG8_BAR;
        if (cur.part) { E.mid(acc, cur, wr, wc, fr, fq); }
        else {
            E(acc, cur, wr, wc, fr, fq);
            if (has_next) {
#pragma unroll
                for (int a = 0; a < 2; ++a)
#pragma unroll
                    for (int b = 0; b < 2; ++b)
#pragma unroll
                        for (int m = 0; m < 4; ++m)
#pragma unroll
                            for (int n = 0; n < 2; ++n) acc[a][b][m][n] = (f32x4){0.f, 0.f, 0.f, 0.f};
            }
        }
        if (!has_next) break;
        cur = nxt; cA = nA; cB = nB; ++ui;
        if (wr == 1) PG8_BAR;
    }
    PG8_WAIT_V(0);
    PG8_BAR;
#undef PG8_SA
#undef PG8_SB
#undef PG8_STAGE
#undef PG8_LDA
#undef PG8_LDB
#undef PG8_MMA
#undef PG8_WAIT_V
#undef PG8_WAIT_L
#undef PG8_BAR
#undef PG8_SCHED
}
}
using pg8::Unit; using pg8::HALF; using pg8::BM;

typedef f32x4 AccT[2][2][4][2];

__device__ __forceinline__ void red_put(LAS float* red, int ai, int wr, int m, int fr, int wc, int fq, float s) { if (fq == 0) red[(ai * HALF + wr * 64 + m * 16 + fr) * 4 + wc] = s; }
template <bool WT>
__device__ __forceinline__ void red_flush(LAS float* red, float* part, const Unit& u) {
    asm volatile("s_waitcnt lgkmcnt(0)" ::: "memory"); __builtin_amdgcn_s_barrier(); asm volatile("" ::: "memory");
    const int t = threadIdx.x;
    if (t < 256) { const f32x4 v = *(const LAS f32x4*)(red + t * 4); const float sum = (v[0] + v[1]) + (v[2] + v[3]); float* p = part + (size_t)(u.pm * BM + t) * 4 + u.pn;
        if (WT) __hip_atomic_store(p, sum, __ATOMIC_RELAXED, __HIP_MEMORY_SCOPE_AGENT); else *p = sum; }
}
__device__ __forceinline__ float sum4(const f32x4 v) { return (v[0] + v[1]) + (v[2] + v[3]); }
struct EpiGateUp {
    const float* ssq; bf16_t* act;
    __device__ __forceinline__ void mid(AccT&, const Unit&, int, int, int, int) const {}
    __device__ __forceinline__ void operator()(const AccT& acc, const Unit& u, int wr, int wc, int fr, int fq) const {
        const int row0 = u.pm * BM + wr * 64 + fr, col0 = u.pn * 128 + wc * 32 + 8 * fq;
        float rsv[2][4];
#pragma unroll
        for (int ai = 0; ai < 2; ++ai)
#pragma unroll
            for (int m = 0; m < 4; ++m) rsv[ai][m] = sum4(*(const f32x4*)(ssq + (size_t)(row0 + ai * HALF + m * 16) * 4));
#pragma unroll
        for (int ai = 0; ai < 2; ++ai)
#pragma unroll
            for (int m = 0; m < 4; ++m) {
                const int row = row0 + ai * HALF + m * 16; const float rs = rs_from_ssq(rsv[ai][m], 1.0f / DM), rs2 = rs * rs, nl = -1.4426950409f * rs;
                f32x4 a[2];
#pragma unroll
                for (int n = 0; n < 2; ++n) { const f32x4 ga = acc[ai][0][m][n], ua = acc[ai][1][m][n]; const f32x4 pr = (ga * ua) * rs2, tt = ga * nl; f32x4 e;
#pragma unroll
                    for (int j = 0; j < 4; ++j) e[j] = __builtin_amdgcn_exp2f(tt[j]);
                    e = e + 1.0f; f32x4 r;
#pragma unroll
                    for (int j = 0; j < 4; ++j) r[j] = __builtin_amdgcn_rcpf(e[j]);
                    a[n] = pr * r; }
                u32x4 w; w.x = cvt_pk_bf16(a[0][0], a[0][1]); w.y = cvt_pk_bf16(a[0][2], a[0][3]); w.z = cvt_pk_bf16(a[1][0], a[1][1]); w.w = cvt_pk_bf16(a[1][2], a[1][3]);
                *(u32x4*)(act + (size_t)row * DFF + col0) = w;
            }
    }
};
struct EpiResid {
    bf16_t* xb; float* ssq_out; float scale; const float* ssq_row; LAS float* red;
    __device__ __forceinline__ void mid(AccT&, const Unit&, int, int, int, int) const {}
    __device__ __forceinline__ void operator()(const AccT& acc, const Unit& u, int wr, int wc, int fr, int fq) const {
        const int row0 = u.pm * BM + wr * 64 + fr, col0 = u.pn * BM + wc * 32 + 8 * fq;
        float scv[2][4];
#pragma unroll
        for (int ai = 0; ai < 2; ++ai)
#pragma unroll
            for (int m = 0; m < 4; ++m) { f32x2 t = (f32x2){0.f, 0.f}; if (ssq_row) t = *(const f32x2*)(ssq_row + (size_t)(row0 + ai * HALF + m * 16) * 4); scv[ai][m] = t[0] + t[1]; }
#pragma unroll
        for (int ai = 0; ai < 2; ++ai) {
            u32x4 xi[4][2];
#pragma unroll
            for (int m = 0; m < 4; ++m)
#pragma unroll
                for (int bj = 0; bj < 2; ++bj) xi[m][bj] = *(const u32x4*)(xb + (size_t)(row0 + ai * HALF + m * 16) * DM + col0 + bj * HALF);
#pragma unroll
            for (int m = 0; m < 4; ++m) {
                const int row = row0 + ai * HALF + m * 16; const size_t off = (size_t)row * DM + col0; float s = 0.f;
                const float sc = ssq_row ? scale * rs_from_ssq(scv[ai][m], 1.0f / DSSM) : scale;
#pragma unroll
                for (int bj = 0; bj < 2; ++bj) { const u32x4 x = xi[m][bj]; const f32x4 o0 = bf4_lo(x) + acc[ai][bj][m][0] * sc, o1 = bf4_hi(x) + acc[ai][bj][m][1] * sc;
                    const f32x4 q = o0 * o0 + o1 * o1; s += (q[0] + q[1]) + (q[2] + q[3]);
                    *(u32x4*)(xb + off + bj * HALF) = pack8(o0, o1); }
                s += __shfl_xor(s, 16); s += __shfl_xor(s, 32);
                red_put(red, ai, wr, m, fr, wc, fq, s);
            }
        }
        red_flush<false>(red, ssq_out, u);
    }
};
struct EpiFinal {
    const bf16_t* xb; float* ssq_out; unsigned* cnt; const float* gn; float* out; LAS float* red;
    __device__ __forceinline__ void mid(AccT&, const Unit&, int, int, int, int) const {}
    __device__ __forceinline__ void operator()(const AccT& acc, const Unit& u, int wr, int wc, int fr, int fq) const {
        const int row0 = u.pm * BM + wr * 64 + fr, col0 = u.pn * BM + wc * 32 + 8 * fq;
#pragma unroll
        for (int ai = 0; ai < 2; ++ai) {
            u32x4 xi[4][2];
#pragma unroll
            for (int m = 0; m < 4; ++m)
#pragma unroll
                for (int bj = 0; bj < 2; ++bj) xi[m][bj] = *(const u32x4*)(xb + (size_t)(row0 + ai * HALF + m * 16) * DM + col0 + bj * HALF);
#pragma unroll
            for (int m = 0; m < 4; ++m) { float s = 0.f;
#pragma unroll
                for (int bj = 0; bj < 2; ++bj) { const u32x4 x = xi[m][bj]; const f32x4 o0 = bf4_lo(x) + acc[ai][bj][m][0] * 0.5f, o1 = bf4_hi(x) + acc[ai][bj][m][1] * 0.5f;
                    const f32x4 q = o0 * o0 + o1 * o1; s += (q[0] + q[1]) + (q[2] + q[3]); }
                s += __shfl_xor(s, 16); s += __shfl_xor(s, 32);
                red_put(red, ai, wr, m, fr, wc, fq, s);
            }
        }
        red_flush<true>(red, ssq_out, u);
        asm volatile("s_waitcnt vmcnt(0)" ::: "memory");
        unsigned* cw = cnt + 64 * u.pm;
        if ((threadIdx.x & 63) == 0 && threadIdx.x < 256) __hip_atomic_fetch_add(cw, 1u, __ATOMIC_RELAXED, __HIP_MEMORY_SCOPE_AGENT);
        { unsigned sp = 0;
          while ((unsigned)__builtin_amdgcn_readfirstlane(__hip_atomic_load(cw, __ATOMIC_RELAXED, __HIP_MEMORY_SCOPE_AGENT)) < 16u) { __builtin_amdgcn_s_sleep(2); if (++sp > (1u << 20)) break; } }
        __builtin_amdgcn_fence(__ATOMIC_ACQUIRE, "agent");
        f32x4 gv[2][2];
#pragma unroll
        for (int bj = 0; bj < 2; ++bj)
#pragma unroll
            for (int n = 0; n < 2; ++n) gv[bj][n] = *(const f32x4*)(gn + col0 + bj * HALF + n * 4);
#pragma unroll
        for (int ai = 0; ai < 2; ++ai) {
            u32x4 xi[4][2]; float sq[4];
#pragma unroll
            for (int m = 0; m < 4; ++m) { const float* pp = ssq_out + (size_t)(row0 + ai * HALF + m * 16) * 4;
                sq[m] = (__hip_atomic_load(pp, __ATOMIC_RELAXED, __HIP_MEMORY_SCOPE_AGENT) + __hip_atomic_load(pp + 1, __ATOMIC_RELAXED, __HIP_MEMORY_SCOPE_AGENT)) + (__hip_atomic_load(pp + 2, __ATOMIC_RELAXED, __HIP_MEMORY_SCOPE_AGENT) + __hip_atomic_load(pp + 3, __ATOMIC_RELAXED, __HIP_MEMORY_SCOPE_AGENT));
#pragma unroll
                for (int bj = 0; bj < 2; ++bj) xi[m][bj] = *(const u32x4*)(xb + (size_t)(row0 + ai * HALF + m * 16) * DM + col0 + bj * HALF); }
#pragma unroll
            for (int m = 0; m < 4; ++m) { const float rs = rs_from_ssq(sq[m], 1.0f / DM); float* orow = out + (size_t)(row0 + ai * HALF + m * 16) * DM + col0;
#pragma unroll
                for (int bj = 0; bj < 2; ++bj) { const u32x4 x = xi[m][bj];
                    *(f32x4*)(orow + bj * HALF) = (bf4_lo(x) + acc[ai][bj][m][0] * 0.5f) * (gv[bj][0] * rs); *(f32x4*)(orow + bj * HALF + 4) = (bf4_hi(x) + acc[ai][bj][m][1] * 0.5f) * (gv[bj][1] * rs); }
            }
        }
    }
};
struct EpiWin {
    const float* ssq; bf16_t* app; bf16_t* qkv; const float* ropec; const float* ropes;
    __device__ __forceinline__ void mid(AccT&, const Unit&, int, int, int, int) const {}
    __device__ __forceinline__ void operator()(const AccT& acc, const Unit& u, int wr, int wc, int fr, int fq) const {
        const int row0 = u.pm * BM + wr * 64 + fr;
        const bool rope_w = (u.pn >= 2) && ((wc & 1) == 0);
        float rsv[2][4];
#pragma unroll
        for (int ai = 0; ai < 2; ++ai)
#pragma unroll
            for (int m = 0; m < 4; ++m) rsv[ai][m] = sum4(*(const f32x4*)(ssq + (size_t)(row0 + ai * HALF + m * 16) * 4));
#pragma unroll
        for (int ai = 0; ai < 2; ++ai)
#pragma unroll
            for (int mh = 0; mh < 2; ++mh) {
                f32x4 csv[2][2], snv[2][2];
                if (rope_w) {
#pragma unroll
                    for (int mm = 0; mm < 2; ++mm) { const int pos = (row0 + ai * HALF + (2 * mh + mm) * 16) & (SEQ - 1);
#pragma unroll
                        for (int n = 0; n < 2; ++n) { csv[mm][n] = *(const f32x4*)(ropec + pos * 8 + 4 * n); snv[mm][n] = *(const f32x4*)(ropes + pos * 8 + 4 * n); } }
                } else {
#pragma unroll
                    for (int mm = 0; mm < 2; ++mm)
#pragma unroll
                        for (int n = 0; n < 2; ++n) { csv[mm][n] = (f32x4){1.f, 1.f, 1.f, 1.f}; snv[mm][n] = (f32x4){0.f, 0.f, 0.f, 0.f}; }
                }
#pragma unroll
                for (int mm = 0; mm < 2; ++mm) {
                    const int m = 2 * mh + mm, row = row0 + ai * HALF + m * 16; const float rs = rs_from_ssq(rsv[ai][m], 1.0f / DM);
#pragma unroll
                    for (int bj = 0; bj < 2; ++bj) {
                        const int col = u.pn * BM + bj * HALF + wc * 32 + 8 * fq; f32x4 v0 = acc[ai][bj][m][0] * rs, v1 = acc[ai][bj][m][1] * rs;
                        bf16_t* p;
                        if (u.pn < 2) { const int g = col >> 4, c = col & 15; p = app + ((size_t)(g * NBN + (row >> 5)) * KY + (row & 31) * NCH + c); }
                        else {
                            const bool is_v = (u.pn == 4 && bj == 1);
                            if (!is_v && rope_w) {
                                f32x4 p0, p1;
#pragma unroll
                                for (int j = 0; j < 4; ++j) { p0[j] = __shfl_xor(v0[j], 16); p1[j] = __shfl_xor(v1[j], 16); }
                                if (fq == 0) { v0 = v0 * csv[mm][0] - p0 * snv[mm][0]; v1 = v1 * csv[mm][1] - p1 * snv[mm][1]; }
                                else if (fq == 1) { v0 = v0 * csv[mm][0] + p0 * snv[mm][0]; v1 = v1 * csv[mm][1] + p1 * snv[mm][1]; }
                            }
                            p = qkv + (size_t)row * 768 + (col - 512);
                        }
                        u32x4 w; w.x = cvt_pk_bf16(v0[0], v0[1]); w.y = cvt_pk_bf16(v0[2], v0[3]); w.z = cvt_pk_bf16(v1[0], v1[1]); w.w = cvt_pk_bf16(v1[2], v1[3]); *(u32x4*)p = w;
                    }
                }
            }
    }
};
struct EpiS1 {
    float* sloc;
    __device__ __forceinline__ void mid(AccT&, const Unit&, int, int, int, int) const {}
    __device__ __forceinline__ void operator()(const AccT& acc, const Unit& u, int wr, int wc, int fr, int fq) const {
        const int row0 = u.pm * BM + wr * 64 + fr, col0 = wc * 32 + 8 * fq;
#pragma unroll
        for (int ai = 0; ai < 2; ++ai)
#pragma unroll
            for (int m = 0; m < 4; ++m) { float* rowp = sloc + (size_t)(row0 + ai * HALF + m * 16) * 128 + col0;
#pragma unroll
                for (int n = 0; n < 2; ++n) *(f32x4*)(rowp + n * 4) = acc[ai][0][m][n]; }
    }
};
struct EpiY {
    const bf16_t* app; const float* Dv; bf16_t* ygelu;
    __device__ __forceinline__ void mid(AccT&, const Unit&, int, int, int, int) const {}
    __device__ __forceinline__ void operator()(const AccT& acc, const Unit& u, int wr, int wc, int fr, int fq) const {
        const int row0 = u.pm * BM + wr * 64 + fr, g = u.pm >> 2, colb = (u.pn & 1) * BM + wc * 32 + 8 * fq, c0 = 8 * (fq & 1);
        const f32x4 d0 = *(const f32x4*)(Dv + g * NCH + c0), d1 = *(const f32x4*)(Dv + g * NCH + c0 + 4);
#pragma unroll
        for (int ai = 0; ai < 2; ++ai) {
            u32x4 uw[4][2];
#pragma unroll
            for (int m = 0; m < 4; ++m)
#pragma unroll
                for (int bj = 0; bj < 2; ++bj) uw[m][bj] = *(const u32x4*)(app + (size_t)(row0 + ai * HALF + m * 16) * KY + colb + bj * HALF);
#pragma unroll
            for (int m = 0; m < 4; ++m) {
                const int row = row0 + ai * HALF + m * 16, nidx = row & (NBN - 1);
#pragma unroll
                for (int bj = 0; bj < 2; ++bj) {
                    const int colg = colb + bj * HALF, t = colg >> 4; const u32x4 w0 = uw[m][bj];
                    const f32x4 y0 = gelu_tanh_v(acc[ai][bj][m][0] + d0 * bf4_lo(w0)), y1 = gelu_tanh_v(acc[ai][bj][m][1] + d1 * bf4_hi(w0));
                    *(u32x4*)(ygelu + (size_t)(nidx * TCH + t) * DSSM + g * NCH + c0) = pack8(y0, y1);
                }
            }
        }
    }
};
struct EpiGlu {
    const bf16_t* ygelu; const float* bias; bf16_t* ycat; float* ssq_out; LAS float* red; unsigned* cnt;
    __device__ __forceinline__ void mid(AccT&, const Unit&, int, int, int, int) const {}
    __device__ __forceinline__ void operator()(const AccT& acc, const Unit& u, int wr, int wc, int fr, int fq) const {
        const int row0 = u.pm * BM + wr * 64 + fr, col0 = u.pn * BM + wc * 32 + 8 * fq;
        f32x4 bv[2][2];
#pragma unroll
        for (int bj = 0; bj < 2; ++bj)
#pragma unroll
            for (int n = 0; n < 2; ++n) bv[bj][n] = *(const f32x4*)(bias + col0 + bj * HALF + n * 4);
#pragma unroll
        for (int ai = 0; ai < 2; ++ai) {
            u32x4 yv[4][2];
#pragma unroll
            for (int m = 0; m < 4; ++m)
#pragma unroll
                for (int bj = 0; bj < 2; ++bj) yv[m][bj] = *(const u32x4*)(ygelu + (size_t)(row0 + ai * HALF + m * 16) * DSSM + col0 + bj * HALF);
#pragma unroll
            for (int m = 0; m < 4; ++m) {
                const int row = row0 + ai * HALF + m * 16; float s = 0.f;
#pragma unroll
                for (int bj = 0; bj < 2; ++bj) { const u32x4 yw = yv[m][bj];
                    const f32x4 z0 = bf4_lo(yw) * sigmoid_v(acc[ai][bj][m][0] + bv[bj][0]), z1 = bf4_hi(yw) * sigmoid_v(acc[ai][bj][m][1] + bv[bj][1]);
                    const f32x4 q = z0 * z0 + z1 * z1; s += (q[0] + q[1]) + (q[2] + q[3]);
                    *(u32x4*)(ycat + (size_t)row * DM + col0 + bj * HALF) = pack8(z0, z1); }
                s += __shfl_xor(s, 16); s += __shfl_xor(s, 32);
                red_put(red, ai, wr, m, fr, wc, fq, s);
            }
        }
        red_flush<true>(red, ssq_out, u);
        asm volatile("s_waitcnt vmcnt(0)" ::: "memory");
        if ((threadIdx.x & 63) == 0 && threadIdx.x < 256) __hip_atomic_fetch_add(cnt + 64 * u.pm, 1u, __ATOMIC_RELAXED, __HIP_MEMORY_SCOPE_AGENT);
    }
};

#define XB_TMO      128
#define XB_XCNT(j)  (256  + 64 * (j))
#define XB_XSUB(j)  (1280 + 64 * (j))
#define XB_XGEN(j)  (2304 + 64 * (j))
#define XB_TOP      3328
#define XB_TOPGEN   3392
#define XCD_BAR_WORDS 3456
#define XB_SPIN_CAP (1u << 18)
__device__ __forceinline__ unsigned xb_ld(unsigned* p)              { return __hip_atomic_load(p, __ATOMIC_RELAXED, __HIP_MEMORY_SCOPE_AGENT); }
__device__ __forceinline__ unsigned xb_add(unsigned* p, unsigned v) { return __hip_atomic_fetch_add(p, v, __ATOMIC_RELAXED, __HIP_MEMORY_SCOPE_AGENT); }
__device__ __forceinline__ unsigned xb_xcc_id() { return (unsigned)__builtin_amdgcn_s_getreg((3 << 11) | 20) & 0xFu; }
#define XB_SPIN(cond, bar) do { unsigned _sp = 0; while (cond) { __builtin_amdgcn_s_sleep(1); \
    if ((++_sp & 255u) == 0u) { if (xb_ld(&(bar)[XB_TMO])) break; if (_sp > XB_SPIN_CAP) { atomicAdd(&(bar)[XB_TMO], 1u); break; } } } } while (0)
struct XcdBarrier { unsigned* bar; unsigned x; volatile LAS unsigned* st; };
__device__ __forceinline__ XcdBarrier xcd_barrier_post(unsigned* bar, volatile LAS unsigned* st) {
    XcdBarrier b; b.bar = bar; b.x = xb_xcc_id(); b.st = st;
    if (threadIdx.x == 0) (void)xb_add(&bar[XB_XCNT(b.x)], 1u);
    return b;
}
__device__ __forceinline__ void xcd_barrier_complete(unsigned* bar, unsigned x, unsigned& nloc, unsigned& nx) {
    const unsigned G = gridDim.x * gridDim.y * gridDim.z;
    unsigned sum, cnt, mine, sp = 0u;
    for (;;) {
        sum = 0u; cnt = 0u; mine = 0u;
#pragma unroll
        for (unsigned j = 0; j < 16; ++j) { const unsigned c = xb_ld(&bar[XB_XCNT(j)]); sum += c; cnt += (c > 0u) ? 1u : 0u; mine = (j == x) ? c : mine; }
        if (sum == G) break;
        __builtin_amdgcn_s_sleep(1);
        if ((++sp & 255u) == 0u) { if (xb_ld(&bar[XB_TMO])) break; if (sp > XB_SPIN_CAP) { atomicAdd(&bar[XB_TMO], 1u); break; } }
    }
    nloc = mine > 0u ? mine : 1u; nx = cnt > 0u ? cnt : 1u;
}
__device__ __forceinline__ void xcd_barrier(const XcdBarrier& b) {
    asm volatile("s_waitcnt vmcnt(0)" ::: "memory");
    __syncthreads();
    if (threadIdx.x == 0) {
        unsigned* bar = b.bar;
        __builtin_amdgcn_s_waitcnt(0);
        unsigned nloc = b.st[0], nx = b.st[1];
        if (nloc == 0u) { xcd_barrier_complete(bar, b.x, nloc, nx); b.st[0] = nloc; b.st[1] = nx; }
        const unsigned old = xb_add(&bar[XB_XSUB(b.x)], 1u);
        const unsigned gen = old / nloc;
        if (old + 1u == (gen + 1u) * nloc) {
            __builtin_amdgcn_fence(__ATOMIC_RELEASE, "agent");
            asm volatile("s_waitcnt vmcnt(0)" ::: "memory");
            const unsigned og = xb_add(&bar[XB_TOP], 1u);
            const unsigned tg = og / nx;
            if (og + 1u == (tg + 1u) * nx) xb_add(&bar[XB_TOPGEN], 1u);
            else XB_SPIN(xb_ld(&bar[XB_TOPGEN]) == tg, bar);
            __builtin_amdgcn_fence(__ATOMIC_ACQUIRE, "agent");
            xb_add(&bar[XB_XGEN(b.x)], 1u);
            asm volatile("s_waitcnt vmcnt(0)" ::: "memory");
        } else {
            XB_SPIN(xb_ld(&bar[XB_XGEN(b.x)]) == gen, bar);
            __builtin_amdgcn_fence(__ATOMIC_ACQUIRE, "agent");
            asm volatile("s_waitcnt vmcnt(0)" ::: "memory");
        }
    }
    __syncthreads();
}

struct Ctx {
    const float* in[26]; float* out; unsigned char* ws; LAS unsigned char* lds; int tid, lane, wave, G, bx;
    __device__ __forceinline__ const float* inp(int i) const { return in[i]; }
};
#define WSP(T, off) ((T*)(C.ws + (off)))

__device__ __forceinline__ void transpose_item(const float* W, int K, int N, bf16_t* WT, const float* g0, const float* g1, int ksplit, int mode, LAS float* scr, int item, int lane) {
    const int nblk = N / 32, kb = item / nblk, nb = item % nblk, k0 = 64 * kb, n0 = 32 * nb;
#pragma unroll
    for (int i = 0; i < 8; ++i) { const int kk = 8 * i + (lane >> 3), k = k0 + kk, n4 = (lane & 7) * 4; const float gs = g0 ? (k < ksplit ? g0[k] : g1[k - ksplit]) : 1.0f;
        const f32x4 v = __builtin_nontemporal_load((const f32x4*)(W + (size_t)k * N + n0 + n4)); LAS float* d = scr + kk * 33 + n4; d[0] = v[0] * gs; d[1] = v[1] * gs; d[2] = v[2] * gs; d[3] = v[3] * gs; }
    asm volatile("s_waitcnt lgkmcnt(0)" ::: "memory");
    const int c = lane & 7;
#pragma unroll
    for (int j = 0; j < 4; ++j) { const int n = (lane >> 3) + 8 * j, ncol = n0 + n; const LAS float* s = scr + (8 * c) * 33 + n;
        const int drow = (mode == 0) ? ncol : (((ncol >> 7) << 8) + (ncol & 127) + (mode == 2 ? 128 : 0));
        u32x4 o; o.x = cvt_pk_bf16(s[0 * 33], s[1 * 33]); o.y = cvt_pk_bf16(s[2 * 33], s[3 * 33]); o.z = cvt_pk_bf16(s[4 * 33], s[5 * 33]); o.w = cvt_pk_bf16(s[6 * 33], s[7 * 33]);
        *(u32x4*)(WT + (size_t)drow * K + k0 + 8 * c) = o; }
    asm volatile("s_waitcnt lgkmcnt(0)" ::: "memory");
}

__device__ __forceinline__ float wave_sum(float v) {
#pragma unroll
    for (int o = 1; o < 64; o <<= 1) v += __shfl_xor(v, o);
    return v;
}

__device__ __forceinline__ void phase_prep0(const Ctx& C) {
    const int gw = C.wave * C.G + C.bx, NGW = C.G * NWAVES;
    const int gt = C.bx * NTHREADS + C.tid, NGT = C.G * NTHREADS;
    float* ssq = WSP(float, WS_SSQ);
    {
        const float* x = C.inp(0); bf16_t* xb = WSP(bf16_t, WS_XB);
        for (int row = gw; row < M_TOK; row += NGW) {
            const f32x4* xr = (const f32x4*)(x + (size_t)row * DM) + C.lane; f32x4 v[4]; float s = 0.f;
#pragma unroll
            for (int j = 0; j < 4; ++j) { v[j] = __builtin_nontemporal_load(xr + 64 * j); s += (v[j][0] * v[j][0] + v[j][1] * v[j][1]) + (v[j][2] * v[j][2] + v[j][3] * v[j][3]); }
            s = wave_sum(s);
            u32x2* o8 = (u32x2*)(xb + (size_t)row * DM) + C.lane;
#pragma unroll
            for (int j = 0; j < 4; ++j) { u32x2 w; w.x = cvt_pk_bf16(v[j][0], v[j][1]); w.y = cvt_pk_bf16(v[j][2], v[j][3]); o8[64 * j] = w; }
            if (C.lane == 0) *(f32x4*)(ssq + (size_t)row * 4) = (f32x4){s, 0.f, 0.f, 0.f};
        }
    }
    for (int i = gt; i < 2 * 128 * 64; i += NGT) ssq[5 * SSQ_STRIDE + i] = 0.f;
    {
        LAS float* scr = (LAS float*)(C.lds + C.wave * 16384);
        constexpr int I_GU = (DM / 64) * (DFF / 32), I_DN = (DFF / 64) * (DM / 32), I_IN = (DM / 64) * (DIN / 32), I_OUT = (DM / 64) * (DM / 32), I_GLU = (DSSM / 64) * (DSSM / 32);
        constexpr int NITEMS = 2 * I_GU + I_DN + I_IN;
        for (int it = gw; it < NITEMS; it += NGW) {
            int r = it;
            if (r < I_GU) { transpose_item(C.inp(2), DM, DFF, WSP(bf16_t, WS_WGU1), C.inp(1), C.inp(1), DM, 1, scr, r, C.lane); continue; } r -= I_GU;
            if (r < I_GU) { transpose_item(C.inp(3), DM, DFF, WSP(bf16_t, WS_WGU1), C.inp(1), C.inp(1), DM, 2, scr, r, C.lane); continue; } r -= I_GU;
            if (r < I_DN) { transpose_item(C.inp(4), DFF, DM, WSP(bf16_t, WS_WD1), nullptr, nullptr, 0, 0, scr, r, C.lane); continue; } r -= I_DN;
            transpose_item(C.inp(6), DM, DIN, WSP(bf16_t, WS_WIN), C.inp(5), C.inp(5), DM, 0, scr, r, C.lane);
        }
    }
    {
        float* rc = WSP(float, WS_ROPE); float* rsn = rc + SEQ * 8;
        for (int i = gt; i < SEQ * 8; i += NGT) {
            const int pos = i >> 3, k = i & 7;
            const double f = (k == 0) ? 1.0 : (k == 1) ? 0.19392274474868576 : (k == 2) ? 0.03760603093086393 : (k == 3) ? 0.007292664737217109 : (k == 4) ? 0.001414213562373095 : (k == 5) ? 0.0002742481756762073 : (k == 6) ? 5.318295896944988e-05 : 1.031338537721246e-05;
            const double xx = (double)pos * f; const double kk = __builtin_rint(xx * 0.15915494309189535); const float r = (float)(xx - kk * 6.283185307179586);
            rc[i] = cosf(r); rsn[i] = sinf(r);
        }
    }
    {
        f32x2* pw = WSP(f32x2, WS_PW); f32x2* bbar = WSP(f32x2, WS_BBAR);
        for (int i = gt; i < NG * NP * PWN; i += NGT) {
            const int gp = i / PWN, d = i - gp * PWN, g = gp >> 6; const float are = C.inp(7)[gp], aim = C.inp(8)[gp], dt = expf(C.inp(9)[g]);
            const double xx = (double)aim * (double)dt * (double)d; const double kk = __builtin_rint(xx * 0.15915494309189535); const float r = (float)(xx - kk * 6.283185307179586);
            const float mag = expf(are * dt * (float)d); pw[i] = (f32x2){mag * cosf(r), mag * sinf(r)};
        }
        for (int i = gt; i < NG * NP * NCH; i += NGT) {
            const int gp = i >> 4, g = gp >> 6; const float are = C.inp(7)[gp], aim = C.inp(8)[gp], dt = expf(C.inp(9)[g]);
            const double xx = (double)aim * (double)dt; const double kk = __builtin_rint(xx * 0.15915494309189535); const float r = (float)(xx - kk * 6.283185307179586);
            const float mag = expf(are * dt), l1r = mag * cosf(r), l1i = mag * sinf(r);
            const float nr = l1r - 1.0f, ni = l1i, den = 1.0f / (are * are + aim * aim); const float zr = (nr * are + ni * aim) * den, zi = (ni * are - nr * aim) * den;
            const float br = C.inp(10)[i], bi = C.inp(11)[i]; bbar[i] = (f32x2){zr * br - zi * bi, zr * bi + zi * br};
        }
    }
}
__device__ __forceinline__ void weights_late_item(const Ctx& C, int it) {
    LAS float* scr = (LAS float*)(C.lds + C.wave * 16384);
    constexpr int I_GU = (DM / 64) * (DFF / 32), I_DN = (DFF / 64) * (DM / 32), I_OUT = (DM / 64) * (DM / 32), I_GLU = (DSSM / 64) * (DSSM / 32);
    static_assert(2 * I_GU + I_DN + I_OUT + I_GLU == 256 * 19, "late weight items: 19 per workgroup");
    int r = it;
    if (r < I_GU) { transpose_item(C.inp(22), DM, DFF, WSP(bf16_t, WS_WGU2), C.inp(21), C.inp(21), DM, 1, scr, r, C.lane); return; } r -= I_GU;
    if (r < I_GU) { transpose_item(C.inp(23), DM, DFF, WSP(bf16_t, WS_WGU2), C.inp(21), C.inp(21), DM, 2, scr, r, C.lane); return; } r -= I_GU;
    if (r < I_DN) { transpose_item(C.inp(24), DFF, DM, WSP(bf16_t, WS_WD2), nullptr, nullptr, 0, 0, scr, r, C.lane); return; } r -= I_DN;
    if (r < I_OUT) { transpose_item(C.inp(20), DM, DM, WSP(bf16_t, WS_WOUT), C.inp(18), C.inp(19), DSSM, 0, scr, r, C.lane); return; } r -= I_OUT;
    transpose_item(C.inp(15), DSSM, DSSM, WSP(bf16_t, WS_WGLU), nullptr, nullptr, 0, 0, scr, r, C.lane);
}
__device__ __forceinline__ void phase_prep1(const Ctx& C) {
    LAS float* L = (LAS float*)C.lds;
    LAS float* Cr = L; LAS float* Ci = L + 1024; LAS f32x2* Bb = (LAS f32x2*)(L + 2048); LAS f32x2* Pw = (LAS f32x2*)(L + 4096);
    const f32x2* pw = WSP(f32x2, WS_PW); const f32x2* bbar = WSP(f32x2, WS_BBAR); float* ktab = WSP(float, WS_KTAB);
    constexpr int per = 4;
    const int base = (C.bx & 255) * per, g = base >> 5, d0 = base & 31;
    __syncthreads();
    for (int i = C.tid; i < 1024; i += NTHREADS) { Cr[i] = C.inp(12)[g * 1024 + i]; Ci[i] = C.inp(13)[g * 1024 + i]; Bb[i] = bbar[g * 1024 + i]; }
    for (int i = C.tid; i < per * 64; i += NTHREADS) { const int k = i >> 6, p = i & 63; Pw[i] = pw[(size_t)(g * 64 + p) * PWN + d0 + k]; }
    __syncthreads();
    const int half = C.tid >> 8, t = C.tid & 255, cp = t >> 4, c = t & 15;
#pragma unroll 1
    for (int k = half; k < per; k += 2) {
        float s = 0.f;
#pragma unroll 4
        for (int p = 0; p < NP; ++p) { const float cr = Cr[cp * 64 + p], ci = Ci[cp * 64 + p]; const f32x2 w = Pw[k * 64 + p], b = Bb[p * 16 + c];
            const float xr = cr * w.x - ci * w.y, xi = cr * w.y + ci * w.x; s += xr * b.x - xi * b.y; }
        ktab[(size_t)(base + k) * 256 + t] = s;
    }
    __syncthreads();
}
__device__ __forceinline__ void phase_prep2(const Ctx& C, int gt, int NGT) {
    const f32x2* pw = WSP(f32x2, WS_PW); const f32x2* bbar = WSP(f32x2, WS_BBAR); const float* ktab = WSP(float, WS_KTAB);
    bf16_t* bty = WSP(bf16_t, WS_BTY); bf16_t* bts1 = WSP(bf16_t, WS_BTS1);
    for (int q = gt; q < NG * K1 * (KY / 8); q += NGT) {
        const int row = q / (KY / 8), ck = q % (KY / 8), g = row >> 9, t = (row >> 4) & 31, cp = row & 15, k0 = ck * 8; float v[8];
        if (k0 < K1) { const int tau = k0 >> 4, c0 = k0 & 15;
            if (t >= tau) { const f32x4* kp = (const f32x4*)(ktab + ((size_t)((g * TCH + (t - tau)) * 16 + cp) * 16 + c0)); const f32x4 a = kp[0], b = kp[1];
                v[0] = a[0]; v[1] = a[1]; v[2] = a[2]; v[3] = a[3]; v[4] = b[0]; v[5] = b[1]; v[6] = b[2]; v[7] = b[3]; }
            else {
#pragma unroll
                for (int e = 0; e < 8; ++e) v[e] = 0.f; }
        } else { const int p0 = (k0 - K1) >> 1;
#pragma unroll
            for (int e = 0; e < 4; ++e) { const int p = p0 + e; const float cr = C.inp(12)[(g * 16 + cp) * 64 + p], ci = C.inp(13)[(g * 16 + cp) * 64 + p]; const f32x2 w = pw[(size_t)(g * 64 + p) * PWN + t + 1];
                v[2 * e] = cr * w.x - ci * w.y; v[2 * e + 1] = -(cr * w.y + ci * w.x); }
        }
        u32x4 o; o.x = cvt_pk_bf16(v[0], v[1]); o.y = cvt_pk_bf16(v[2], v[3]); o.z = cvt_pk_bf16(v[4], v[5]); o.w = cvt_pk_bf16(v[6], v[7]);
        *(u32x4*)(bty + (size_t)row * KY + k0) = o;
    }
    for (int q = gt; q < NG * 128 * (K1 / 8); q += NGT) {
        const int g = q / (128 * 64), p2 = (q >> 6) & 127, ck = q & 63, k0 = ck * 8, tau = k0 >> 4, c0 = k0 & 15, part = p2 & 1, p = p2 >> 1;
        const f32x2 w = pw[(size_t)(g * 64 + p) * PWN + (TCH - 1 - tau)]; float v[8];
#pragma unroll
        for (int e = 0; e < 8; ++e) { const f32x2 b = bbar[(g * 64 + p) * 16 + c0 + e]; v[e] = part == 0 ? (w.x * b.x - w.y * b.y) : (w.x * b.y + w.y * b.x); }
        u32x4 o; o.x = cvt_pk_bf16(v[0], v[1]); o.y = cvt_pk_bf16(v[2], v[3]); o.z = cvt_pk_bf16(v[4], v[5]); o.w = cvt_pk_bf16(v[6], v[7]);
        *(u32x4*)(bts1 + (size_t)(g * 256 + p2) * K1 + k0) = o;
    }
}
__device__ __forceinline__ void carry_task(const Ctx& C, int b, int g) {
    const f32x2* pw = WSP(f32x2, WS_PW); const float* sloc = WSP(float, WS_SLOC); bf16_t* app = WSP(bf16_t, WS_APP);
    const int p = C.lane; const f32x2 lt = pw[(size_t)(g * 64 + p) * PWN + TCH];
    float sr = 0.f, si = 0.f;
    const size_t row0 = (size_t)g * NBN + b * NCK;
#pragma unroll 1
    for (int c0 = 0; c0 < NCK; c0 += 16) {
        f32x2 l[16];
#pragma unroll
        for (int j = 0; j < 16; ++j) l[j] = *(const f32x2*)(sloc + (row0 + c0 + j) * 128 + 2 * p);
#pragma unroll
        for (int j = 0; j < 16; ++j) {
            const size_t row = row0 + c0 + j;
            *(unsigned*)(app + row * KY + K1 + 2 * p) = cvt_pk_bf16(sr, si);
            const float nr = lt.x * sr - lt.y * si + l[j].x, ni = lt.x * si + lt.y * sr + l[j].y; sr = nr; si = ni;
        }
    }
}
typedef float f32x16 __attribute__((ext_vector_type(16)));
#define MFMA32(a, b, c) __builtin_amdgcn_mfma_f32_32x32x16_bf16((a), (b), (c), 0, 0, 0)
__device__ __forceinline__ bf16x8 pack8_mfma(const f32x16& x, int s) {
    u32x4 p; p[0] = cvt_pk_bf16(x[8 * s], x[8 * s + 1]); p[1] = cvt_pk_bf16(x[8 * s + 2], x[8 * s + 3]); p[2] = cvt_pk_bf16(x[8 * s + 4], x[8 * s + 5]); p[3] = cvt_pk_bf16(x[8 * s + 6], x[8 * s + 7]);
    return __builtin_bit_cast(bf16x8, p);
}
__device__ __forceinline__ void phase_attn(const Ctx& C) {
    constexpr int KROW = 144, KSZ = 256 * KROW, VROW = 528, VSZ = 64 * VROW, V_OFF = 2 * KSZ;
    static_assert(V_OFF + 2 * VSZ <= LDS_BYTES, "attention LDS");
    const bf16_t* qkv = WSP(bf16_t, WS_QKV); bf16_t* ycat = WSP(bf16_t, WS_YCAT); const float* ssq_ssm = WSP(float, WS_SSQ) + 2 * SSQ_STRIDE; unsigned* glu_cnt = (unsigned*)(WSP(float, WS_SSQ) + 5 * SSQ_STRIDE) + 128 * 64;
    LAS unsigned char* lds = C.lds; const int tid = C.tid, lane = C.lane, wave = C.wave;
    for (int item = C.bx; item < BATCH * 32; item += C.G) {
        const int b = item >> 5, nb = item & 31, tok0 = b * SEQ + nb * 128; const long kbase = (long)tok0 - 128;
        __syncthreads();
#pragma unroll
        for (int i = 0; i < 8; ++i) { const int c = tid + NTHREADS * i, part = c & 7, sk = (c >> 3) & 255, kvh = c >> 11;
            if (nb > 0 || sk >= 128) { const u32x4 v = *(const u32x4*)(qkv + (size_t)(kbase + sk) * 768 + 512 + kvh * 64 + part * 8); *(LAS u32x4*)(lds + kvh * KSZ + sk * KROW + part * 16) = v; } }
#pragma unroll
        for (int i = 0; i < 4; ++i) { const int c = tid + NTHREADS * i, sp = c & 127, part = (c >> 7) & 7, kvh = c >> 10, sk = 2 * sp;
            if (nb > 0 || sk >= 128) { const bf16_t* vp = qkv + (size_t)(kbase + sk) * 768 + 640 + kvh * 64 + part * 8; const u32x4 v0 = *(const u32x4*)vp, v1 = *(const u32x4*)(vp + 768);
                LAS unsigned char* dst = lds + V_OFF + kvh * VSZ + (part * 8) * VROW + sp * 4;
#pragma unroll
                for (int e = 0; e < 4; ++e) { const unsigned a0 = v0[e], a1 = v1[e];
                    *(LAS unsigned*)(dst + (2 * e) * VROW) = (a0 & 0xffffu) | (a1 << 16); *(LAS unsigned*)(dst + (2 * e + 1) * VROW) = (a0 >> 16) | (a1 & 0xffff0000u); } } }
        __syncthreads();
        const int q0 = wave * 16, ql = lane & 15, hl = (lane >> 4) & 1, h = lane >> 5, a = q0 >> 5, qrel = (q0 & 31) + ql, l31 = lane & 31;
        const int tok = tok0 + q0 + ql;
        float ssq_acc = 0.f;
#pragma unroll 1
        for (int hp = 0; hp < 4; ++hp) {
            const int kvh = hp >> 1, head = 2 * hp + hl;
            bf16x8 qf[4];
#pragma unroll
            for (int ks = 0; ks < 4; ++ks) qf[ks] = *(const bf16x8*)(qkv + (size_t)tok * 768 + head * 64 + 16 * ks + 8 * h);
            f32x16 sc[5];
#pragma unroll
            for (int j = 0; j < 5; ++j) {
#pragma unroll
                for (int r = 0; r < 16; ++r) sc[j][r] = 0.f;
                const int st = a + j;
                if (nb > 0 || st >= 4) {
#pragma unroll
                    for (int ks = 0; ks < 4; ++ks) { const bf16x8 kf = *(const LAS bf16x8*)(lds + kvh * KSZ + (32 * st + l31) * KROW + (16 * ks + 8 * h) * 2); sc[j] = MFMA32(kf, qf[ks], sc[j]); }
                }
            }
            const float sink = C.inp(17)[head] * 1.4426950409f; float mx = sink;
#pragma unroll
            for (int j = 0; j < 5; ++j) { const bool tv = (nb > 0) || (a + j >= 4);
#pragma unroll
                for (int r = 0; r < 16; ++r) { const int cr = (r & 3) + 8 * (r >> 2) + 4 * h; bool ok = tv; if (j == 0) ok = ok && (cr > qrel); if (j == 4) ok = ok && (cr <= qrel);
                    const float t = ok ? sc[j][r] * 0.18033688011f : -1e30f; sc[j][r] = t; mx = fmaxf(mx, t); } }
            mx = fmaxf(mx, __shfl_xor(mx, 32));
            float lsum = 0.f;
#pragma unroll
            for (int j = 0; j < 5; ++j)
#pragma unroll
                for (int r = 0; r < 16; ++r) { const float p = __builtin_amdgcn_exp2f(sc[j][r] - mx); sc[j][r] = p; lsum += p; }
            lsum += __shfl_xor(lsum, 32); lsum += __builtin_amdgcn_exp2f(sink - mx);
            f32x16 o[2];
#pragma unroll
            for (int r = 0; r < 16; ++r) { o[0][r] = 0.f; o[1][r] = 0.f; }
#pragma unroll
            for (int j = 0; j < 5; ++j) { const int st = a + j;
                if (nb > 0 || st >= 4) {
#pragma unroll
                    for (int ks = 0; ks < 2; ++ks) { const bf16x8 pb = pack8_mfma(sc[j], ks);
#pragma unroll
                        for (int dt = 0; dt < 2; ++dt) { const LAS unsigned char* vp = lds + V_OFF + kvh * VSZ + (32 * dt + l31) * VROW + (32 * st + 16 * ks + 4 * h) * 2;
                            const u32x2 x0 = *(const LAS u32x2*)vp, x1 = *(const LAS u32x2*)(vp + 16); u32x4 xv; xv.x = x0.x; xv.y = x0.y; xv.z = x1.x; xv.w = x1.y;
                            o[dt] = MFMA32(__builtin_bit_cast(bf16x8, xv), pb, o[dt]); } }
                }
            }
            const float inv = __builtin_amdgcn_rcpf(lsum);
#pragma unroll
            for (int dt = 0; dt < 2; ++dt) {
                u32x2 w[4];
#pragma unroll
                for (int g4 = 0; g4 < 4; ++g4) { const float v0 = o[dt][4 * g4] * inv, v1 = o[dt][4 * g4 + 1] * inv, v2 = o[dt][4 * g4 + 2] * inv, v3 = o[dt][4 * g4 + 3] * inv;
                    ssq_acc += (v0 * v0 + v1 * v1) + (v2 * v2 + v3 * v3);
                    w[g4].x = cvt_pk_bf16(v0, v1); w[g4].y = cvt_pk_bf16(v2, v3); }
#pragma unroll
                for (int k = 0; k < 4; k += 2) {
                    const auto rx = __builtin_amdgcn_permlane32_swap(w[k].x, w[k + 1].x, false, false); const auto ry = __builtin_amdgcn_permlane32_swap(w[k].y, w[k + 1].y, false, false);
                    u32x4 q; q.x = rx[0]; q.y = ry[0]; q.z = rx[1]; q.w = ry[1];
                    *(u32x4*)(ycat + (size_t)tok * DM + 512 + head * 64 + 32 * dt + 8 * k + 8 * h) = q; }
            }
        }
        ssq_acc += __shfl_xor(ssq_acc, 16); ssq_acc += __shfl_xor(ssq_acc, 32);
        { unsigned* cw = glu_cnt + 64 * (item >> 1); unsigned sp = 0;
          while ((unsigned)__builtin_amdgcn_readfirstlane(__hip_atomic_load(cw, __ATOMIC_RELAXED, __HIP_MEMORY_SCOPE_AGENT)) < 8u) { __builtin_amdgcn_s_sleep(2); if (++sp > (1u << 20)) break; }
          __builtin_amdgcn_fence(__ATOMIC_ACQUIRE, "agent"); }
        const float ssm_sq = __hip_atomic_load(ssq_ssm + (size_t)tok * 4, __ATOMIC_RELAXED, __HIP_MEMORY_SCOPE_AGENT) + __hip_atomic_load(ssq_ssm + (size_t)tok * 4 + 1, __ATOMIC_RELAXED, __HIP_MEMORY_SCOPE_AGENT);
        const float rs = rsqrtf(ssq_acc * (1.0f / 512.0f) + EPS) * sqrtf(ssm_sq * (1.0f / 512.0f) + EPS);
#pragma unroll 1
        for (int hp = 0; hp < 4; ++hp)
#pragma unroll
            for (int dt = 0; dt < 2; ++dt)
#pragma unroll
                for (int k = 0; k < 4; k += 2) { u32x4* p = (u32x4*)(ycat + (size_t)tok * DM + 512 + (2 * hp + hl) * 64 + 32 * dt + 8 * k + 8 * h); const u32x4 w0 = *p;
                    u32x4 w; w.x = cvt_pk_bf16(bf_lo(w0.x) * rs, bf_hi(w0.x) * rs); w.y = cvt_pk_bf16(bf_lo(w0.y) * rs, bf_hi(w0.y) * rs); w.z = cvt_pk_bf16(bf_lo(w0.z) * rs, bf_hi(w0.z) * rs); w.w = cvt_pk_bf16(bf_lo(w0.w) * rs, bf_hi(w0.w) * rs); *p = w; }
    }
    __syncthreads();
}

constexpr int N_PHASES = 12;
__global__ void __launch_bounds__(NTHREADS, 2) mk_fwd(const float* p0, const float* p1, const float* p2, const float* p3, const float* p4, const float* p5, const float* p6, const float* p7, const float* p8, const float* p9, const float* p10, const float* p11, const float* p12, const float* p13, const float* p14, const float* p15, const float* p16, const float* p17, const float* p18, const float* p19, const float* p20, const float* p21, const float* p22, const float* p23, const float* p24, const float* p25, float* out_p, unsigned char* ws_p, int ph_lo, int ph_hi) {
    extern __shared__ __attribute__((aligned(16))) unsigned char lds_raw[];
    Ctx C; C.in[0] = p0; C.in[1] = p1; C.in[2] = p2; C.in[3] = p3; C.in[4] = p4; C.in[5] = p5; C.in[6] = p6; C.in[7] = p7; C.in[8] = p8; C.in[9] = p9; C.in[10] = p10; C.in[11] = p11; C.in[12] = p12; C.in[13] = p13; C.in[14] = p14; C.in[15] = p15; C.in[16] = p16; C.in[17] = p17; C.in[18] = p18; C.in[19] = p19; C.in[20] = p20; C.in[21] = p21; C.in[22] = p22; C.in[23] = p23; C.in[24] = p24; C.in[25] = p25; C.out = out_p; C.ws = ws_p; C.lds = (LAS unsigned char*)lds_raw;
    C.tid = threadIdx.x; C.lane = C.tid & 63; C.wave = __builtin_amdgcn_readfirstlane(C.tid >> 6); C.G = gridDim.x; C.bx = blockIdx.x;
    const int lo = ph_lo, hi = ph_hi;
#define IN(k) (lo <= (k) && (k) < hi)
#define SEAM(k) do { if (IN(k) && IN((k) + 1)) { xcd_barrier(xbar); } } while (0)
    volatile LAS unsigned* xst = (volatile LAS unsigned*)(C.lds + LDS_BYTES - 16);
    if (C.tid == 0) { xst[0] = 0u; xst[1] = 0u; }
    __syncthreads();
    const XcdBarrier xbar = xcd_barrier_post(WSP(unsigned, WS_BAR), xst);
    float* ssq = WSP(float, WS_SSQ); LAS float* red = (LAS float*)(C.lds + RED_OFF);
    if (IN(0)) { phase_prep0(C); __syncthreads(); }
    SEAM(0);
    if (IN(1)) {
        phase_prep1(C);
        pg8::Gemm g{WSP(bf16_t, WS_XB), WSP(bf16_t, WS_WGU1), DM, DM, DM}; pg8::StaticOrder S; S.init(M_TOK, 2 * DFF, C.G, C.bx);
        EpiGateUp E{ssq, WSP(bf16_t, WS_ACT)}; pg8::gemm_phase<EpiGateUp, pg8::StaticOrder, true>(C.lds, g, S, E);
    }
    SEAM(1);
    if (IN(2)) {
        pg8::Gemm g{WSP(bf16_t, WS_ACT), WSP(bf16_t, WS_WD1), DFF, DFF, DFF}; pg8::StaticOrder S; S.init(M_TOK, DM, C.G, C.bx);
        EpiResid E{WSP(bf16_t, WS_XB), ssq + SSQ_STRIDE, 0.5f, nullptr, red}; pg8::gemm_phase<EpiResid, pg8::StaticOrder, true>(C.lds, g, S, E);
    }
    SEAM(2);
    if (IN(3)) {
        pg8::Gemm g{WSP(bf16_t, WS_XB), WSP(bf16_t, WS_WIN), DM, DM, DM}; pg8::StaticOrder S; S.init(M_TOK, DIN, C.G, C.bx);
        EpiWin E{ssq + SSQ_STRIDE, WSP(bf16_t, WS_APP), WSP(bf16_t, WS_QKV), WSP(float, WS_ROPE), WSP(float, WS_ROPE) + SEQ * 8}; pg8::gemm_phase<EpiWin, pg8::StaticOrder, true>(C.lds, g, S, E);
        if (C.G <= 128) phase_prep2(C, C.bx * NTHREADS + C.tid, C.G * NTHREADS);
        else if (C.bx >= 128) phase_prep2(C, (C.bx - 128) * NTHREADS + C.tid, (C.G - 128) * NTHREADS);
    }
    SEAM(3);
    if (IN(4)) {
        { const int it = C.bx & 255;
            const int pm = it >> 1, g = pm >> 2;
            __syncthreads();
            { pg8::Gemm g1{WSP(bf16_t, WS_APP), WSP(bf16_t, WS_BTS1), KY, K1, K1}; pg8::OneUnit S{pm, g}; EpiS1 E{WSP(float, WS_SLOC)}; pg8::gemm_phase<EpiS1, pg8::OneUnit, true, true>(C.lds, g1, S, E); }
            asm volatile("s_waitcnt vmcnt(0)" ::: "memory"); __syncthreads();
            if (C.wave < 2) carry_task(C, 2 * (pm & 3) + C.wave, g);
            if (C.wave >= 2) {
#pragma unroll 1
                for (int j = C.wave - 2; j < 18; j += 6) weights_late_item(C, it * 19 + j);
            } else if (C.wave == 0) weights_late_item(C, it * 19 + 18);
            asm volatile("s_waitcnt vmcnt(0)" ::: "memory"); __syncthreads();
            { pg8::Gemm gy{WSP(bf16_t, WS_APP), WSP(bf16_t, WS_BTY), KY, KY, KY}; pg8::OneUnit S{pm, 2 * g + (it & 1)}; EpiY E{WSP(bf16_t, WS_APP), C.inp(14), WSP(bf16_t, WS_YGELU)}; pg8::gemm_phase<EpiY, pg8::OneUnit, true>(C.lds, gy, S, E); }
        }
    }
    SEAM(4);
    if (IN(7)) {
        pg8::Gemm g{WSP(bf16_t, WS_YGELU), WSP(bf16_t, WS_WGLU), DSSM, DSSM, DSSM}; pg8::StaticOrder S; S.init(M_TOK, DSSM, C.G, C.bx);
        EpiGlu E{WSP(bf16_t, WS_YGELU), C.inp(16), WSP(bf16_t, WS_YCAT), ssq + 2 * SSQ_STRIDE, red, (unsigned*)(ssq + 5 * SSQ_STRIDE) + 128 * 64}; pg8::gemm_phase<EpiGlu, pg8::StaticOrder, true>(C.lds, g, S, E);
        phase_attn(C);
    }
    SEAM(8);
    if (IN(9)) {
        pg8::Gemm g{WSP(bf16_t, WS_YCAT), WSP(bf16_t, WS_WOUT), DM, DM, DM}; pg8::StaticOrder S; S.init(M_TOK, DM, C.G, C.bx);
        EpiResid E{WSP(bf16_t, WS_XB), ssq + 3 * SSQ_STRIDE, 1.0f, ssq + 2 * SSQ_STRIDE, red}; pg8::gemm_phase<EpiResid, pg8::StaticOrder, true>(C.lds, g, S, E);
    }
    SEAM(9);
    if (IN(10)) {
        pg8::Gemm g{WSP(bf16_t, WS_XB), WSP(bf16_t, WS_WGU2), DM, DM, DM}; pg8::StaticOrder S; S.init(M_TOK, 2 * DFF, C.G, C.bx);
        EpiGateUp E{ssq + 3 * SSQ_STRIDE, WSP(bf16_t, WS_ACT)}; pg8::gemm_phase<EpiGateUp, pg8::StaticOrder, true>(C.lds, g, S, E);
    }
    SEAM(10);
    if (IN(11)) {
        pg8::Gemm g{WSP(bf16_t, WS_ACT), WSP(bf16_t, WS_WD2), DFF, DFF, DFF}; pg8::StaticOrder S; S.init(M_TOK, DM, C.G, C.bx);
        EpiFinal E{WSP(bf16_t, WS_XB), ssq + 4 * SSQ_STRIDE, (unsigned*)(ssq + 5 * SSQ_STRIDE), C.inp(25), C.out, red}; pg8::gemm_phase<EpiFinal, pg8::StaticOrder, true>(C.lds, g, S, E);
    }
#undef IN
#undef SEAM
}

extern "C" void kernel_launch(void* const* d_in, const int* in_sizes, int n_in, void* d_out, int out_size, void* d_ws, size_t ws_size, hipStream_t stream) {
    static int grid = 0;
    if (grid == 0) {
        if (n_in != 26 || out_size != M_TOK * DM || ws_size < WS_END) { fprintf(stderr, "kernel_launch: unexpected shapes (n_in %d out %d ws %zu)\n", n_in, out_size, ws_size); grid = -1; return; }
        int dev = 0, cus = 0, per_cu = 0;
        hipGetDevice(&dev); hipDeviceGetAttribute(&cus, hipDeviceAttributeMultiprocessorCount, dev);
        if (hipFuncSetAttribute((const void*)mk_fwd, hipFuncAttributeMaxDynamicSharedMemorySize, LDS_BYTES) != hipSuccess) { fprintf(stderr, "kernel_launch: hipFuncSetAttribute failed\n"); grid = -1; return; }
        hipOccupancyMaxActiveBlocksPerMultiprocessor(&per_cu, (const void*)mk_fwd, NTHREADS, LDS_BYTES);
        if (per_cu < 1) { fprintf(stderr, "kernel_launch: occupancy query says %d blocks/CU\n", per_cu); per_cu = 1; }
        (void)hipGetLastError();
        grid = cus;
    }
    if (grid < 0) return;
    const float* ip[26]; for (int i = 0; i < 26; ++i) ip[i] = (const float*)d_in[i];
    float* outp = (float*)d_out; unsigned char* wsp = (unsigned char*)d_ws; int lo = 0, hi = N_PHASES;
    (void)hipMemsetAsync((unsigned char*)d_ws + WS_BAR, 0, XCD_BAR_WORDS * sizeof(unsigned), stream);
    void* kargs[30]; for (int i = 0; i < 26; ++i) kargs[i] = (void*)&ip[i];
    kargs[26] = (void*)&outp; kargs[27] = (void*)&wsp; kargs[28] = (void*)&lo; kargs[29] = (void*)&hi;
    hipError_t e = hipLaunchCooperativeKernel((const void*)mk_fwd, dim3(grid), dim3(NTHREADS), kargs, LDS_BYTES, stream);
    if (e != hipSuccess) fprintf(stderr, "kernel_launch: cooperative launch failed: %s (grid %d)\n", hipGetErrorString(e), grid);
}
```

```cpp
#include <hip/hip_runtime.h>
#include <hip/hip_cooperative_groups.h>
#include <cstdio>
#include <cstdint>
namespace cg = cooperative_groups;

#define LAS __attribute__((address_space(3)))
#define GAS __attribute__((address_space(1)))
typedef unsigned short bf16_t;
typedef short bf16x8 __attribute__((ext_vector_type(8)));
typedef float f32x4 __attribute__((ext_vector_type(4)));
typedef float f32x2 __attribute__((ext_vector_type(2)));
typedef unsigned u32x4 __attribute__((ext_vector_type(4)));
typedef unsigned u32x2 __attribute__((ext_vector_type(2)));

constexpr int BATCH = 8, SEQ = 4096, M_TOK = BATCH * SEQ, DM = 1024, DFF = 2816, DIN = 1280, DSSM = 512;
constexpr int NG = 32, NP = 64, NCH = 16;
constexpr int TCH = 32, NCK = SEQ / TCH, NBN = BATCH * NCK;
constexpr int K1 = TCH * NCH;
constexpr int KY = K1 + 2 * NP;
constexpr int PWN = TCH + 1;
constexpr float EPS = 1e-6f;
constexpr int NTHREADS = 512, NWAVES = 8;
constexpr int LDS_BYTES = 147456;
constexpr int RED_OFF = 131072;
constexpr size_t SSQ_STRIDE = 4 * (size_t)32768;

constexpr size_t MiB = 1024 * 1024;
constexpr size_t WS_XB = 0;
constexpr size_t WS_ACT = 64 * MiB;
constexpr size_t WS_APP = WS_ACT;
constexpr size_t WS_QKV = WS_ACT + 40 * MiB;
constexpr size_t WS_YGELU = WS_ACT + 88 * MiB;
constexpr size_t WS_SLOC = WS_ACT + 120 * MiB;
constexpr size_t WS_YCAT = 240 * MiB;
constexpr size_t WS_WGU1 = 304 * MiB, WS_WD1 = 315 * MiB, WS_WGU2 = 321 * MiB, WS_WD2 = 332 * MiB;
constexpr size_t WS_WIN = 338 * MiB, WS_WOUT = 341 * MiB, WS_WGLU = 343 * MiB;
constexpr size_t WS_BTY = 344 * MiB;
constexpr size_t WS_BTS1 = 364 * MiB;
constexpr size_t WS_PW = 372 * MiB;
constexpr size_t WS_BBAR = 373 * MiB;
constexpr size_t WS_KTAB = 374 * MiB;
constexpr size_t WS_SSQ = 380 * MiB;
constexpr size_t WS_ROPE = 377 * MiB;
constexpr size_t WS_BAR = 378 * MiB;
constexpr size_t WS_END = 384 * MiB;


typedef __bf16 bf16x2_t __attribute__((ext_vector_type(2)));
__device__ __forceinline__ unsigned cvt_pk_bf16(float lo, float hi) { const f32x2 v = {lo, hi}; return __builtin_bit_cast(unsigned, __builtin_convertvector(v, bf16x2_t)); }
__device__ __forceinline__ float bf_lo(unsigned w) { return __uint_as_float(w << 16); }
__device__ __forceinline__ float bf_hi(unsigned w) { return __uint_as_float(w & 0xffff0000u); }
__device__ __forceinline__ float bf2f(bf16_t b) { return __uint_as_float(((unsigned)b) << 16); }
__device__ __forceinline__ bf16_t f2bf(float f) { return (bf16_t)(cvt_pk_bf16(f, 0.f) & 0xffffu); }
__device__ __forceinline__ float gelu_tanh(float v) { const float z = -2.3022081198f * (v + 0.044715f * v * v * v); return v * __builtin_amdgcn_rcpf(1.0f + __builtin_amdgcn_exp2f(z)); }
__device__ __forceinline__ float sigmoidf_(float v) { return __builtin_amdgcn_rcpf(1.0f + __builtin_amdgcn_exp2f(-1.4426950409f * v)); }
__device__ __forceinline__ f32x4 bf4_lo(const u32x4 x) { return (f32x4){bf_lo(x.x), bf_hi(x.x), bf_lo(x.y), bf_hi(x.y)}; }
__device__ __forceinline__ f32x4 bf4_hi(const u32x4 x) { return (f32x4){bf_lo(x.z), bf_hi(x.z), bf_lo(x.w), bf_hi(x.w)}; }
__device__ __forceinline__ f32x4 exp2_v(const f32x4 t) { return (f32x4){__builtin_amdgcn_exp2f(t[0]), __builtin_amdgcn_exp2f(t[1]), __builtin_amdgcn_exp2f(t[2]), __builtin_amdgcn_exp2f(t[3])}; }
__device__ __forceinline__ f32x4 rcp_v(const f32x4 t) { return (f32x4){__builtin_amdgcn_rcpf(t[0]), __builtin_amdgcn_rcpf(t[1]), __builtin_amdgcn_rcpf(t[2]), __builtin_amdgcn_rcpf(t[3])}; }
__device__ __forceinline__ f32x4 sigmoid_v(const f32x4 a) { return rcp_v(exp2_v(a * -1.4426950409f) + 1.0f); }
__device__ __forceinline__ f32x4 gelu_tanh_v(const f32x4 v) { const f32x4 z = v * ((v * v) * -0.1029432397f + -2.3022081198f); return v * rcp_v(exp2_v(z) + 1.0f); }
__device__ __forceinline__ u32x4 pack8(const f32x4 a, const f32x4 b) { u32x4 w; w.x = cvt_pk_bf16(a[0], a[1]); w.y = cvt_pk_bf16(a[2], a[3]); w.z = cvt_pk_bf16(b[0], b[1]); w.w = cvt_pk_bf16(b[2], b[3]); return w; }
__device__ __forceinline__ float rs_from_ssq(float ssq, float inv_n) { return __builtin_amdgcn_rsqf(ssq * inv_n + EPS); }

namespace pg8 {
constexpr int BM = 256, BK = 64, HALF = 128, HTB = HALF * BK * 2, STAGE_BYTES = 8 * HTB, NXCD = 8, WGM = 8;
__host__ __device__ __forceinline__ int lds_byte(int r, int c) { const int st = (r >> 4) * 2 + (c >> 5), rr = r & 15, cc = c & 31, ob = rr * 64 + cc * 2; return st * 1024 + (ob ^ (((ob >> 9) & 1) << 5)); }
__host__ __device__ __forceinline__ int perm32(int rho) { const int n = rho >> 4, i = rho & 15; return 8 * (i >> 2) + 4 * n + (i & 3); }
__host__ __device__ __forceinline__ void stage_rc(int b, int& R, int& C) { const int st = b / 1024, sb = b % 1024, swz = sb ^ (((sb >> 9) & 1) << 5); R = (st >> 1) * 16 + swz / 64; C = (st & 1) * 32 + (swz % 64) / 2; }

struct Unit { int pm, pn, ka, kb, part; };
struct Gemm { const bf16_t* A; const bf16_t* Bt; int lda, ldb, K; };

struct StaticOrder {
    int nM, nN, nwg, G, c;
    __device__ void init(int M, int N, int G_, int c_) { nM = M / BM; nN = N / BM; nwg = nM * nN; G = G_; c = c_; }
    __device__ bool next(int i, Unit& u) const {
        const long L = (long)i * G + c; if (L >= nwg) return false;
        int wgid = (int)L; { const int q = nwg / NXCD, r = nwg % NXCD, xcd = wgid % NXCD, off = wgid / NXCD; wgid = (xcd < r ? xcd * (q + 1) : r * (q + 1) + (xcd - r) * q) + off; }
        const int nig = WGM * nN, gid = wgid / nig, fm = gid * WGM, gsz = (nM - fm) < WGM ? (nM - fm) : WGM;
        u.pm = fm + ((wgid % nig) % gsz); u.pn = (wgid % nig) / gsz; u.ka = 0; u.kb = 0; u.part = 0; return true;
    }
};
struct OneUnit { int pm, pn;
    __device__ bool next(int i, Unit& u) const { if (i) return false; u.pm = pm; u.pn = pn; u.ka = 0; u.kb = 0; u.part = 0; return true; } };
struct SplitOrder { StaticOrder so;
    __device__ bool next(int i, Unit& u) const { if (!so.next(i >> 1, u)) return false; u.ka = u.kb = (i & 1) * 512; u.part = (i & 1) ? 0 : 1; return true; } };

template <class Epi, class Sched, bool PERM = false, bool HALF_N = false>
__device__ __forceinline__ void gemm_phase(LAS unsigned char* lds, const Gemm g, const Sched& S, const Epi& E) {
    const int tid = threadIdx.x, wid = __builtin_amdgcn_readfirstlane(tid >> 6), lane = tid & 63, wr = wid >> 2, wc = wid & 3, fr = lane & 15, fq = lane >> 4;
    const int nt = g.K / BK;
    unsigned voffA[2], voffB[2];
#pragma unroll
    for (int i = 0; i < 2; ++i) { int R, C; stage_rc(tid * 16 + i * 8192, R, C); const int Rb = PERM ? ((R & ~31) + perm32(R & 31)) : R; voffA[i] = (unsigned)(R * g.lda + C) * 2u; voffB[i] = (unsigned)(Rb * g.ldb + C) * 2u; }
    const size_t kstep = (size_t)(BK * 2);
    const size_t hA = (size_t)HALF * g.lda * 2, hB = (size_t)HALF * g.ldb * 2, tA = 2 * hA, tB = 2 * hB;
    const unsigned ldsw = (unsigned)wid * 1024u;
    const int aoff = lds_byte(wr * 64 + fr, fq * 8), boff = lds_byte(wc * 32 + fr, fq * 8);
#define PG8_SA(b, h) (((b) * 2 + (h)) * HTB)
#define PG8_SB(b, h) ((4 + (b) * 2 + (h)) * HTB)
#define PG8_STAGE(bufoff, gbase, voff) do { _Pragma("unroll") for (int _i = 0; _i < 2; ++_i) \
        __builtin_amdgcn_global_load_lds((const unsigned*)((const char*)(gbase) + (voff)[_i]), (LAS unsigned*)(lds + (bufoff) + ldsw + _i * 8192), 16, 0, 0); } while (0)
#define PG8_LDA(dst, b, h) do { _Pragma("unroll") for (int m = 0; m < 4; ++m) _Pragma("unroll") for (int k = 0; k < 2; ++k) dst[m][k] = *(const LAS bf16x8*)(lds + PG8_SA(b, h) + aoff + m * 2048 + k * 1024); } while (0)
#define PG8_LDB(dst, b, h) do { _Pragma("unroll") for (int n = 0; n < 2; ++n) _Pragma("unroll") for (int k = 0; k < 2; ++k) dst[n][k] = *(const LAS bf16x8*)(lds + PG8_SB(b, h) + boff + n * 2048 + k * 1024); } while (0)
#define PG8_MMA(ai, bj, At, Bt) do { __builtin_amdgcn_s_setprio(1); _Pragma("unroll") for (int m = 0; m < 4; ++m) _Pragma("unroll") for (int n = 0; n < 2; ++n) _Pragma("unroll") for (int k = 0; k < 2; ++k) \
        acc[ai][bj][m][n] = __builtin_amdgcn_mfma_f32_16x16x32_bf16(Bt[n][k], At[m][k], acc[ai][bj][m][n], 0, 0, 0); __builtin_amdgcn_s_setprio(0); } while (0)
#define PG8_WAIT_V(n) asm volatile("s_waitcnt vmcnt(" #n ")" ::: "memory")
#define PG8_WAIT_L(n) asm volatile("s_waitcnt lgkmcnt(" #n ")" ::: "memory")
#define PG8_BAR __builtin_amdgcn_s_barrier()
#define PG8_SCHED __builtin_amdgcn_sched_barrier(0)
    Unit cur, nxt; int ui = 0;
    if (!S.next(0, cur)) return;
    f32x4 acc[2][2][4][2];
#pragma unroll
    for (int a = 0; a < 2; ++a)
#pragma unroll
        for (int b = 0; b < 2; ++b)
#pragma unroll
            for (int m = 0; m < 4; ++m)
#pragma unroll
                for (int n = 0; n < 2; ++n) acc[a][b][m][n] = (f32x4){0.f, 0.f, 0.f, 0.f};
    bf16x8 At[4][2], B0[2][2], B1[2][2];
    const char* cA = (const char*)g.A + (size_t)cur.pm * tA + (size_t)cur.ka * 2; const char* cB = (const char*)g.Bt + (size_t)cur.pn * tB + (size_t)cur.kb * 2;
    PG8_STAGE(PG8_SB(0, 0), cB, voffB); PG8_STAGE(PG8_SB(0, 1), cB + hB, voffB); PG8_STAGE(PG8_SA(0, 0), cA, voffA); PG8_STAGE(PG8_SA(0, 1), cA + hA, voffA);
    if (wr == 1) PG8_BAR;
    PG8_WAIT_V(2); PG8_BAR;
    PG8_STAGE(PG8_SB(1, 0), cB + kstep, voffB); PG8_STAGE(PG8_SA(1, 0), cA + kstep, voffA); PG8_STAGE(PG8_SB(1, 1), cB + hB + kstep, voffB);
    PG8_WAIT_V(6); PG8_BAR;
    for (;;) {
        const bool has_next = S.next(ui + 1, nxt);
        const char* nA = has_next ? (const char*)g.A + (size_t)nxt.pm * tA + (size_t)nxt.ka * 2 : cA; const char* nB = has_next ? (const char*)g.Bt + (size_t)nxt.pn * tB + (size_t)nxt.kb * 2 : cB;
        for (int t = 0; t < nt; t += 2) {
            const bool last = (t == nt - 2);
            const char* a1 = cA + (size_t)(t + 1) * kstep;
            const char* a2 = last ? nA : cA + (size_t)(t + 2) * kstep; const char* b2 = last ? nB : cB + (size_t)(t + 2) * kstep;
            const char* a3 = a2 + kstep; const char* b3 = b2 + kstep;
            PG8_LDB(B0, 0, 0); if constexpr (!HALF_N) PG8_LDB(B1, 0, 1); PG8_SCHED; PG8_LDA(At, 0, 0); PG8_STAGE(PG8_SA(1, 1), a1 + hA, voffA);
            PG8_WAIT_V(8); PG8_WAIT_L(0); PG8_BAR; PG8_MMA(0, 0, At, B0); if constexpr (!HALF_N) PG8_MMA(0, 1, At, B1); PG8_BAR; PG8_SCHED;
            PG8_LDA(At, 0, 1); PG8_STAGE(PG8_SB(0, 0), b2, voffB); PG8_STAGE(PG8_SB(0, 1), b2 + hB, voffB); PG8_STAGE(PG8_SA(0, 0), a2, voffA);
            PG8_WAIT_V(8); PG8_WAIT_L(0); PG8_BAR; PG8_MMA(1, 0, At, B0); if constexpr (!HALF_N) PG8_MMA(1, 1, At, B1); PG8_BAR; PG8_SCHED;
            PG8_LDB(B0, 1, 0); if constexpr (!HALF_N) PG8_LDB(B1, 1, 1); PG8_SCHED; PG8_LDA(At, 1, 0); PG8_STAGE(PG8_SA(0, 1), a2 + hA, voffA);
            PG8_WAIT_V(8); PG8_WAIT_L(0); PG8_BAR; PG8_MMA(0, 0, At, B0); if constexpr (!HALF_N) PG8_MMA(0, 1, At, B1); PG8_BAR; PG8_SCHED;
            PG8_LDA(At, 1, 1); PG8_STAGE(PG8_SB(1, 0), b3, voffB); PG8_STAGE(PG8_SB(1, 1), b3 + hB, voffB); PG8_STAGE(PG8_SA(1, 0), a3, voffA);
            PG8_WAIT_V(8); PG8_WAIT_L(0); PG8_BAR; PG8_MMA(1, 0, At, B0); if constexpr (!HALF_N) PG8_MMA(1, 1, At, B1); PG8_BAR; PG8_SCHED;
        }
        if (wr == 0) PG8_BAR;
        if (cur.part) { E.mid(acc, cur, wr, wc, fr, fq); }
        else {
            E(acc, cur, wr, wc, fr, fq);
            if (has_next) {
#pragma unroll
                for (int a = 0; a < 2; ++a)
#pragma unroll
                    for (int b = 0; b < 2; ++b)
#pragma unroll
                        for (int m = 0; m < 4; ++m)
#pragma unroll
                            for (int n = 0; n < 2; ++n) acc[a][b][m][n] = (f32x4){0.f, 0.f, 0.f, 0.f};
            }
        }
        if (!has_next) break;
        cur = nxt; cA = nA; cB = nB; ++ui;
        if (wr == 1) PG8_BAR;
    }
    PG8_WAIT_V(0);
    PG8_BAR;
#undef PG8_SA
#undef PG8_SB
#undef PG8_STAGE
#undef PG8_LDA
#undef PG8_LDB
#undef PG8_MMA
#undef PG8_WAIT_V
#undef PG8_WAIT_L
#undef PG8_BAR
#undef PG8_SCHED
}
}
using pg8::Unit; using pg8::HALF; using pg8::BM;

typedef f32x4 AccT[2][2][4][2];

__device__ __forceinline__ void red_put(LAS float* red, int ai, int wr, int m, int fr, int wc, int fq, float s) { if (fq == 0) red[(ai * HALF + wr * 64 + m * 16 + fr) * 4 + wc] = s; }
template <bool WT>
__device__ __forceinline__ void red_flush(LAS float* red, float* part, const Unit& u) {
    asm volatile("s_waitcnt lgkmcnt(0)" ::: "memory"); __builtin_amdgcn_s_barrier(); asm volatile("" ::: "memory");
    const int t = threadIdx.x;
    if (t < 256) { const f32x4 v = *(const LAS f32x4*)(red + t * 4); const float sum = (v[0] + v[1]) + (v[2] + v[3]); float* p = part + (size_t)(u.pm * BM + t) * 4 + u.pn;
        if (WT) __hip_atomic_store(p, sum, __ATOMIC_RELAXED, __HIP_MEMORY_SCOPE_AGENT); else *p = sum; }
}
__device__ __forceinline__ float sum4(const f32x4 v) { return (v[0] + v[1]) + (v[2] + v[3]); }
struct EpiGateUp {
    const float* ssq; bf16_t* act;
    __device__ __forceinline__ void mid(AccT&, const Unit&, int, int, int, int) const {}
    __device__ __forceinline__ void operator()(const AccT& acc, const Unit& u, int wr, int wc, int fr, int fq) const {
        const int row0 = u.pm * BM + wr * 64 + fr, col0 = u.pn * 128 + wc * 32 + 8 * fq;
        float rsv[2][4];
#pragma unroll
        for (int ai = 0; ai < 2; ++ai)
#pragma unroll
            for (int m = 0; m < 4; ++m) rsv[ai][m] = sum4(*(const f32x4*)(ssq + (size_t)(row0 + ai * HALF + m * 16) * 4));
#pragma unroll
        for (int ai = 0; ai < 2; ++ai)
#pragma unroll
            for (int m = 0; m < 4; ++m) {
                const int row = row0 + ai * HALF + m * 16; const float rs = rs_from_ssq(rsv[ai][m], 1.0f / DM), rs2 = rs * rs, nl = -1.4426950409f * rs;
                f32x4 a[2];
#pragma unroll
                for (int n = 0; n < 2; ++n) { const f32x4 ga = acc[ai][0][m][n], ua = acc[ai][1][m][n]; const f32x4 pr = (ga * ua) * rs2, tt = ga * nl; f32x4 e;
#pragma unroll
                    for (int j = 0; j < 4; ++j) e[j] = __builtin_amdgcn_exp2f(tt[j]);
                    e = e + 1.0f; f32x4 r;
#pragma unroll
                    for (int j = 0; j < 4; ++j) r[j] = __builtin_amdgcn_rcpf(e[j]);
                    a[n] = pr * r; }
                u32x4 w; w.x = cvt_pk_bf16(a[0][0], a[0][1]); w.y = cvt_pk_bf16(a[0][2], a[0][3]); w.z = cvt_pk_bf16(a[1][0], a[1][1]); w.w = cvt_pk_bf16(a[1][2], a[1][3]);
                *(u32x4*)(act + (size_t)row * DFF + col0) = w;
            }
    }
};
struct EpiResid {
    bf16_t* xb; float* ssq_out; float scale; const float* ssq_row; LAS float* red;
    __device__ __forceinline__ void mid(AccT&, const Unit&, int, int, int, int) const {}
    __device__ __forceinline__ void operator()(const AccT& acc, const Unit& u, int wr, int wc, int fr, int fq) const {
        const int row0 = u.pm * BM + wr * 64 + fr, col0 = u.pn * BM + wc * 32 + 8 * fq;
        float scv[2][4];
#pragma unroll
        for (int ai = 0; ai < 2; ++ai)
#pragma unroll
            for (int m = 0; m < 4; ++m) { f32x2 t = (f32x2){0.f, 0.f}; if (ssq_row) t = *(const f32x2*)(ssq_row + (size_t)(row0 + ai * HALF + m * 16) * 4); scv[ai][m] = t[0] + t[1]; }
#pragma unroll
        for (int ai = 0; ai < 2; ++ai) {
            u32x4 xi[4][2];
#pragma unroll
            for (int m = 0; m < 4; ++m)
#pragma unroll
                for (int bj = 0; bj < 2; ++bj) xi[m][bj] = *(const u32x4*)(xb + (size_t)(row0 + ai * HALF + m * 16) * DM + col0 + bj * HALF);
#pragma unroll
            for (int m = 0; m < 4; ++m) {
                const int row = row0 + ai * HALF + m * 16; const size_t off = (size_t)row * DM + col0; float s = 0.f;
                const float sc = ssq_row ? scale * rs_from_ssq(scv[ai][m], 1.0f / DSSM) : scale;
#pragma unroll
                for (int bj = 0; bj < 2; ++bj) { const u32x4 x = xi[m][bj]; const f32x4 o0 = bf4_lo(x) + acc[ai][bj][m][0] * sc, o1 = bf4_hi(x) + acc[ai][bj][m][1] * sc;
                    const f32x4 q = o0 * o0 + o1 * o1; s += (q[0] + q[1]) + (q[2] + q[3]);
                    *(u32x4*)(xb + off + bj * HALF) = pack8(o0, o1); }
                s += __shfl_xor(s, 16); s += __shfl_xor(s, 32);
                red_put(red, ai, wr, m, fr, wc, fq, s);
            }
        }
        red_flush<false>(red, ssq_out, u);
    }
};
struct EpiFinal {
    const bf16_t* xb; float* ssq_out; unsigned* cnt; const float* gn; float* out; LAS float* red;
    __device__ __forceinline__ void mid(AccT&, const Unit&, int, int, int, int) const {}
    __device__ __forceinline__ void operator()(const AccT& acc, const Unit& u, int wr, int wc, int fr, int fq) const {
        const int row0 = u.pm * BM + wr * 64 + fr, col0 = u.pn * BM + wc * 32 + 8 * fq;
#pragma unroll
        for (int ai = 0; ai < 2; ++ai) {
            u32x4 xi[4][2];
#pragma unroll
            for (int m = 0; m < 4; ++m)
#pragma unroll
                for (int bj = 0; bj < 2; ++bj) xi[m][bj] = *(const u32x4*)(xb + (size_t)(row0 + ai * HALF + m * 16) * DM + col0 + bj * HALF);
#pragma unroll
            for (int m = 0; m < 4; ++m) { float s = 0.f;
#pragma unroll
                for (int bj = 0; bj < 2; ++bj) { const u32x4 x = xi[m][bj]; const f32x4 o0 = bf4_lo(x) + acc[ai][bj][m][0] * 0.5f, o1 = bf4_hi(x) + acc[ai][bj][m][1] * 0.5f;
                    const f32x4 q = o0 * o0 + o1 * o1; s += (q[0] + q[1]) + (q[2] + q[3]); }
                s += __shfl_xor(s, 16); s += __shfl_xor(s, 32);
                red_put(red, ai, wr, m, fr, wc, fq, s);
            }
        }
        red_flush<true>(red, ssq_out, u);
        asm volatile("s_waitcnt vmcnt(0)" ::: "memory");
        unsigned* cw = cnt + 64 * u.pm;
        if ((threadIdx.x & 63) == 0 && threadIdx.x < 256) __hip_atomic_fetch_add(cw, 1u, __ATOMIC_RELAXED, __HIP_MEMORY_SCOPE_AGENT);
        { unsigned sp = 0;
          while ((unsigned)__builtin_amdgcn_readfirstlane(__hip_atomic_load(cw, __ATOMIC_RELAXED, __HIP_MEMORY_SCOPE_AGENT)) < 16u) { __builtin_amdgcn_s_sleep(2); if (++sp > (1u << 20)) break; } }
        __builtin_amdgcn_fence(__ATOMIC_ACQUIRE, "agent");
        f32x4 gv[2][2];
#pragma unroll
        for (int bj = 0; bj < 2; ++bj)
#pragma unroll
            for (int n = 0; n < 2; ++n) gv[bj][n] = *(const f32x4*)(gn + col0 + bj * HALF + n * 4);
#pragma unroll
        for (int ai = 0; ai < 2; ++ai) {
            u32x4 xi[4][2]; float sq[4];
#pragma unroll
            for (int m = 0; m < 4; ++m) { const float* pp = ssq_out + (size_t)(row0 + ai * HALF + m * 16) * 4;
                sq[m] = (__hip_atomic_load(pp, __ATOMIC_RELAXED, __HIP_MEMORY_SCOPE_AGENT) + __hip_atomic_load(pp + 1, __ATOMIC_RELAXED, __HIP_MEMORY_SCOPE_AGENT)) + (__hip_atomic_load(pp + 2, __ATOMIC_RELAXED, __HIP_MEMORY_SCOPE_AGENT) + __hip_atomic_load(pp + 3, __ATOMIC_RELAXED, __HIP_MEMORY_SCOPE_AGENT));
#pragma unroll
                for (int bj = 0; bj < 2; ++bj) xi[m][bj] = *(const u32x4*)(xb + (size_t)(row0 + ai * HALF + m * 16) * DM + col0 + bj * HALF); }
#pragma unroll
            for (int m = 0; m < 4; ++m) { const float rs = rs_from_ssq(sq[m], 1.0f / DM); float* orow = out + (size_t)(row0 + ai * HALF + m * 16) * DM + col0;
#pragma unroll
                for (int bj = 0; bj < 2; ++bj) { const u32x4 x = xi[m][bj];
                    *(f32x4*)(orow + bj * HALF) = (bf4_lo(x) + acc[ai][bj][m][0] * 0.5f) * (gv[bj][0] * rs); *(f32x4*)(orow + bj * HALF + 4) = (bf4_hi(x) + acc[ai][bj][m][1] * 0.5f) * (gv[bj][1] * rs); }
            }
        }
    }
};
struct EpiWin {
    const float* ssq; bf16_t* app; bf16_t* qkv; const float* ropec; const float* ropes;
    __device__ __forceinline__ void mid(AccT&, const Unit&, int, int, int, int) const {}
    __device__ __forceinline__ void operator()(const AccT& acc, const Unit& u, int wr, int wc, int fr, int fq) const {
        const int row0 = u.pm * BM + wr * 64 + fr;
        const bool rope_w = (u.pn >= 2) && ((wc & 1) == 0);
        float rsv[2][4];
#pragma unroll
        for (int ai = 0; ai < 2; ++ai)
#pragma unroll
            for (int m = 0; m < 4; ++m) rsv[ai][m] = sum4(*(const f32x4*)(ssq + (size_t)(row0 + ai * HALF + m * 16) * 4));
#pragma unroll
        for (int ai = 0; ai < 2; ++ai)
#pragma unroll
            for (int mh = 0; mh < 2; ++mh) {
                f32x4 csv[2][2], snv[2][2];
                if (rope_w) {
#pragma unroll
                    for (int mm = 0; mm < 2; ++mm) { const int pos = (row0 + ai * HALF + (2 * mh + mm) * 16) & (SEQ - 1);
#pragma unroll
                        for (int n = 0; n < 2; ++n) { csv[mm][n] = *(const f32x4*)(ropec + pos * 8 + 4 * n); snv[mm][n] = *(const f32x4*)(ropes + pos * 8 + 4 * n); } }
                } else {
#pragma unroll
                    for (int mm = 0; mm < 2; ++mm)
#pragma unroll
                        for (int n = 0; n < 2; ++n) { csv[mm][n] = (f32x4){1.f, 1.f, 1.f, 1.f}; snv[mm][n] = (f32x4){0.f, 0.f, 0.f, 0.f}; }
                }
#pragma unroll
                for (int mm = 0; mm < 2; ++mm) {
                    const int m = 2 * mh + mm, row = row0 + ai * HALF + m * 16; const float rs = rs_from_ssq(rsv[ai][m], 1.0f / DM);
#pragma unroll
                    for (int bj = 0; bj < 2; ++bj) {
                        const int col = u.pn * BM + bj * HALF + wc * 32 + 8 * fq; f32x4 v0 = acc[ai][bj][m][0] * rs, v1 = acc[ai][bj][m][1] * rs;
                        bf16_t* p;
                        if (u.pn < 2) { const int g = col >> 4, c = col & 15; p = app + ((size_t)(g * NBN + (row >> 5)) * KY + (row & 31) * NCH + c); }
                        else {
                            const bool is_v = (u.pn == 4 && bj == 1);
                            if (!is_v && rope_w) {
                                f32x4 p0, p1;
#pragma unroll
                                for (int j = 0; j < 4; ++j) { p0[j] = __shfl_xor(v0[j], 16); p1[j] = __shfl_xor(v1[j], 16); }
                                if (fq == 0) { v0 = v0 * csv[mm][0] - p0 * snv[mm][0]; v1 = v1 * csv[mm][1] - p1 * snv[mm][1]; }
                                else if (fq == 1) { v0 = v0 * csv[mm][0] + p0 * snv[mm][0]; v1 = v1 * csv[mm][1] + p1 * snv[mm][1]; }
                            }
                            p = qkv + (size_t)row * 768 + (col - 512);
                        }
                        u32x4 w; w.x = cvt_pk_bf16(v0[0], v0[1]); w.y = cvt_pk_bf16(v0[2], v0[3]); w.z = cvt_pk_bf16(v1[0], v1[1]); w.w = cvt_pk_bf16(v1[2], v1[3]); *(u32x4*)p = w;
                    }
                }
            }
    }
};
struct EpiS1 {
    float* sloc;
    __device__ __forceinline__ void mid(AccT&, const Unit&, int, int, int, int) const {}
    __device__ __forceinline__ void operator()(const AccT& acc, const Unit& u, int wr, int wc, int fr, int fq) const {
        const int row0 = u.pm * BM + wr * 64 + fr, col0 = wc * 32 + 8 * fq;
#pragma unroll
        for (int ai = 0; ai < 2; ++ai)
#pragma unroll
            for (int m = 0; m < 4; ++m) { float* rowp = sloc + (size_t)(row0 + ai * HALF + m * 16) * 128 + col0;
#pragma unroll
                for (int n = 0; n < 2; ++n) *(f32x4*)(rowp + n * 4) = acc[ai][0][m][n]; }
    }
};
struct EpiY {
    const bf16_t* app; const float* Dv; bf16_t* ygelu;
    __device__ __forceinline__ void mid(AccT&, const Unit&, int, int, int, int) const {}
    __device__ __forceinline__ void operator()(const AccT& acc, const Unit& u, int wr, int wc, int fr, int fq) const {
        const int row0 = u.pm * BM + wr * 64 + fr, g = u.pm >> 2, colb = (u.pn & 1) * BM + wc * 32 + 8 * fq, c0 = 8 * (fq & 1);
        const f32x4 d0 = *(const f32x4*)(Dv + g * NCH + c0), d1 = *(const f32x4*)(Dv + g * NCH + c0 + 4);
#pragma unroll
        for (int ai = 0; ai < 2; ++ai) {
            u32x4 uw[4][2];
#pragma unroll
            for (int m = 0; m < 4; ++m)
#pragma unroll
                for (int bj = 0; bj < 2; ++bj) uw[m][bj] = *(const u32x4*)(app + (size_t)(row0 + ai * HALF + m * 16) * KY + colb + bj * HALF);
#pragma unroll
            for (int m = 0; m < 4; ++m) {
                const int row = row0 + ai * HALF + m * 16, nidx = row & (NBN - 1);
#pragma unroll
                for (int bj = 0; bj < 2; ++bj) {
                    const int colg = colb + bj * HALF, t = colg >> 4; const u32x4 w0 = uw[m][bj];
                    const f32x4 y0 = gelu_tanh_v(acc[ai][bj][m][0] + d0 * bf4_lo(w0)), y1 = gelu_tanh_v(acc[ai][bj][m][1] + d1 * bf4_hi(w0));
                    *(u32x4*)(ygelu + (size_t)(nidx * TCH + t) * DSSM + g * NCH + c0) = pack8(y0, y1);
                }
            }
        }
    }
};
struct EpiGlu {
    const bf16_t* ygelu; const float* bias; bf16_t* ycat; float* ssq_out; LAS float* red;
    __device__ __forceinline__ void mid(AccT&, const Unit&, int, int, int, int) const {}
    __device__ __forceinline__ void operator()(const AccT& acc, const Unit& u, int wr, int wc, int fr, int fq) const {
        const int row0 = u.pm * BM + wr * 64 + fr, col0 = u.pn * BM + wc * 32 + 8 * fq;
        f32x4 bv[2][2];
#pragma unroll
        for (int bj = 0; bj < 2; ++bj)
#pragma unroll
            for (int n = 0; n < 2; ++n) bv[bj][n] = *(const f32x4*)(bias + col0 + bj * HALF + n * 4);
#pragma unroll
        for (int ai = 0; ai < 2; ++ai) {
            u32x4 yv[4][2];
#pragma unroll
            for (int m = 0; m < 4; ++m)
#pragma unroll
                for (int bj = 0; bj < 2; ++bj) yv[m][bj] = *(const u32x4*)(ygelu + (size_t)(row0 + ai * HALF + m * 16) * DSSM + col0 + bj * HALF);
#pragma unroll
            for (int m = 0; m < 4; ++m) {
                const int row = row0 + ai * HALF + m * 16; float s = 0.f;
#pragma unroll
                for (int bj = 0; bj < 2; ++bj) { const u32x4 yw = yv[m][bj];
                    const f32x4 z0 = bf4_lo(yw) * sigmoid_v(acc[ai][bj][m][0] + bv[bj][0]), z1 = bf4_hi(yw) * sigmoid_v(acc[ai][bj][m][1] + bv[bj][1]);
                    const f32x4 q = z0 * z0 + z1 * z1; s += (q[0] + q[1]) + (q[2] + q[3]);
                    *(u32x4*)(ycat + (size_t)row * DM + col0 + bj * HALF) = pack8(z0, z1); }
                s += __shfl_xor(s, 16); s += __shfl_xor(s, 32);
                red_put(red, ai, wr, m, fr, wc, fq, s);
            }
        }
        red_flush<false>(red, ssq_out, u);
    }
};

#define XB_TMO      128
#define XB_XCNT(j)  (256  + 64 * (j))
#define XB_XSUB(j)  (1280 + 64 * (j))
#define XB_XGEN(j)  (2304 + 64 * (j))
#define XB_TOP      3328
#define XB_TOPGEN   3392
#define XCD_BAR_WORDS 3456
#define XB_SPIN_CAP (1u << 18)
__device__ __forceinline__ unsigned xb_ld(unsigned* p)              { return __hip_atomic_load(p, __ATOMIC_RELAXED, __HIP_MEMORY_SCOPE_AGENT); }
__device__ __forceinline__ unsigned xb_add(unsigned* p, unsigned v) { return __hip_atomic_fetch_add(p, v, __ATOMIC_RELAXED, __HIP_MEMORY_SCOPE_AGENT); }
__device__ __forceinline__ unsigned xb_xcc_id() { return (unsigned)__builtin_amdgcn_s_getreg((3 << 11) | 20) & 0xFu; }
#define XB_SPIN(cond, bar) do { unsigned _sp = 0; while (cond) { __builtin_amdgcn_s_sleep(1); \
    if ((++_sp & 255u) == 0u) { if (xb_ld(&(bar)[XB_TMO])) break; if (_sp > XB_SPIN_CAP) { atomicAdd(&(bar)[XB_TMO], 1u); break; } } } } while (0)
struct XcdBarrier { unsigned* bar; unsigned x; volatile LAS unsigned* st; };
__device__ __forceinline__ XcdBarrier xcd_barrier_post(unsigned* bar, volatile LAS unsigned* st) {
    XcdBarrier b; b.bar = bar; b.x = xb_xcc_id(); b.st = st;
    if (threadIdx.x == 0) (void)xb_add(&bar[XB_XCNT(b.x)], 1u);
    return b;
}
__device__ __forceinline__ void xcd_barrier_complete(unsigned* bar, unsigned x, unsigned& nloc, unsigned& nx) {
    const unsigned G = gridDim.x * gridDim.y * gridDim.z;
    unsigned sum, cnt, mine, sp = 0u;
    for (;;) {
        sum = 0u; cnt = 0u; mine = 0u;
#pragma unroll
        for (unsigned j = 0; j < 16; ++j) { const unsigned c = xb_ld(&bar[XB_XCNT(j)]); sum += c; cnt += (c > 0u) ? 1u : 0u; mine = (j == x) ? c : mine; }
        if (sum == G) break;
        __builtin_amdgcn_s_sleep(1);
        if ((++sp & 255u) == 0u) { if (xb_ld(&bar[XB_TMO])) break; if (sp > XB_SPIN_CAP) { atomicAdd(&bar[XB_TMO], 1u); break; } }
    }
    nloc = mine > 0u ? mine : 1u; nx = cnt > 0u ? cnt : 1u;
}
__device__ __forceinline__ void xcd_barrier(const XcdBarrier& b) {
    asm volatile("s_waitcnt vmcnt(0)" ::: "memory");
    __syncthreads();
    if (threadIdx.x == 0) {
        unsigned* bar = b.bar;
        __builtin_amdgcn_s_waitcnt(0);
        unsigned nloc = b.st[0], nx = b.st[1];
        if (nloc == 0u) { xcd_barrier_complete(bar, b.x, nloc, nx); b.st[0] = nloc; b.st[1] = nx; }
        const unsigned old = xb_add(&bar[XB_XSUB(b.x)], 1u);
        const unsigned gen = old / nloc;
        if (old + 1u == (gen + 1u) * nloc) {
            __builtin_amdgcn_fence(__ATOMIC_RELEASE, "agent");
            asm volatile("s_waitcnt vmcnt(0)" ::: "memory");
            const unsigned og = xb_add(&bar[XB_TOP], 1u);
            const unsigned tg = og / nx;
            if (og + 1u == (tg + 1u) * nx) xb_add(&bar[XB_TOPGEN], 1u);
            else XB_SPIN(xb_ld(&bar[XB_TOPGEN]) == tg, bar);
            __builtin_amdgcn_fence(__ATOMIC_ACQUIRE, "agent");
            xb_add(&bar[XB_XGEN(b.x)], 1u);
            asm volatile("s_waitcnt vmcnt(0)" ::: "memory");
        } else {
            XB_SPIN(xb_ld(&bar[XB_XGEN(b.x)]) == gen, bar);
            __builtin_amdgcn_fence(__ATOMIC_ACQUIRE, "agent");
            asm volatile("s_waitcnt vmcnt(0)" ::: "memory");
        }
    }
    __syncthreads();
}

struct Ctx {
    const float* in[26]; float* out; unsigned char* ws; LAS unsigned char* lds; int tid, lane, wave, G, bx;
    __device__ __forceinline__ const float* inp(int i) const { return in[i]; }
};
#define WSP(T, off) ((T*)(C.ws + (off)))

__device__ __forceinline__ void transpose_item(const float* W, int K, int N, bf16_t* WT, const float* g0, const float* g1, int ksplit, int mode, LAS float* scr, int item, int lane) {
    const int nblk = N / 32, kb = item / nblk, nb = item % nblk, k0 = 64 * kb, n0 = 32 * nb;
#pragma unroll
    for (int i = 0; i < 8; ++i) { const int kk = 8 * i + (lane >> 3), k = k0 + kk, n4 = (lane & 7) * 4; const float gs = g0 ? (k < ksplit ? g0[k] : g1[k - ksplit]) : 1.0f;
        const f32x4 v = __builtin_nontemporal_load((const f32x4*)(W + (size_t)k * N + n0 + n4)); LAS float* d = scr + kk * 33 + n4; d[0] = v[0] * gs; d[1] = v[1] * gs; d[2] = v[2] * gs; d[3] = v[3] * gs; }
    asm volatile("s_waitcnt lgkmcnt(0)" ::: "memory");
    const int c = lane & 7;
#pragma unroll
    for (int j = 0; j < 4; ++j) { const int n = (lane >> 3) + 8 * j, ncol = n0 + n; const LAS float* s = scr + (8 * c) * 33 + n;
        const int drow = (mode == 0) ? ncol : (((ncol >> 7) << 8) + (ncol & 127) + (mode == 2 ? 128 : 0));
        u32x4 o; o.x = cvt_pk_bf16(s[0 * 33], s[1 * 33]); o.y = cvt_pk_bf16(s[2 * 33], s[3 * 33]); o.z = cvt_pk_bf16(s[4 * 33], s[5 * 33]); o.w = cvt_pk_bf16(s[6 * 33], s[7 * 33]);
        *(u32x4*)(WT + (size_t)drow * K + k0 + 8 * c) = o; }
    asm volatile("s_waitcnt lgkmcnt(0)" ::: "memory");
}

__device__ __forceinline__ float wave_sum(float v) {
#pragma unroll
    for (int o = 1; o < 64; o <<= 1) v += __shfl_xor(v, o);
    return v;
}

__device__ __forceinline__ void phase_prep0(const Ctx& C) {
    const int gw = C.wave * C.G + C.bx, NGW = C.G * NWAVES;
    const int gt = C.bx * NTHREADS + C.tid, NGT = C.G * NTHREADS;
    float* ssq = WSP(float, WS_SSQ);
    {
        const float* x = C.inp(0); bf16_t* xb = WSP(bf16_t, WS_XB);
        for (int row = gw; row < M_TOK; row += NGW) {
            const f32x4* xr = (const f32x4*)(x + (size_t)row * DM) + C.lane; f32x4 v[4]; float s = 0.f;
#pragma unroll
            for (int j = 0; j < 4; ++j) { v[j] = __builtin_nontemporal_load(xr + 64 * j); s += (v[j][0] * v[j][0] + v[j][1] * v[j][1]) + (v[j][2] * v[j][2] + v[j][3] * v[j][3]); }
            s = wave_sum(s);
            u32x2* o8 = (u32x2*)(xb + (size_t)row * DM) + C.lane;
#pragma unroll
            for (int j = 0; j < 4; ++j) { u32x2 w; w.x = cvt_pk_bf16(v[j][0], v[j][1]); w.y = cvt_pk_bf16(v[j][2], v[j][3]); o8[64 * j] = w; }
            if (C.lane == 0) *(f32x4*)(ssq + (size_t)row * 4) = (f32x4){s, 0.f, 0.f, 0.f};
        }
    }
    for (int i = gt; i < 128 * 64; i += NGT) ssq[5 * SSQ_STRIDE + i] = 0.f;
    {
        LAS float* scr = (LAS float*)(C.lds + C.wave * 16384);
        constexpr int I_GU = (DM / 64) * (DFF / 32), I_DN = (DFF / 64) * (DM / 32), I_IN = (DM / 64) * (DIN / 32), I_OUT = (DM / 64) * (DM / 32), I_GLU = (DSSM / 64) * (DSSM / 32);
        constexpr int NITEMS = 2 * I_GU + I_DN + I_IN;
        for (int it = gw; it < NITEMS; it += NGW) {
            int r = it;
            if (r < I_GU) { transpose_item(C.inp(2), DM, DFF, WSP(bf16_t, WS_WGU1), C.inp(1), C.inp(1), DM, 1, scr, r, C.lane); continue; } r -= I_GU;
            if (r < I_GU) { transpose_item(C.inp(3), DM, DFF, WSP(bf16_t, WS_WGU1), C.inp(1), C.inp(1), DM, 2, scr, r, C.lane); continue; } r -= I_GU;
            if (r < I_DN) { transpose_item(C.inp(4), DFF, DM, WSP(bf16_t, WS_WD1), nullptr, nullptr, 0, 0, scr, r, C.lane); continue; } r -= I_DN;
            transpose_item(C.inp(6), DM, DIN, WSP(bf16_t, WS_WIN), C.inp(5), C.inp(5), DM, 0, scr, r, C.lane);
        }
    }
    {
        float* rc = WSP(float, WS_ROPE); float* rsn = rc + SEQ * 8;
        for (int i = gt; i < SEQ * 8; i += NGT) {
            const int pos = i >> 3, k = i & 7;
            const double f = (k == 0) ? 1.0 : (k == 1) ? 0.19392274474868576 : (k == 2) ? 0.03760603093086393 : (k == 3) ? 0.007292664737217109 : (k == 4) ? 0.001414213562373095 : (k == 5) ? 0.0002742481756762073 : (k == 6) ? 5.318295896944988e-05 : 1.031338537721246e-05;
            const double xx = (double)pos * f; const double kk = __builtin_rint(xx * 0.15915494309189535); const float r = (float)(xx - kk * 6.283185307179586);
            rc[i] = cosf(r); rsn[i] = sinf(r);
        }
    }
    {
        f32x2* pw = WSP(f32x2, WS_PW); f32x2* bbar = WSP(f32x2, WS_BBAR);
        for (int i = gt; i < NG * NP * PWN; i += NGT) {
            const int gp = i / PWN, d = i - gp * PWN, g = gp >> 6; const float are = C.inp(7)[gp], aim = C.inp(8)[gp], dt = expf(C.inp(9)[g]);
            const double xx = (double)aim * (double)dt * (double)d; const double kk = __builtin_rint(xx * 0.15915494309189535); const float r = (float)(xx - kk * 6.283185307179586);
            const float mag = expf(are * dt * (float)d); pw[i] = (f32x2){mag * cosf(r), mag * sinf(r)};
        }
        for (int i = gt; i < NG * NP * NCH; i += NGT) {
            const int gp = i >> 4, g = gp >> 6; const float are = C.inp(7)[gp], aim = C.inp(8)[gp], dt = expf(C.inp(9)[g]);
            const double xx = (double)aim * (double)dt; const double kk = __builtin_rint(xx * 0.15915494309189535); const float r = (float)(xx - kk * 6.283185307179586);
            const float mag = expf(are * dt), l1r = mag * cosf(r), l1i = mag * sinf(r);
            const float nr = l1r - 1.0f, ni = l1i, den = 1.0f / (are * are + aim * aim); const float zr = (nr * are + ni * aim) * den, zi = (ni * are - nr * aim) * den;
            const float br = C.inp(10)[i], bi = C.inp(11)[i]; bbar[i] = (f32x2){zr * br - zi * bi, zr * bi + zi * br};
        }
    }
}
__device__ __forceinline__ void weights_late_item(const Ctx& C, int it) {
    LAS float* scr = (LAS float*)(C.lds + C.wave * 16384);
    constexpr int I_GU = (DM / 64) * (DFF / 32), I_DN = (DFF / 64) * (DM / 32), I_OUT = (DM / 64) * (DM / 32), I_GLU = (DSSM / 64) * (DSSM / 32);
    static_assert(2 * I_GU + I_DN + I_OUT + I_GLU == 256 * 19, "late weight items: 19 per workgroup");
    int r = it;
    if (r < I_GU) { transpose_item(C.inp(22), DM, DFF, WSP(bf16_t, WS_WGU2), C.inp(21), C.inp(21), DM, 1, scr, r, C.lane); return; } r -= I_GU;
    if (r < I_GU) { transpose_item(C.inp(23), DM, DFF, WSP(bf16_t, WS_WGU2), C.inp(21), C.inp(21), DM, 2, scr, r, C.lane); return; } r -= I_GU;
    if (r < I_DN) { transpose_item(C.inp(24), DFF, DM, WSP(bf16_t, WS_WD2), nullptr, nullptr, 0, 0, scr, r, C.lane); return; } r -= I_DN;
    if (r < I_OUT) { transpose_item(C.inp(20), DM, DM, WSP(bf16_t, WS_WOUT), C.inp(18), C.inp(19), DSSM, 0, scr, r, C.lane); return; } r -= I_OUT;
    transpose_item(C.inp(15), DSSM, DSSM, WSP(bf16_t, WS_WGLU), nullptr, nullptr, 0, 0, scr, r, C.lane);
}
__device__ __forceinline__ void phase_prep1(const Ctx& C) {
    LAS float* L = (LAS float*)C.lds;
    LAS float* Cr = L; LAS float* Ci = L + 1024; LAS f32x2* Bb = (LAS f32x2*)(L + 2048); LAS f32x2* Pw = (LAS f32x2*)(L + 4096);
    const f32x2* pw = WSP(f32x2, WS_PW); const f32x2* bbar = WSP(f32x2, WS_BBAR); float* ktab = WSP(float, WS_KTAB);
    constexpr int per = 4;
    const int base = (C.bx & 255) * per, g = base >> 5, d0 = base & 31;
    __syncthreads();
    for (int i = C.tid; i < 1024; i += NTHREADS) { Cr[i] = C.inp(12)[g * 1024 + i]; Ci[i] = C.inp(13)[g * 1024 + i]; Bb[i] = bbar[g * 1024 + i]; }
    for (int i = C.tid; i < per * 64; i += NTHREADS) { const int k = i >> 6, p = i & 63; Pw[i] = pw[(size_t)(g * 64 + p) * PWN + d0 + k]; }
    __syncthreads();
    const int half = C.tid >> 8, t = C.tid & 255, cp = t >> 4, c = t & 15;
#pragma unroll 1
    for (int k = half; k < per; k += 2) {
        float s = 0.f;
#pragma unroll 4
        for (int p = 0; p < NP; ++p) { const float cr = Cr[cp * 64 + p], ci = Ci[cp * 64 + p]; const f32x2 w = Pw[k * 64 + p], b = Bb[p * 16 + c];
            const float xr = cr * w.x - ci * w.y, xi = cr * w.y + ci * w.x; s += xr * b.x - xi * b.y; }
        ktab[(size_t)(base + k) * 256 + t] = s;
    }
    __syncthreads();
}
__device__ __forceinline__ void phase_prep2(const Ctx& C, int gt, int NGT) {
    const f32x2* pw = WSP(f32x2, WS_PW); const f32x2* bbar = WSP(f32x2, WS_BBAR); const float* ktab = WSP(float, WS_KTAB);
    bf16_t* bty = WSP(bf16_t, WS_BTY); bf16_t* bts1 = WSP(bf16_t, WS_BTS1);
    for (int q = gt; q < NG * K1 * (KY / 8); q += NGT) {
        const int row = q / (KY / 8), ck = q % (KY / 8), g = row >> 9, t = (row >> 4) & 31, cp = row & 15, k0 = ck * 8; float v[8];
        if (k0 < K1) { const int tau = k0 >> 4, c0 = k0 & 15;
            if (t >= tau) { const f32x4* kp = (const f32x4*)(ktab + ((size_t)((g * TCH + (t - tau)) * 16 + cp) * 16 + c0)); const f32x4 a = kp[0], b = kp[1];
                v[0] = a[0]; v[1] = a[1]; v[2] = a[2]; v[3] = a[3]; v[4] = b[0]; v[5] = b[1]; v[6] = b[2]; v[7] = b[3]; }
            else {
#pragma unroll
                for (int e = 0; e < 8; ++e) v[e] = 0.f; }
        } else { const int p0 = (k0 - K1) >> 1;
#pragma unroll
            for (int e = 0; e < 4; ++e) { const int p = p0 + e; const float cr = C.inp(12)[(g * 16 + cp) * 64 + p], ci = C.inp(13)[(g * 16 + cp) * 64 + p]; const f32x2 w = pw[(size_t)(g * 64 + p) * PWN + t + 1];
                v[2 * e] = cr * w.x - ci * w.y; v[2 * e + 1] = -(cr * w.y + ci * w.x); }
        }
        u32x4 o; o.x = cvt_pk_bf16(v[0], v[1]); o.y = cvt_pk_bf16(v[2], v[3]); o.z = cvt_pk_bf16(v[4], v[5]); o.w = cvt_pk_bf16(v[6], v[7]);
        *(u32x4*)(bty + (size_t)row * KY + k0) = o;
    }
    for (int q = gt; q < NG * 128 * (K1 / 8); q += NGT) {
        const int g = q / (128 * 64), p2 = (q >> 6) & 127, ck = q & 63, k0 = ck * 8, tau = k0 >> 4, c0 = k0 & 15, part = p2 & 1, p = p2 >> 1;
        const f32x2 w = pw[(size_t)(g * 64 + p) * PWN + (TCH - 1 - tau)]; float v[8];
#pragma unroll
        for (int e = 0; e < 8; ++e) { const f32x2 b = bbar[(g * 64 + p) * 16 + c0 + e]; v[e] = part == 0 ? (w.x * b.x - w.y * b.y) : (w.x * b.y + w.y * b.x); }
        u32x4 o; o.x = cvt_pk_bf16(v[0], v[1]); o.y = cvt_pk_bf16(v[2], v[3]); o.z = cvt_pk_bf16(v[4], v[5]); o.w = cvt_pk_bf16(v[6], v[7]);
        *(u32x4*)(bts1 + (size_t)(g * 256 + p2) * K1 + k0) = o;
    }
}
__device__ __forceinline__ void carry_task(const Ctx& C, int b, int g) {
    const f32x2* pw = WSP(f32x2, WS_PW); const float* sloc = WSP(float, WS_SLOC); bf16_t* app = WSP(bf16_t, WS_APP);
    const int p = C.lane; const f32x2 lt = pw[(size_t)(g * 64 + p) * PWN + TCH];
    float sr = 0.f, si = 0.f;
    const size_t row0 = (size_t)g * NBN + b * NCK;
#pragma unroll 1
    for (int c0 = 0; c0 < NCK; c0 += 16) {
        f32x2 l[16];
#pragma unroll
        for (int j = 0; j < 16; ++j) l[j] = *(const f32x2*)(sloc + (row0 + c0 + j) * 128 + 2 * p);
#pragma unroll
        for (int j = 0; j < 16; ++j) {
            const size_t row = row0 + c0 + j;
            *(unsigned*)(app + row * KY + K1 + 2 * p) = cvt_pk_bf16(sr, si);
            const float nr = lt.x * sr - lt.y * si + l[j].x, ni = lt.x * si + lt.y * sr + l[j].y; sr = nr; si = ni;
        }
    }
}
typedef float f32x16 __attribute__((ext_vector_type(16)));
#define MFMA32(a, b, c) __builtin_amdgcn_mfma_f32_32x32x16_bf16((a), (b), (c), 0, 0, 0)
__device__ __forceinline__ bf16x8 pack8_mfma(const f32x16& x, int s) {
    u32x4 p; p[0] = cvt_pk_bf16(x[8 * s], x[8 * s + 1]); p[1] = cvt_pk_bf16(x[8 * s + 2], x[8 * s + 3]); p[2] = cvt_pk_bf16(x[8 * s + 4], x[8 * s + 5]); p[3] = cvt_pk_bf16(x[8 * s + 6], x[8 * s + 7]);
    return __builtin_bit_cast(bf16x8, p);
}
__device__ __forceinline__ void phase_attn(const Ctx& C) {
    constexpr int KROW = 144, KSZ = 256 * KROW, VROW = 528, VSZ = 64 * VROW, V_OFF = 2 * KSZ;
    static_assert(V_OFF + 2 * VSZ <= LDS_BYTES, "attention LDS");
    const bf16_t* qkv = WSP(bf16_t, WS_QKV); bf16_t* ycat = WSP(bf16_t, WS_YCAT); const float* ssq_ssm = WSP(float, WS_SSQ) + 2 * SSQ_STRIDE;
    LAS unsigned char* lds = C.lds; const int tid = C.tid, lane = C.lane, wave = C.wave;
    for (int it0 = C.bx; it0 < BATCH * 32; it0 += C.G) {
        const int item = (C.G == 256) ? (((it0 & 7) << 5) | (it0 >> 3)) : it0;
        const int b = item >> 5, nb = item & 31, tok0 = b * SEQ + nb * 128; const long kbase = (long)tok0 - 128;
        __syncthreads();
#pragma unroll
        for (int i = 0; i < 8; ++i) { const int c = tid + NTHREADS * i, part = c & 7, sk = (c >> 3) & 255, kvh = c >> 11;
            if (nb > 0 || sk >= 128) { const u32x4 v = *(const u32x4*)(qkv + (size_t)(kbase + sk) * 768 + 512 + kvh * 64 + part * 8); *(LAS u32x4*)(lds + kvh * KSZ + sk * KROW + part * 16) = v; } }
#pragma unroll
        for (int i = 0; i < 4; ++i) { const int c = tid + NTHREADS * i, sp = c & 127, part = (c >> 7) & 7, kvh = c >> 10, sk = 2 * sp;
            if (nb > 0 || sk >= 128) { const bf16_t* vp = qkv + (size_t)(kbase + sk) * 768 + 640 + kvh * 64 + part * 8; const u32x4 v0 = *(const u32x4*)vp, v1 = *(const u32x4*)(vp + 768);
                LAS unsigned char* dst = lds + V_OFF + kvh * VSZ + (part * 8) * VROW + sp * 4;
#pragma unroll
                for (int e = 0; e < 4; ++e) { const unsigned a0 = v0[e], a1 = v1[e];
                    *(LAS unsigned*)(dst + (2 * e) * VROW) = (a0 & 0xffffu) | (a1 << 16); *(LAS unsigned*)(dst + (2 * e + 1) * VROW) = (a0 >> 16) | (a1 & 0xffff0000u); } } }
        __syncthreads();
        const int q0 = wave * 16, ql = lane & 15, hl = (lane >> 4) & 1, h = lane >> 5, a = q0 >> 5, qrel = (q0 & 31) + ql, l31 = lane & 31;
        const int tok = tok0 + q0 + ql;
        float ssq_acc = 0.f;
#pragma unroll 1
        for (int hp = 0; hp < 4; ++hp) {
            const int kvh = hp >> 1, head = 2 * hp + hl;
            bf16x8 qf[4];
#pragma unroll
            for (int ks = 0; ks < 4; ++ks) qf[ks] = *(const bf16x8*)(qkv + (size_t)tok * 768 + head * 64 + 16 * ks + 8 * h);
            f32x16 sc[5];
#pragma unroll
            for (int j = 0; j < 5; ++j) {
#pragma unroll
                for (int r = 0; r < 16; ++r) sc[j][r] = 0.f;
                const int st = a + j;
                if (nb > 0 || st >= 4) {
#pragma unroll
                    for (int ks = 0; ks < 4; ++ks) { const bf16x8 kf = *(const LAS bf16x8*)(lds + kvh * KSZ + (32 * st + l31) * KROW + (16 * ks + 8 * h) * 2); sc[j] = MFMA32(kf, qf[ks], sc[j]); }
                }
            }
            const float sink = C.inp(17)[head] * 1.4426950409f; float mx = sink;
#pragma unroll
            for (int j = 0; j < 5; ++j) { const bool tv = (nb > 0) || (a + j >= 4);
#pragma unroll
                for (int r = 0; r < 16; ++r) { const int cr = (r & 3) + 8 * (r >> 2) + 4 * h; bool ok = tv; if (j == 0) ok = ok && (cr > qrel); if (j == 4) ok = ok && (cr <= qrel);
                    const float t = ok ? sc[j][r] * 0.18033688011f : -1e30f; sc[j][r] = t; mx = fmaxf(mx, t); } }
            mx = fmaxf(mx, __shfl_xor(mx, 32));
            float lsum = 0.f;
#pragma unroll
            for (int j = 0; j < 5; ++j)
#pragma unroll
                for (int r = 0; r < 16; ++r) { const float p = __builtin_amdgcn_exp2f(sc[j][r] - mx); sc[j][r] = p; lsum += p; }
            lsum += __shfl_xor(lsum, 32); lsum += __builtin_amdgcn_exp2f(sink - mx);
            f32x16 o[2];
#pragma unroll
            for (int r = 0; r < 16; ++r) { o[0][r] = 0.f; o[1][r] = 0.f; }
#pragma unroll
            for (int j = 0; j < 5; ++j) { const int st = a + j;
                if (nb > 0 || st >= 4) {
#pragma unroll
                    for (int ks = 0; ks < 2; ++ks) { const bf16x8 pb = pack8_mfma(sc[j], ks);
#pragma unroll
                        for (int dt = 0; dt < 2; ++dt) { const LAS unsigned char* vp = lds + V_OFF + kvh * VSZ + (32 * dt + l31) * VROW + (32 * st + 16 * ks + 4 * h) * 2;
                            const u32x2 x0 = *(const LAS u32x2*)vp, x1 = *(const LAS u32x2*)(vp + 16); u32x4 xv; xv.x = x0.x; xv.y = x0.y; xv.z = x1.x; xv.w = x1.y;
                            o[dt] = MFMA32(__builtin_bit_cast(bf16x8, xv), pb, o[dt]); } }
                }
            }
            const float inv = __builtin_amdgcn_rcpf(lsum);
#pragma unroll
            for (int dt = 0; dt < 2; ++dt) {
                u32x2 w[4];
#pragma unroll
                for (int g4 = 0; g4 < 4; ++g4) { const float v0 = o[dt][4 * g4] * inv, v1 = o[dt][4 * g4 + 1] * inv, v2 = o[dt][4 * g4 + 2] * inv, v3 = o[dt][4 * g4 + 3] * inv;
                    ssq_acc += (v0 * v0 + v1 * v1) + (v2 * v2 + v3 * v3);
                    w[g4].x = cvt_pk_bf16(v0, v1); w[g4].y = cvt_pk_bf16(v2, v3); }
#pragma unroll
                for (int k = 0; k < 4; k += 2) {
                    const auto rx = __builtin_amdgcn_permlane32_swap(w[k].x, w[k + 1].x, false, false); const auto ry = __builtin_amdgcn_permlane32_swap(w[k].y, w[k + 1].y, false, false);
                    u32x4 q; q.x = rx[0]; q.y = ry[0]; q.z = rx[1]; q.w = ry[1];
                    *(u32x4*)(ycat + (size_t)tok * DM + 512 + head * 64 + 32 * dt + 8 * k + 8 * h) = q; }
            }
        }
        ssq_acc += __shfl_xor(ssq_acc, 16); ssq_acc += __shfl_xor(ssq_acc, 32);
        const float rs = rsqrtf(ssq_acc * (1.0f / 512.0f) + EPS) * sqrtf((ssq_ssm[(size_t)tok * 4] + ssq_ssm[(size_t)tok * 4 + 1]) * (1.0f / 512.0f) + EPS);
#pragma unroll 1
        for (int hp = 0; hp < 4; ++hp)
#pragma unroll
            for (int dt = 0; dt < 2; ++dt)
#pragma unroll
                for (int k = 0; k < 4; k += 2) { u32x4* p = (u32x4*)(ycat + (size_t)tok * DM + 512 + (2 * hp + hl) * 64 + 32 * dt + 8 * k + 8 * h); const u32x4 w0 = *p;
                    u32x4 w; w.x = cvt_pk_bf16(bf_lo(w0.x) * rs, bf_hi(w0.x) * rs); w.y = cvt_pk_bf16(bf_lo(w0.y) * rs, bf_hi(w0.y) * rs); w.z = cvt_pk_bf16(bf_lo(w0.z) * rs, bf_hi(w0.z) * rs); w.w = cvt_pk_bf16(bf_lo(w0.w) * rs, bf_hi(w0.w) * rs); *p = w; }
    }
    __syncthreads();
}

constexpr int N_PHASES = 12;
__global__ void __launch_bounds__(NTHREADS, 2) mk_fwd(const float* p0, const float* p1, const float* p2, const float* p3, const float* p4, const float* p5, const float* p6, const float* p7, const float* p8, const float* p9, const float* p10, const float* p11, const float* p12, const float* p13, const float* p14, const float* p15, const float* p16, const float* p17, const float* p18, const float* p19, const float* p20, const float* p21, const float* p22, const float* p23, const float* p24, const float* p25, float* out_p, unsigned char* ws_p, int ph_lo, int ph_hi) {
    extern __shared__ __attribute__((aligned(16))) unsigned char lds_raw[];
    Ctx C; C.in[0] = p0; C.in[1] = p1; C.in[2] = p2; C.in[3] = p3; C.in[4] = p4; C.in[5] = p5; C.in[6] = p6; C.in[7] = p7; C.in[8] = p8; C.in[9] = p9; C.in[10] = p10; C.in[11] = p11; C.in[12] = p12; C.in[13] = p13; C.in[14] = p14; C.in[15] = p15; C.in[16] = p16; C.in[17] = p17; C.in[18] = p18; C.in[19] = p19; C.in[20] = p20; C.in[21] = p21; C.in[22] = p22; C.in[23] = p23; C.in[24] = p24; C.in[25] = p25; C.out = out_p; C.ws = ws_p; C.lds = (LAS unsigned char*)lds_raw;
    C.tid = threadIdx.x; C.lane = C.tid & 63; C.wave = __builtin_amdgcn_readfirstlane(C.tid >> 6); C.G = gridDim.x; C.bx = blockIdx.x;
    const int lo = ph_lo, hi = ph_hi;
#define IN(k) (lo <= (k) && (k) < hi)
#define SEAM(k) do { if (IN(k) && IN((k) + 1)) { xcd_barrier(xbar); } } while (0)
    volatile LAS unsigned* xst = (volatile LAS unsigned*)(C.lds + LDS_BYTES - 16);
    if (C.tid == 0) { xst[0] = 0u; xst[1] = 0u; }
    __syncthreads();
    const XcdBarrier xbar = xcd_barrier_post(WSP(unsigned, WS_BAR), xst);
    float* ssq = WSP(float, WS_SSQ); LAS float* red = (LAS float*)(C.lds + RED_OFF);
    if (IN(0)) { phase_prep0(C); __syncthreads(); }
    SEAM(0);
    if (IN(1)) {
        phase_prep1(C);
        pg8::Gemm g{WSP(bf16_t, WS_XB), WSP(bf16_t, WS_WGU1), DM, DM, DM}; pg8::StaticOrder S; S.init(M_TOK, 2 * DFF, C.G, C.bx);
        EpiGateUp E{ssq, WSP(bf16_t, WS_ACT)}; pg8::gemm_phase<EpiGateUp, pg8::StaticOrder, true>(C.lds, g, S, E);
    }
    SEAM(1);
    if (IN(2)) {
        pg8::Gemm g{WSP(bf16_t, WS_ACT), WSP(bf16_t, WS_WD1), DFF, DFF, DFF}; pg8::StaticOrder S; S.init(M_TOK, DM, C.G, C.bx);
        EpiResid E{WSP(bf16_t, WS_XB), ssq + SSQ_STRIDE, 0.5f, nullptr, red}; pg8::gemm_phase<EpiResid, pg8::StaticOrder, true>(C.lds, g, S, E);
    }
    SEAM(2);
    if (IN(3)) {
        pg8::Gemm g{WSP(bf16_t, WS_XB), WSP(bf16_t, WS_WIN), DM, DM, DM}; pg8::StaticOrder S; S.init(M_TOK, DIN, C.G, C.bx);
        EpiWin E{ssq + SSQ_STRIDE, WSP(bf16_t, WS_APP), WSP(bf16_t, WS_QKV), WSP(float, WS_ROPE), WSP(float, WS_ROPE) + SEQ * 8}; pg8::gemm_phase<EpiWin, pg8::StaticOrder, true>(C.lds, g, S, E);
        if (C.G <= 128) phase_prep2(C, C.bx * NTHREADS + C.tid, C.G * NTHREADS);
        else if (C.bx >= 128) phase_prep2(C, (C.bx - 128) * NTHREADS + C.tid, (C.G - 128) * NTHREADS);
    }
    SEAM(3);
    if (IN(4)) {
        { const int it = C.bx & 255;
            const int pm = it >> 1, g = pm >> 2;
            __syncthreads();
            { pg8::Gemm g1{WSP(bf16_t, WS_APP), WSP(bf16_t, WS_BTS1), KY, K1, K1}; pg8::OneUnit S{pm, g}; EpiS1 E{WSP(float, WS_SLOC)}; pg8::gemm_phase<EpiS1, pg8::OneUnit, true, true>(C.lds, g1, S, E); }
            asm volatile("s_waitcnt vmcnt(0)" ::: "memory"); __syncthreads();
            if (C.wave < 2) carry_task(C, 2 * (pm & 3) + C.wave, g);
            if (C.wave >= 2) {
#pragma unroll 1
                for (int j = C.wave - 2; j < 18; j += 6) weights_late_item(C, it * 19 + j);
            } else if (C.wave == 0) weights_late_item(C, it * 19 + 18);
            asm volatile("s_waitcnt vmcnt(0)" ::: "memory"); __syncthreads();
            { pg8::Gemm gy{WSP(bf16_t, WS_APP), WSP(bf16_t, WS_BTY), KY, KY, KY}; pg8::OneUnit S{pm, 2 * g + (it & 1)}; EpiY E{WSP(bf16_t, WS_APP), C.inp(14), WSP(bf16_t, WS_YGELU)}; pg8::gemm_phase<EpiY, pg8::OneUnit, true>(C.lds, gy, S, E); }
        }
    }
    SEAM(4);
    if (IN(7)) {
        pg8::Gemm g{WSP(bf16_t, WS_YGELU), WSP(bf16_t, WS_WGLU), DSSM, DSSM, DSSM}; pg8::StaticOrder S; S.init(M_TOK, DSSM, C.G, C.bx);
        EpiGlu E{WSP(bf16_t, WS_YGELU), C.inp(16), WSP(bf16_t, WS_YCAT), ssq + 2 * SSQ_STRIDE, red}; pg8::gemm_phase<EpiGlu, pg8::StaticOrder, true>(C.lds, g, S, E);
    }
    SEAM(7);
    if (IN(8)) { phase_attn(C); }
    SEAM(8);
    if (IN(9)) {
        pg8::Gemm g{WSP(bf16_t, WS_YCAT), WSP(bf16_t, WS_WOUT), DM, DM, DM}; pg8::StaticOrder S; S.init(M_TOK, DM, C.G, C.bx);
        EpiResid E{WSP(bf16_t, WS_XB), ssq + 3 * SSQ_STRIDE, 1.0f, ssq + 2 * SSQ_STRIDE, red}; pg8::gemm_phase<EpiResid, pg8::StaticOrder, true>(C.lds, g, S, E);
    }
    SEAM(9);
    if (IN(10)) {
        pg8::Gemm g{WSP(bf16_t, WS_XB), WSP(bf16_t, WS_WGU2), DM, DM, DM}; pg8::StaticOrder S; S.init(M_TOK, 2 * DFF, C.G, C.bx);
        EpiGateUp E{ssq + 3 * SSQ_STRIDE, WSP(bf16_t, WS_ACT)}; pg8::gemm_phase<EpiGateUp, pg8::StaticOrder, true>(C.lds, g, S, E);
    }
    SEAM(10);
    if (IN(11)) {
        pg8::Gemm g{WSP(bf16_t, WS_ACT), WSP(bf16_t, WS_WD2), DFF, DFF, DFF}; pg8::StaticOrder S; S.init(M_TOK, DM, C.G, C.bx);
        EpiFinal E{WSP(bf16_t, WS_XB), ssq + 4 * SSQ_STRIDE, (unsigned*)(ssq + 5 * SSQ_STRIDE), C.inp(25), C.out, red}; pg8::gemm_phase<EpiFinal, pg8::StaticOrder, true>(C.lds, g, S, E);
    }
#undef IN
#undef SEAM
}

extern "C" void kernel_launch(void* const* d_in, const int* in_sizes, int n_in, void* d_out, int out_size, void* d_ws, size_t ws_size, hipStream_t stream) {
    static int grid = 0;
    if (grid == 0) {
        if (n_in != 26 || out_size != M_TOK * DM || ws_size < WS_END) { fprintf(stderr, "kernel_launch: unexpected shapes (n_in %d out %d ws %zu)\n", n_in, out_size, ws_size); grid = -1; return; }
        int dev = 0, cus = 0, per_cu = 0;
        hipGetDevice(&dev); hipDeviceGetAttribute(&cus, hipDeviceAttributeMultiprocessorCount, dev);
        if (hipFuncSetAttribute((const void*)mk_fwd, hipFuncAttributeMaxDynamicSharedMemorySize, LDS_BYTES) != hipSuccess) { fprintf(stderr, "kernel_launch: hipFuncSetAttribute failed\n"); grid = -1; return; }
        hipOccupancyMaxActiveBlocksPerMultiprocessor(&per_cu, (const void*)mk_fwd, NTHREADS, LDS_BYTES);
        if (per_cu < 1) { fprintf(stderr, "kernel_launch: occupancy query says %d blocks/CU\n", per_cu); per_cu = 1; }
        (void)hipGetLastError();
        grid = cus;
    }
    if (grid < 0) return;
    const float* ip[26]; for (int i = 0; i < 26; ++i) ip[i] = (const float*)d_in[i];
    float* outp = (float*)d_out; unsigned char* wsp = (unsigned char*)d_ws; int lo = 0, hi = N_PHASES;
    (void)hipMemsetAsync((unsigned char*)d_ws + WS_BAR, 0, XCD_BAR_WORDS * sizeof(unsigned), stream);
    void* kargs[30]; for (int i = 0; i < 26; ++i) kargs[i] = (void*)&ip[i];
    kargs[26] = (void*)&outp; kargs[27] = (void*)&wsp; kargs[28] = (void*)&lo; kargs[29] = (void*)&hi;
    hipError_t e = hipLaunchCooperativeKernel((const void*)mk_fwd, dim3(grid), dim3(NTHREADS), kargs, LDS_BYTES, stream);
    if (e != hipSuccess) fprintf(stderr, "kernel_launch: cooperative launch failed: %s (grid %d)\n", hipGetErrorString(e), grid);
}
```

```cpp
#include <hip/hip_runtime.h>
#include <hip/hip_cooperative_groups.h>
#include <cstdio>
#include <cstdint>
namespace cg = cooperative_groups;

#define LAS __attribute__((address_space(3)))
#define GAS __attribute__((address_space(1)))
typedef unsigned short bf16_t;
typedef short bf16x8 __attribute__((ext_vector_type(8)));
typedef float f32x4 __attribute__((ext_vector_type(4)));
typedef float f32x2 __attribute__((ext_vector_type(2)));
typedef unsigned u32x4 __attribute__((ext_vector_type(4)));
typedef unsigned u32x2 __attribute__((ext_vector_type(2)));

constexpr int BATCH = 8, SEQ = 4096, M_TOK = BATCH * SEQ, DM = 1024, DFF = 2816, DIN = 1280, DSSM = 512;
constexpr int NG = 32, NP = 64, NCH = 16;
constexpr int TCH = 32, NCK = SEQ / TCH, NBN = BATCH * NCK;
constexpr int K1 = TCH * NCH;
constexpr int KY = K1 + 2 * NP;
constexpr int PWN = TCH + 1;
constexpr float EPS = 1e-6f;
constexpr int NTHREADS = 512, NWAVES = 8;
constexpr int LDS_BYTES = 147456;
constexpr int RED_OFF = 131072;
constexpr size_t SSQ_STRIDE = 4 * (size_t)32768;

constexpr size_t MiB = 1024 * 1024;
constexpr size_t WS_XB = 0;
constexpr size_t WS_ACT = 64 * MiB;
constexpr size_t WS_APP = WS_ACT;
constexpr size_t WS_QKV = WS_ACT + 40 * MiB;
constexpr size_t WS_YGELU = WS_ACT + 88 * MiB;
constexpr size_t WS_SLOC = WS_ACT + 120 * MiB;
constexpr size_t WS_YCAT = 240 * MiB;
constexpr size_t WS_WGU1 = 304 * MiB, WS_WD1 = 315 * MiB, WS_WGU2 = 321 * MiB, WS_WD2 = 332 * MiB;
constexpr size_t WS_WIN = 338 * MiB, WS_WOUT = 341 * MiB, WS_WGLU = 343 * MiB;
constexpr size_t WS_BTY = 344 * MiB;
constexpr size_t WS_BTS1 = 364 * MiB;
constexpr size_t WS_PW = 372 * MiB;
constexpr size_t WS_BBAR = 373 * MiB;
constexpr size_t WS_KTAB = 374 * MiB;
constexpr size_t WS_SSQ = 380 * MiB;
constexpr size_t WS_ROPE = 377 * MiB;
constexpr size_t WS_BAR = 378 * MiB;
constexpr size_t WS_END = 384 * MiB;


typedef __bf16 bf16x2_t __attribute__((ext_vector_type(2)));
__device__ __forceinline__ unsigned cvt_pk_bf16(float lo, float hi) { const f32x2 v = {lo, hi}; return __builtin_bit_cast(unsigned, __builtin_convertvector(v, bf16x2_t)); }
__device__ __forceinline__ float bf_lo(unsigned w) { return __uint_as_float(w << 16); }
__device__ __forceinline__ float bf_hi(unsigned w) { return __uint_as_float(w & 0xffff0000u); }
__device__ __forceinline__ float bf2f(bf16_t b) { return __uint_as_float(((unsigned)b) << 16); }
__device__ __forceinline__ bf16_t f2bf(float f) { return (bf16_t)(cvt_pk_bf16(f, 0.f) & 0xffffu); }
__device__ __forceinline__ float gelu_tanh(float v) { const float z = -2.3022081198f * (v + 0.044715f * v * v * v); return v * __builtin_amdgcn_rcpf(1.0f + __builtin_amdgcn_exp2f(z)); }
__device__ __forceinline__ float sigmoidf_(float v) { return __builtin_amdgcn_rcpf(1.0f + __builtin_amdgcn_exp2f(-1.4426950409f * v)); }
__device__ __forceinline__ f32x4 bf4_lo(const u32x4 x) { return (f32x4){bf_lo(x.x), bf_hi(x.x), bf_lo(x.y), bf_hi(x.y)}; }
__device__ __forceinline__ f32x4 bf4_hi(const u32x4 x) { return (f32x4){bf_lo(x.z), bf_hi(x.z), bf_lo(x.w), bf_hi(x.w)}; }
__device__ __forceinline__ f32x4 exp2_v(const f32x4 t) { return (f32x4){__builtin_amdgcn_exp2f(t[0]), __builtin_amdgcn_exp2f(t[1]), __builtin_amdgcn_exp2f(t[2]), __builtin_amdgcn_exp2f(t[3])}; }
__device__ __forceinline__ f32x4 rcp_v(const f32x4 t) { return (f32x4){__builtin_amdgcn_rcpf(t[0]), __builtin_amdgcn_rcpf(t[1]), __builtin_amdgcn_rcpf(t[2]), __builtin_amdgcn_rcpf(t[3])}; }
__device__ __forceinline__ f32x4 sigmoid_v(const f32x4 a) { return rcp_v(exp2_v(a * -1.4426950409f) + 1.0f); }
__device__ __forceinline__ f32x4 gelu_tanh_v(const f32x4 v) { const f32x4 z = v * ((v * v) * -0.1029432397f + -2.3022081198f); return v * rcp_v(exp2_v(z) + 1.0f); }
__device__ __forceinline__ u32x4 pack8(const f32x4 a, const f32x4 b) { u32x4 w; w.x = cvt_pk_bf16(a[0], a[1]); w.y = cvt_pk_bf16(a[2], a[3]); w.z = cvt_pk_bf16(b[0], b[1]); w.w = cvt_pk_bf16(b[2], b[3]); return w; }
__device__ __forceinline__ float rs_from_ssq(float ssq, float inv_n) { return __builtin_amdgcn_rsqf(ssq * inv_n + EPS); }

namespace pg8 {
constexpr int BM = 256, BK = 64, HALF = 128, HTB = HALF * BK * 2, STAGE_BYTES = 8 * HTB, NXCD = 8, WGM = 8;
__host__ __device__ __forceinline__ int lds_byte(int r, int c) { const int st = (r >> 4) * 2 + (c >> 5), rr = r & 15, cc = c & 31, ob = rr * 64 + cc * 2; return st * 1024 + (ob ^ (((ob >> 9) & 1) << 5)); }
__host__ __device__ __forceinline__ int perm32(int rho) { const int n = rho >> 4, i = rho & 15; return 8 * (i >> 2) + 4 * n + (i & 3); }
__host__ __device__ __forceinline__ void stage_rc(int b, int& R, int& C) { const int st = b / 1024, sb = b % 1024, swz = sb ^ (((sb >> 9) & 1) << 5); R = (st >> 1) * 16 + swz / 64; C = (st & 1) * 32 + (swz % 64) / 2; }

struct Unit { int pm, pn, ka, kb, part; };
struct Gemm { const bf16_t* A; const bf16_t* Bt; int lda, ldb, K; };

struct StaticOrder {
    int nM, nN, nwg, G, c;
    __device__ void init(int M, int N, int G_, int c_) { nM = M / BM; nN = N / BM; nwg = nM * nN; G = G_; c = c_; }
    __device__ bool next(int i, Unit& u) const {
        const long L = (long)i * G + c; if (L >= nwg) return false;
        int wgid = (int)L; { const int q = nwg / NXCD, r = nwg % NXCD, xcd = wgid % NXCD, off = wgid / NXCD; wgid = (xcd < r ? xcd * (q + 1) : r * (q + 1) + (xcd - r) * q) + off; }
        const int nig = WGM * nN, gid = wgid / nig, fm = gid * WGM, gsz = (nM - fm) < WGM ? (nM - fm) : WGM;
        u.pm = fm + ((wgid % nig) % gsz); u.pn = (wgid % nig) / gsz; u.ka = 0; u.kb = 0; u.part = 0; return true;
    }
};
struct OneUnit { int pm, pn;
    __device__ bool next(int i, Unit& u) const { if (i) return false; u.pm = pm; u.pn = pn; u.ka = 0; u.kb = 0; u.part = 0; return true; } };
struct SplitOrder { StaticOrder so;
    __device__ bool next(int i, Unit& u) const { if (!so.next(i >> 1, u)) return false; u.ka = u.kb = (i & 1) * 512; u.part = (i & 1) ? 0 : 1; return true; } };

template <class Epi, class Sched, bool PERM = false, bool HALF_N = false>
__device__ __forceinline__ void gemm_phase(LAS unsigned char* lds, const Gemm g, const Sched& S, const Epi& E) {
    const int tid = threadIdx.x, wid = __builtin_amdgcn_readfirstlane(tid >> 6), lane = tid & 63, wr = wid >> 2, wc = wid & 3, fr = lane & 15, fq = lane >> 4;
    const int nt = g.K / BK;
    unsigned voffA[2], voffB[2];
#pragma unroll
    for (int i = 0; i < 2; ++i) { int R, C; stage_rc(tid * 16 + i * 8192, R, C); const int Rb = PERM ? ((R & ~31) + perm32(R & 31)) : R; voffA[i] = (unsigned)(R * g.lda + C) * 2u; voffB[i] = (unsigned)(Rb * g.ldb + C) * 2u; }
    const size_t kstep = (size_t)(BK * 2);
    const size_t hA = (size_t)HALF * g.lda * 2, hB = (size_t)HALF * g.ldb * 2, tA = 2 * hA, tB = 2 * hB;
    const unsigned ldsw = (unsigned)wid * 1024u;
    const int aoff = lds_byte(wr * 64 + fr, fq * 8), boff = lds_byte(wc * 32 + fr, fq * 8);
#define PG8_SA(b, h) (((b) * 2 + (h)) * HTB)
#define PG8_SB(b, h) ((4 + (b) * 2 + (h)) * HTB)
#define PG8_STAGE(bufoff, gbase, voff) do { _Pragma("unroll") for (int _i = 0; _i < 2; ++_i) \
        __builtin_amdgcn_global_load_lds((const unsigned*)((const char*)(gbase) + (voff)[_i]), (LAS unsigned*)(lds + (bufoff) + ldsw + _i * 8192), 16, 0, 0); } while (0)
#define PG8_LDA(dst, b, h) do { _Pragma("unroll") for (int m = 0; m < 4; ++m) _Pragma("unroll") for (int k = 0; k < 2; ++k) dst[m][k] = *(const LAS bf16x8*)(lds + PG8_SA(b, h) + aoff + m * 2048 + k * 1024); } while (0)
#define PG8_LDB(dst, b, h) do { _Pragma("unroll") for (int n = 0; n < 2; ++n) _Pragma("unroll") for (int k = 0; k < 2; ++k) dst[n][k] = *(const LAS bf16x8*)(lds + PG8_SB(b, h) + boff + n * 2048 + k * 1024); } while (0)
#define PG8_MMA(ai, bj, At, Bt) do { __builtin_amdgcn_s_setprio(1); _Pragma("unroll") for (int m = 0; m < 4; ++m) _Pragma("unroll") for (int n = 0; n < 2; ++n) _Pragma("unroll") for (int k = 0; k < 2; ++k) \
        acc[ai][bj][m][n] = __builtin_amdgcn_mfma_f32_16x16x32_bf16(Bt[n][k], At[m][k], acc[ai][bj][m][n], 0, 0, 0); __builtin_amdgcn_s_setprio(0); } while (0)
#define PG8_WAIT_V(n) asm volatile("s_waitcnt vmcnt(" #n ")" ::: "memory")
#define PG8_WAIT_L(n) asm volatile("s_waitcnt lgkmcnt(" #n ")" ::: "memory")
#define PG8_BAR __builtin_amdgcn_s_barrier()
#define PG8_SCHED __builtin_amdgcn_sched_barrier(0)
    Unit cur, nxt; int ui = 0;
    if (!S.next(0, cur)) return;
    f32x4 acc[2][2][4][2];
#pragma unroll
    for (int a = 0; a < 2; ++a)
#pragma unroll
        for (int b = 0; b < 2; ++b)
#pragma unroll
            for (int m = 0; m < 4; ++m)
#pragma unroll
                for (int n = 0; n < 2; ++n) acc[a][b][m][n] = (f32x4){0.f, 0.f, 0.f, 0.f};
    bf16x8 At[4][2], B0[2][2], B1[2][2];
    const char* cA = (const char*)g.A + (size_t)cur.pm * tA + (size_t)cur.ka * 2; const char* cB = (const char*)g.Bt + (size_t)cur.pn * tB + (size_t)cur.kb * 2;
    PG8_STAGE(PG8_SB(0, 0), cB, voffB); PG8_STAGE(PG8_SB(0, 1), cB + hB, voffB); PG8_STAGE(PG8_SA(0, 0), cA, voffA); PG8_STAGE(PG8_SA(0, 1), cA + hA, voffA);
    if (wr == 1) PG8_BAR;
    PG8_WAIT_V(2); PG8_BAR;
    PG8_STAGE(PG8_SB(1, 0), cB + kstep, voffB); PG8_STAGE(PG8_SA(1, 0), cA + kstep, voffA); PG8_STAGE(PG8_SB(1, 1), cB + hB + kstep, voffB);
    PG8_WAIT_V(6); PG8_BAR;
    for (;;) {
        const bool has_next = S.next(ui + 1, nxt);
        const char* nA = has_next ? (const char*)g.A + (size_t)nxt.pm * tA + (size_t)nxt.ka * 2 : cA; const char* nB = has_next ? (const char*)g.Bt + (size_t)nxt.pn * tB + (size_t)nxt.kb * 2 : cB;
        for (int t = 0; t < nt; t += 2) {
            const bool last = (t == nt - 2);
            const char* a1 = cA + (size_t)(t + 1) * kstep;
            const char* a2 = last ? nA : cA + (size_t)(t + 2) * kstep; const char* b2 = last ? nB : cB + (size_t)(t + 2) * kstep;
            const char* a3 = a2 + kstep; const char* b3 = b2 + kstep;
            PG8_LDB(B0, 0, 0); if constexpr (!HALF_N) PG8_LDB(B1, 0, 1); PG8_SCHED; PG8_LDA(At, 0, 0); PG8_STAGE(PG8_SA(1, 1), a1 + hA, voffA);
            PG8_WAIT_V(8); PG8_WAIT_L(0); PG8_BAR; PG8_MMA(0, 0, At, B0); if constexpr (!HALF_N) PG8_MMA(0, 1, At, B1); PG8_BAR; PG8_SCHED;
            PG8_LDA(At, 0, 1); PG8_STAGE(PG8_SB(0, 0), b2, voffB); PG8_STAGE(PG8_SB(0, 1), b2 + hB, voffB); PG8_STAGE(PG8_SA(0, 0), a2, voffA);
            PG8_WAIT_V(8); PG8_WAIT_L(0); PG8_BAR; PG8_MMA(1, 0, At, B0); if constexpr (!HALF_N) PG8_MMA(1, 1, At, B1); PG8_BAR; PG8_SCHED;
            PG8_LDB(B0, 1, 0); if constexpr (!HALF_N) PG8_LDB(B1, 1, 1); PG8_SCHED; PG8_LDA(At, 1, 0); PG8_STAGE(PG8_SA(0, 1), a2 + hA, voffA);
            PG8_WAIT_V(8); PG8_WAIT_L(0); PG8_BAR; PG8_MMA(0, 0, At, B0); if constexpr (!HALF_N) PG8_MMA(0, 1, At, B1); PG8_BAR; PG8_SCHED;
            PG8_LDA(At, 1, 1); PG8_STAGE(PG8_SB(1, 0), b3, voffB); PG8_STAGE(PG8_SB(1, 1), b3 + hB, voffB); PG8_STAGE(PG8_SA(1, 0), a3, voffA);
            PG8_WAIT_V(8); PG8_WAIT_L(0); PG8_BAR; PG8_MMA(1, 0, At, B0); if constexpr (!HALF_N) PG8_MMA(1, 1, At, B1); PG8_BAR; PG8_SCHED;
        }
        if (wr == 0) PG8_BAR;
        if (cur.part) { E.mid(acc, cur, wr, wc, fr, fq); }
        else {
            E(acc, cur, wr, wc, fr, fq);
            if (has_next) {
#pragma unroll
                for (int a = 0; a < 2; ++a)
#pragma unroll
                    for (int b = 0; b < 2; ++b)
#pragma unroll
                        for (int m = 0; m < 4; ++m)
#pragma unroll
                            for (int n = 0; n < 2; ++n) acc[a][b][m][n] = (f32x4){0.f, 0.f, 0.f, 0.f};
            }
        }
        if (!has_next) break;
        cur = nxt; cA = nA; cB = nB; ++ui;
        if (wr == 1) PG8_BAR;
    }
    PG8_WAIT_V(0);
    PG8_BAR;
#undef PG8_SA
#undef PG8_SB
#undef PG8_STAGE
#undef PG8_LDA
#undef PG8_LDB
#undef PG8_MMA
#undef PG8_WAIT_V
#undef PG8_WAIT_L
#undef PG8_BAR
#undef PG8_SCHED
}
}
using pg8::Unit; using pg8::HALF; using pg8::BM;

typedef f32x4 AccT[2][2][4][2];

__device__ __forceinline__ void red_put(LAS float* red, int ai, int wr, int m, int fr, int wc, int fq, float s) { if (fq == 0) red[(ai * HALF + wr * 64 + m * 16 + fr) * 4 + wc] = s; }
template <bool WT>
__device__ __forceinline__ void red_flush(LAS float* red, float* part, const Unit& u) {
    asm volatile("s_waitcnt lgkmcnt(0)" ::: "memory"); __builtin_amdgcn_s_barrier(); asm volatile("" ::: "memory");
    const int t = threadIdx.x;
    if (t < 256) { const f32x4 v = *(const LAS f32x4*)(red + t * 4); const float sum = (v[0] + v[1]) + (v[2] + v[3]); float* p = part + (size_t)(u.pm * BM + t) * 4 + u.pn;
        if (WT) __hip_atomic_store(p, sum, __ATOMIC_RELAXED, __HIP_MEMORY_SCOPE_AGENT); else *p = sum; }
}
__device__ __forceinline__ float sum4(const f32x4 v) { return (v[0] + v[1]) + (v[2] + v[3]); }
struct EpiGateUp {
    const float* ssq; bf16_t* act;
    __device__ __forceinline__ void mid(AccT&, const Unit&, int, int, int, int) const {}
    __device__ __forceinline__ void operator()(const AccT& acc, const Unit& u, int wr, int wc, int fr, int fq) const {
        const int row0 = u.pm * BM + wr * 64 + fr, col0 = u.pn * 128 + wc * 32 + 8 * fq;
        float rsv[2][4];
#pragma unroll
        for (int ai = 0; ai < 2; ++ai)
#pragma unroll
            for (int m = 0; m < 4; ++m) rsv[ai][m] = sum4(*(const f32x4*)(ssq + (size_t)(row0 + ai * HALF + m * 16) * 4));
#pragma unroll
        for (int ai = 0; ai < 2; ++ai)
#pragma unroll
            for (int m = 0; m < 4; ++m) {
                const int row = row0 + ai * HALF + m * 16; const float rs = rs_from_ssq(rsv[ai][m], 1.0f / DM), rs2 = rs * rs, nl = -1.4426950409f * rs;
                f32x4 a[2];
#pragma unroll
                for (int n = 0; n < 2; ++n) { const f32x4 ga = acc[ai][0][m][n], ua = acc[ai][1][m][n]; const f32x4 pr = (ga * ua) * rs2, tt = ga * nl; f32x4 e;
#pragma unroll
                    for (int j = 0; j < 4; ++j) e[j] = __builtin_amdgcn_exp2f(tt[j]);
                    e = e + 1.0f; f32x4 r;
#pragma unroll
                    for (int j = 0; j < 4; ++j) r[j] = __builtin_amdgcn_rcpf(e[j]);
                    a[n] = pr * r; }
                u32x4 w; w.x = cvt_pk_bf16(a[0][0], a[0][1]); w.y = cvt_pk_bf16(a[0][2], a[0][3]); w.z = cvt_pk_bf16(a[1][0], a[1][1]); w.w = cvt_pk_bf16(a[1][2], a[1][3]);
                *(u32x4*)(act + (size_t)row * DFF + col0) = w;
            }
    }
};
struct EpiResid {
    bf16_t* xb; float* ssq_out; float scale; const float* ssq_row; LAS float* red;
    __device__ __forceinline__ void mid(AccT&, const Unit&, int, int, int, int) const {}
    __device__ __forceinline__ void operator()(const AccT& acc, const Unit& u, int wr, int wc, int fr, int fq) const {
        const int row0 = u.pm * BM + wr * 64 + fr, col0 = u.pn * BM + wc * 32 + 8 * fq;
        float scv[2][4];
#pragma unroll
        for (int ai = 0; ai < 2; ++ai)
#pragma unroll
            for (int m = 0; m < 4; ++m) { f32x2 t = (f32x2){0.f, 0.f}; if (ssq_row) t = *(const f32x2*)(ssq_row + (size_t)(row0 + ai * HALF + m * 16) * 4); scv[ai][m] = t[0] + t[1]; }
#pragma unroll
        for (int ai = 0; ai < 2; ++ai) {
            u32x4 xi[4][2];
#pragma unroll
            for (int m = 0; m < 4; ++m)
#pragma unroll
                for (int bj = 0; bj < 2; ++bj) xi[m][bj] = *(const u32x4*)(xb + (size_t)(row0 + ai * HALF + m * 16) * DM + col0 + bj * HALF);
#pragma unroll
            for (int m = 0; m < 4; ++m) {
                const int row = row0 + ai * HALF + m * 16; const size_t off = (size_t)row * DM + col0; float s = 0.f;
                const float sc = ssq_row ? scale * rs_from_ssq(scv[ai][m], 1.0f / DSSM) : scale;
#pragma unroll
                for (int bj = 0; bj < 2; ++bj) { const u32x4 x = xi[m][bj]; const f32x4 o0 = bf4_lo(x) + acc[ai][bj][m][0] * sc, o1 = bf4_hi(x) + acc[ai][bj][m][1] * sc;
                    const f32x4 q = o0 * o0 + o1 * o1; s += (q[0] + q[1]) + (q[2] + q[3]);
                    *(u32x4*)(xb + off + bj * HALF) = pack8(o0, o1); }
                s += __shfl_xor(s, 16); s += __shfl_xor(s, 32);
                red_put(red, ai, wr, m, fr, wc, fq, s);
            }
        }
        red_flush<false>(red, ssq_out, u);
    }
};
struct EpiFinal {
    const bf16_t* xb; float* ssq_out; unsigned* cnt; const float* gn; float* out; LAS float* red;
    __device__ __forceinline__ void mid(AccT&, const Unit&, int, int, int, int) const {}
    __device__ __forceinline__ void operator()(const AccT& acc, const Unit& u, int wr, int wc, int fr, int fq) const {
        const int row0 = u.pm * BM + wr * 64 + fr, col0 = u.pn * BM + wc * 32 + 8 * fq;
#pragma unroll
        for (int ai = 0; ai < 2; ++ai) {
            u32x4 xi[4][2];
#pragma unroll
            for (int m = 0; m < 4; ++m)
#pragma unroll
                for (int bj = 0; bj < 2; ++bj) xi[m][bj] = *(const u32x4*)(xb + (size_t)(row0 + ai * HALF + m * 16) * DM + col0 + bj * HALF);
#pragma unroll
            for (int m = 0; m < 4; ++m) { float s = 0.f;
#pragma unroll
                for (int bj = 0; bj < 2; ++bj) { const u32x4 x = xi[m][bj]; const f32x4 o0 = bf4_lo(x) + acc[ai][bj][m][0] * 0.5f, o1 = bf4_hi(x) + acc[ai][bj][m][1] * 0.5f;
                    const f32x4 q = o0 * o0 + o1 * o1; s += (q[0] + q[1]) + (q[2] + q[3]); }
                s += __shfl_xor(s, 16); s += __shfl_xor(s, 32);
                red_put(red, ai, wr, m, fr, wc, fq, s);
            }
        }
        red_flush<true>(red, ssq_out, u);
        asm volatile("s_waitcnt vmcnt(0)" ::: "memory");
        unsigned* cw = cnt + 64 * u.pm;
        if ((threadIdx.x & 63) == 0 && threadIdx.x < 256) __hip_atomic_fetch_add(cw, 1u, __ATOMIC_RELAXED, __HIP_MEMORY_SCOPE_AGENT);
        { unsigned sp = 0;
          while ((unsigned)__builtin_amdgcn_readfirstlane(__hip_atomic_load(cw, __ATOMIC_RELAXED, __HIP_MEMORY_SCOPE_AGENT)) < 16u) { __builtin_amdgcn_s_sleep(2); if (++sp > (1u << 20)) break; } }
        __builtin_amdgcn_fence(__ATOMIC_ACQUIRE, "agent");
        f32x4 gv[2][2];
#pragma unroll
        for (int bj = 0; bj < 2; ++bj)
#pragma unroll
            for (int n = 0; n < 2; ++n) gv[bj][n] = *(const f32x4*)(gn + col0 + bj * HALF + n * 4);
#pragma unroll
        for (int ai = 0; ai < 2; ++ai) {
            u32x4 xi[4][2]; float sq[4];
#pragma unroll
            for (int m = 0; m < 4; ++m) { const float* pp = ssq_out + (size_t)(row0 + ai * HALF + m * 16) * 4;
                sq[m] = (__hip_atomic_load(pp, __ATOMIC_RELAXED, __HIP_MEMORY_SCOPE_AGENT) + __hip_atomic_load(pp + 1, __ATOMIC_RELAXED, __HIP_MEMORY_SCOPE_AGENT)) + (__hip_atomic_load(pp + 2, __ATOMIC_RELAXED, __HIP_MEMORY_SCOPE_AGENT) + __hip_atomic_load(pp + 3, __ATOMIC_RELAXED, __HIP_MEMORY_SCOPE_AGENT));
#pragma unroll
                for (int bj = 0; bj < 2; ++bj) xi[m][bj] = *(const u32x4*)(xb + (size_t)(row0 + ai * HALF + m * 16) * DM + col0 + bj * HALF); }
#pragma unroll
            for (int m = 0; m < 4; ++m) { const float rs = rs_from_ssq(sq[m], 1.0f / DM); float* orow = out + (size_t)(row0 + ai * HALF + m * 16) * DM + col0;
#pragma unroll
                for (int bj = 0; bj < 2; ++bj) { const u32x4 x = xi[m][bj];
                    *(f32x4*)(orow + bj * HALF) = (bf4_lo(x) + acc[ai][bj][m][0] * 0.5f) * (gv[bj][0] * rs); *(f32x4*)(orow + bj * HALF + 4) = (bf4_hi(x) + acc[ai][bj][m][1] * 0.5f) * (gv[bj][1] * rs); }
            }
        }
    }
};
struct EpiWin {
    const float* ssq; bf16_t* app; bf16_t* qkv; const float* ropec; const float* ropes;
    __device__ __forceinline__ void mid(AccT&, const Unit&, int, int, int, int) const {}
    __device__ __forceinline__ void operator()(const AccT& acc, const Unit& u, int wr, int wc, int fr, int fq) const {
        const int row0 = u.pm * BM + wr * 64 + fr;
        const bool rope_w = (u.pn >= 2) && ((wc & 1) == 0);
        float rsv[2][4];
#pragma unroll
        for (int ai = 0; ai < 2; ++ai)
#pragma unroll
            for (int m = 0; m < 4; ++m) rsv[ai][m] = sum4(*(const f32x4*)(ssq + (size_t)(row0 + ai * HALF + m * 16) * 4));
#pragma unroll
        for (int ai = 0; ai < 2; ++ai)
#pragma unroll
            for (int mh = 0; mh < 2; ++mh) {
                f32x4 csv[2][2], snv[2][2];
                if (rope_w) {
#pragma unroll
                    for (int mm = 0; mm < 2; ++mm) { const int pos = (row0 + ai * HALF + (2 * mh + mm) * 16) & (SEQ - 1);
#pragma unroll
                        for (int n = 0; n < 2; ++n) { csv[mm][n] = *(const f32x4*)(ropec + pos * 8 + 4 * n); snv[mm][n] = *(const f32x4*)(ropes + pos * 8 + 4 * n); } }
                } else {
#pragma unroll
                    for (int mm = 0; mm < 2; ++mm)
#pragma unroll
                        for (int n = 0; n < 2; ++n) { csv[mm][n] = (f32x4){1.f, 1.f, 1.f, 1.f}; snv[mm][n] = (f32x4){0.f, 0.f, 0.f, 0.f}; }
                }
#pragma unroll
                for (int mm = 0; mm < 2; ++mm) {
                    const int m = 2 * mh + mm, row = row0 + ai * HALF + m * 16; const float rs = rs_from_ssq(rsv[ai][m], 1.0f / DM);
#pragma unroll
                    for (int bj = 0; bj < 2; ++bj) {
                        const int col = u.pn * BM + bj * HALF + wc * 32 + 8 * fq; f32x4 v0 = acc[ai][bj][m][0] * rs, v1 = acc[ai][bj][m][1] * rs;
                        bf16_t* p;
                        if (u.pn < 2) { const int g = col >> 4, c = col & 15; p = app + ((size_t)(g * NBN + (row >> 5)) * KY + (row & 31) * NCH + c); }
                        else {
                            const bool is_v = (u.pn == 4 && bj == 1);
                            if (!is_v && rope_w) {
                                f32x4 p0, p1;
#pragma unroll
                                for (int j = 0; j < 4; ++j) { p0[j] = __shfl_xor(v0[j], 16); p1[j] = __shfl_xor(v1[j], 16); }
                                if (fq == 0) { v0 = v0 * csv[mm][0] - p0 * snv[mm][0]; v1 = v1 * csv[mm][1] - p1 * snv[mm][1]; }
                                else if (fq == 1) { v0 = v0 * csv[mm][0] + p0 * snv[mm][0]; v1 = v1 * csv[mm][1] + p1 * snv[mm][1]; }
                            }
                            p = qkv + (size_t)row * 768 + (col - 512);
                        }
                        u32x4 w; w.x = cvt_pk_bf16(v0[0], v0[1]); w.y = cvt_pk_bf16(v0[2], v0[3]); w.z = cvt_pk_bf16(v1[0], v1[1]); w.w = cvt_pk_bf16(v1[2], v1[3]); *(u32x4*)p = w;
                    }
                }
            }
    }
};
struct EpiS1 {
    float* sloc;
    __device__ __forceinline__ void mid(AccT&, const Unit&, int, int, int, int) const {}
    __device__ __forceinline__ void operator()(const AccT& acc, const Unit& u, int wr, int wc, int fr, int fq) const {
        const int row0 = u.pm * BM + wr * 64 + fr, col0 = wc * 32 + 8 * fq;
#pragma unroll
        for (int ai = 0; ai < 2; ++ai)
#pragma unroll
            for (int m = 0; m < 4; ++m) { float* rowp = sloc + (size_t)(row0 + ai * HALF + m * 16) * 128 + col0;
#pragma unroll
                for (int n = 0; n < 2; ++n) *(f32x4*)(rowp + n * 4) = acc[ai][0][m][n]; }
    }
};
struct EpiY {
    const bf16_t* app; const float* Dv; bf16_t* ygelu;
    __device__ __forceinline__ void mid(AccT&, const Unit&, int, int, int, int) const {}
    __device__ __forceinline__ void operator()(const AccT& acc, const Unit& u, int wr, int wc, int fr, int fq) const {
        const int row0 = u.pm * BM + wr * 64 + fr, g = u.pm >> 2, colb = (u.pn & 1) * BM + wc * 32 + 8 * fq, c0 = 8 * (fq & 1);
        const f32x4 d0 = *(const f32x4*)(Dv + g * NCH + c0), d1 = *(const f32x4*)(Dv + g * NCH + c0 + 4);
#pragma unroll
        for (int ai = 0; ai < 2; ++ai) {
            u32x4 uw[4][2];
#pragma unroll
            for (int m = 0; m < 4; ++m)
#pragma unroll
                for (int bj = 0; bj < 2; ++bj) uw[m][bj] = *(const u32x4*)(app + (size_t)(row0 + ai * HALF + m * 16) * KY + colb + bj * HALF);
#pragma unroll
            for (int m = 0; m < 4; ++m) {
                const int row = row0 + ai * HALF + m * 16, nidx = row & (NBN - 1);
#pragma unroll
                for (int bj = 0; bj < 2; ++bj) {
                    const int colg = colb + bj * HALF, t = colg >> 4; const u32x4 w0 = uw[m][bj];
                    const f32x4 y0 = gelu_tanh_v(acc[ai][bj][m][0] + d0 * bf4_lo(w0)), y1 = gelu_tanh_v(acc[ai][bj][m][1] + d1 * bf4_hi(w0));
                    *(u32x4*)(ygelu + (size_t)(nidx * TCH + t) * DSSM + g * NCH + c0) = pack8(y0, y1);
                }
            }
        }
    }
};
struct EpiGlu {
    const bf16_t* ygelu; const float* bias; bf16_t* ycat; float* ssq_out; LAS float* red;
    __device__ __forceinline__ void mid(AccT&, const Unit&, int, int, int, int) const {}
    __device__ __forceinline__ void operator()(const AccT& acc, const Unit& u, int wr, int wc, int fr, int fq) const {
        const int row0 = u.pm * BM + wr * 64 + fr, col0 = u.pn * BM + wc * 32 + 8 * fq;
        f32x4 bv[2][2];
#pragma unroll
        for (int bj = 0; bj < 2; ++bj)
#pragma unroll
            for (int n = 0; n < 2; ++n) bv[bj][n] = *(const f32x4*)(bias + col0 + bj * HALF + n * 4);
#pragma unroll
        for (int ai = 0; ai < 2; ++ai) {
            u32x4 yv[4][2];
#pragma unroll
            for (int m = 0; m < 4; ++m)
#pragma unroll
                for (int bj = 0; bj < 2; ++bj) yv[m][bj] = *(const u32x4*)(ygelu + (size_t)(row0 + ai * HALF + m * 16) * DSSM + col0 + bj * HALF);
#pragma unroll
            for (int m = 0; m < 4; ++m) {
                const int row = row0 + ai * HALF + m * 16; float s = 0.f;
#pragma unroll
                for (int bj = 0; bj < 2; ++bj) { const u32x4 yw = yv[m][bj];
                    const f32x4 z0 = bf4_lo(yw) * sigmoid_v(acc[ai][bj][m][0] + bv[bj][0]), z1 = bf4_hi(yw) * sigmoid_v(acc[ai][bj][m][1] + bv[bj][1]);
                    const f32x4 q = z0 * z0 + z1 * z1; s += (q[0] + q[1]) + (q[2] + q[3]);
                    *(u32x4*)(ycat + (size_t)row * DM + col0 + bj * HALF) = pack8(z0, z1); }
                s += __shfl_xor(s, 16); s += __shfl_xor(s, 32);
                red_put(red, ai, wr, m, fr, wc, fq, s);
            }
        }
        red_flush<false>(red, ssq_out, u);
    }
};

#define XB_TMO      128
#define XB_XCNT(j)  (256  + 64 * (j))
#define XB_XSUB(j)  (1280 + 64 * (j))
#define XB_XGEN(j)  (2304 + 64 * (j))
#define XB_TOP      3328
#define XB_TOPGEN   3392
#define XCD_BAR_WORDS 3456
#define XB_SPIN_CAP (1u << 18)
__device__ __forceinline__ unsigned xb_ld(unsigned* p)              { return __hip_atomic_load(p, __ATOMIC_RELAXED, __HIP_MEMORY_SCOPE_AGENT); }
__device__ __forceinline__ unsigned xb_add(unsigned* p, unsigned v) { return __hip_atomic_fetch_add(p, v, __ATOMIC_RELAXED, __HIP_MEMORY_SCOPE_AGENT); }
__device__ __forceinline__ unsigned xb_xcc_id() { return (unsigned)__builtin_amdgcn_s_getreg((3 << 11) | 20) & 0xFu; }
#define XB_SPIN(cond, bar) do { unsigned _sp = 0; while (cond) { __builtin_amdgcn_s_sleep(1); \
    if ((++_sp & 255u) == 0u) { if (xb_ld(&(bar)[XB_TMO])) break; if (_sp > XB_SPIN_CAP) { atomicAdd(&(bar)[XB_TMO], 1u); break; } } } } while (0)
struct XcdBarrier { unsigned* bar; unsigned x; volatile LAS unsigned* st; };
__device__ __forceinline__ XcdBarrier xcd_barrier_post(unsigned* bar, volatile LAS unsigned* st) {
    XcdBarrier b; b.bar = bar; b.x = xb_xcc_id(); b.st = st;
    if (threadIdx.x == 0) (void)xb_add(&bar[XB_XCNT(b.x)], 1u);
    return b;
}
__device__ __forceinline__ void xcd_barrier_complete(unsigned* bar, unsigned x, unsigned& nloc, unsigned& nx) {
    const unsigned G = gridDim.x * gridDim.y * gridDim.z;
    unsigned sum, cnt, mine, sp = 0u;
    for (;;) {
        sum = 0u; cnt = 0u; mine = 0u;
#pragma unroll
        for (unsigned j = 0; j < 16; ++j) { const unsigned c = xb_ld(&bar[XB_XCNT(j)]); sum += c; cnt += (c > 0u) ? 1u : 0u; mine = (j == x) ? c : mine; }
        if (sum == G) break;
        __builtin_amdgcn_s_sleep(1);
        if ((++sp & 255u) == 0u) { if (xb_ld(&bar[XB_TMO])) break; if (sp > XB_SPIN_CAP) { atomicAdd(&bar[XB_TMO], 1u); break; } }
    }
    nloc = mine > 0u ? mine : 1u; nx = cnt > 0u ? cnt : 1u;
}
__device__ __forceinline__ void xcd_barrier(const XcdBarrier& b) {
    asm volatile("s_waitcnt vmcnt(0)" ::: "memory");
    __syncthreads();
    if (threadIdx.x == 0) {
        unsigned* bar = b.bar;
        __builtin_amdgcn_s_waitcnt(0);
        unsigned nloc = b.st[0], nx = b.st[1];
        if (nloc == 0u) { xcd_barrier_complete(bar, b.x, nloc, nx); b.st[0] = nloc; b.st[1] = nx; }
        const unsigned old = xb_add(&bar[XB_XSUB(b.x)], 1u);
        const unsigned gen = old / nloc;
        if (old + 1u == (gen + 1u) * nloc) {
            __builtin_amdgcn_fence(__ATOMIC_RELEASE, "agent");
            asm volatile("s_waitcnt vmcnt(0)" ::: "memory");
            const unsigned og = xb_add(&bar[XB_TOP], 1u);
            const unsigned tg = og / nx;
            if (og + 1u == (tg + 1u) * nx) xb_add(&bar[XB_TOPGEN], 1u);
            else XB_SPIN(xb_ld(&bar[XB_TOPGEN]) == tg, bar);
            __builtin_amdgcn_fence(__ATOMIC_ACQUIRE, "agent");
            xb_add(&bar[XB_XGEN(b.x)], 1u);
            asm volatile("s_waitcnt vmcnt(0)" ::: "memory");
        } else {
            XB_SPIN(xb_ld(&bar[XB_XGEN(b.x)]) == gen, bar);
            __builtin_amdgcn_fence(__ATOMIC_ACQUIRE, "agent");
            asm volatile("s_waitcnt vmcnt(0)" ::: "memory");
        }
    }
    __syncthreads();
}

struct Ctx {
    const float* in[26]; float* out; unsigned char* ws; LAS unsigned char* lds; int tid, lane, wave, G, bx;
    __device__ __forceinline__ const float* inp(int i) const { return in[i]; }
};
#define WSP(T, off) ((T*)(C.ws + (off)))

__device__ __forceinline__ void transpose_item(const float* W, int K, int N, bf16_t* WT, const float* g0, const float* g1, int ksplit, int mode, LAS float* scr, int item, int lane) {
    const int nblk = N / 32, kb = item / nblk, nb = item % nblk, k0 = 64 * kb, n0 = 32 * nb;
#pragma unroll
    for (int i = 0; i < 8; ++i) { const int kk = 8 * i + (lane >> 3), k = k0 + kk, n4 = (lane & 7) * 4; const float gs = g0 ? (k < ksplit ? g0[k] : g1[k - ksplit]) : 1.0f;
        const f32x4 v = __builtin_nontemporal_load((const f32x4*)(W + (size_t)k * N + n0 + n4)); LAS float* d = scr + kk * 33 + n4; d[0] = v[0] * gs; d[1] = v[1] * gs; d[2] = v[2] * gs; d[3] = v[3] * gs; }
    asm volatile("s_waitcnt lgkmcnt(0)" ::: "memory");
    const int c = lane & 7;
#pragma unroll
    for (int j = 0; j < 4; ++j) { const int n = (lane >> 3) + 8 * j, ncol = n0 + n; const LAS float* s = scr + (8 * c) * 33 + n;
        const int drow = (mode == 0) ? ncol : (((ncol >> 7) << 8) + (ncol & 127) + (mode == 2 ? 128 : 0));
        u32x4 o; o.x = cvt_pk_bf16(s[0 * 33], s[1 * 33]); o.y = cvt_pk_bf16(s[2 * 33], s[3 * 33]); o.z = cvt_pk_bf16(s[4 * 33], s[5 * 33]); o.w = cvt_pk_bf16(s[6 * 33], s[7 * 33]);
        *(u32x4*)(WT + (size_t)drow * K + k0 + 8 * c) = o; }
    asm volatile("s_waitcnt lgkmcnt(0)" ::: "memory");
}

__device__ __forceinline__ float wave_sum(float v) {
#pragma unroll
    for (int o = 1; o < 64; o <<= 1) v += __shfl_xor(v, o);
    return v;
}

__device__ __forceinline__ void phase_prep0(const Ctx& C) {
    const int gw = C.wave * C.G + C.bx, NGW = C.G * NWAVES;
    const int gt = C.bx * NTHREADS + C.tid, NGT = C.G * NTHREADS;
    float* ssq = WSP(float, WS_SSQ);
    {
        const float* x = C.inp(0); bf16_t* xb = WSP(bf16_t, WS_XB);
        for (int row = gw; row < M_TOK; row += NGW) {
            const f32x4* xr = (const f32x4*)(x + (size_t)row * DM) + C.lane; f32x4 v[4]; float s = 0.f;
#pragma unroll
            for (int j = 0; j < 4; ++j) { v[j] = __builtin_nontemporal_load(xr + 64 * j); s += (v[j][0] * v[j][0] + v[j][1] * v[j][1]) + (v[j][2] * v[j][2] + v[j][3] * v[j][3]); }
            s = wave_sum(s);
            u32x2* o8 = (u32x2*)(xb + (size_t)row * DM) + C.lane;
#pragma unroll
            for (int j = 0; j < 4; ++j) { u32x2 w; w.x = cvt_pk_bf16(v[j][0], v[j][1]); w.y = cvt_pk_bf16(v[j][2], v[j][3]); o8[64 * j] = w; }
            if (C.lane == 0) *(f32x4*)(ssq + (size_t)row * 4) = (f32x4){s, 0.f, 0.f, 0.f};
        }
    }
    for (int i = gt; i < 128 * 64; i += NGT) ssq[5 * SSQ_STRIDE + i] = 0.f;
    {
        LAS float* scr = (LAS float*)(C.lds + C.wave * 16384);
        constexpr int I_GU = (DM / 64) * (DFF / 32), I_DN = (DFF / 64) * (DM / 32), I_IN = (DM / 64) * (DIN / 32), I_OUT = (DM / 64) * (DM / 32), I_GLU = (DSSM / 64) * (DSSM / 32);
        constexpr int NITEMS = 2 * I_GU + I_DN + I_IN;
        for (int it = gw; it < NITEMS; it += NGW) {
            int r = it;
            if (r < I_GU) { transpose_item(C.inp(2), DM, DFF, WSP(bf16_t, WS_WGU1), C.inp(1), C.inp(1), DM, 1, scr, r, C.lane); continue; } r -= I_GU;
            if (r < I_GU) { transpose_item(C.inp(3), DM, DFF, WSP(bf16_t, WS_WGU1), C.inp(1), C.inp(1), DM, 2, scr, r, C.lane); continue; } r -= I_GU;
            if (r < I_DN) { transpose_item(C.inp(4), DFF, DM, WSP(bf16_t, WS_WD1), nullptr, nullptr, 0, 0, scr, r, C.lane); continue; } r -= I_DN;
            transpose_item(C.inp(6), DM, DIN, WSP(bf16_t, WS_WIN), C.inp(5), C.inp(5), DM, 0, scr, r, C.lane);
        }
    }
    {
        float* rc = WSP(float, WS_ROPE); float* rsn = rc + SEQ * 8;
        for (int i = gt; i < SEQ * 8; i += NGT) {
            const int pos = i >> 3, k = i & 7;
            const double f = (k == 0) ? 1.0 : (k == 1) ? 0.19392274474868576 : (k == 2) ? 0.03760603093086393 : (k == 3) ? 0.007292664737217109 : (k == 4) ? 0.001414213562373095 : (k == 5) ? 0.0002742481756762073 : (k == 6) ? 5.318295896944988e-05 : 1.031338537721246e-05;
            const double xx = (double)pos * f; const double kk = __builtin_rint(xx * 0.15915494309189535); const float r = (float)(xx - kk * 6.283185307179586);
            rc[i] = cosf(r); rsn[i] = sinf(r);
        }
    }
    {
        f32x2* pw = WSP(f32x2, WS_PW); f32x2* bbar = WSP(f32x2, WS_BBAR);
        for (int i = gt; i < NG * NP * PWN; i += NGT) {
            const int gp = i / PWN, d = i - gp * PWN, g = gp >> 6; const float are = C.inp(7)[gp], aim = C.inp(8)[gp], dt = expf(C.inp(9)[g]);
            const double xx = (double)aim * (double)dt * (double)d; const double kk = __builtin_rint(xx * 0.15915494309189535); const float r = (float)(xx - kk * 6.283185307179586);
            const float mag = expf(are * dt * (float)d); pw[i] = (f32x2){mag * cosf(r), mag * sinf(r)};
        }
        for (int i = gt; i < NG * NP * NCH; i += NGT) {
            const int gp = i >> 4, g = gp >> 6; const float are = C.inp(7)[gp], aim = C.inp(8)[gp], dt = expf(C.inp(9)[g]);
            const double xx = (double)aim * (double)dt; const double kk = __builtin_rint(xx * 0.15915494309189535); const float r = (float)(xx - kk * 6.283185307179586);
            const float mag = expf(are * dt), l1r = mag * cosf(r), l1i = mag * sinf(r);
            const float nr = l1r - 1.0f, ni = l1i, den = 1.0f / (are * are + aim * aim); const float zr = (nr * are + ni * aim) * den, zi = (ni * are - nr * aim) * den;
            const float br = C.inp(10)[i], bi = C.inp(11)[i]; bbar[i] = (f32x2){zr * br - zi * bi, zr * bi + zi * br};
        }
    }
}
__device__ __forceinline__ void weights_late_item(const Ctx& C, int it) {
    LAS float* scr = (LAS float*)(C.lds + C.wave * 16384);
    constexpr int I_GU = (DM / 64) * (DFF / 32), I_DN = (DFF / 64) * (DM / 32), I_OUT = (DM / 64) * (DM / 32), I_GLU = (DSSM / 64) * (DSSM / 32);
    static_assert(2 * I_GU + I_DN + I_OUT + I_GLU == 256 * 19, "late weight items: 19 per workgroup");
    int r = it;
    if (r < I_GU) { transpose_item(C.inp(22), DM, DFF, WSP(bf16_t, WS_WGU2), C.inp(21), C.inp(21), DM, 1, scr, r, C.lane); return; } r -= I_GU;
    if (r < I_GU) { transpose_item(C.inp(23), DM, DFF, WSP(bf16_t, WS_WGU2), C.inp(21), C.inp(21), DM, 2, scr, r, C.lane); return; } r -= I_GU;
    if (r < I_DN) { transpose_item(C.inp(24), DFF, DM, WSP(bf16_t, WS_WD2), nullptr, nullptr, 0, 0, scr, r, C.lane); return; } r -= I_DN;
    if (r < I_OUT) { transpose_item(C.inp(20), DM, DM, WSP(bf16_t, WS_WOUT), C.inp(18), C.inp(19), DSSM, 0, scr, r, C.lane); return; } r -= I_OUT;
    transpose_item(C.inp(15), DSSM, DSSM, WSP(bf16_t, WS_WGLU), nullptr, nullptr, 0, 0, scr, r, C.lane);
}
__device__ __forceinline__ void phase_prep1(const Ctx& C) {
    LAS float* L = (LAS float*)C.lds;
    LAS float* Cr = L; LAS float* Ci = L + 1024; LAS f32x2* Bb = (LAS f32x2*)(L + 2048); LAS f32x2* Pw = (LAS f32x2*)(L + 4096);
    const f32x2* pw = WSP(f32x2, WS_PW); const f32x2* bbar = WSP(f32x2, WS_BBAR); float* ktab = WSP(float, WS_KTAB);
    constexpr int per = 4;
    const int base = (C.bx & 255) * per, g = base >> 5, d0 = base & 31;
    __syncthreads();
    for (int i = C.tid; i < 1024; i += NTHREADS) { Cr[i] = C.inp(12)[g * 1024 + i]; Ci[i] = C.inp(13)[g * 1024 + i]; Bb[i] = bbar[g * 1024 + i]; }
    for (int i = C.tid; i < per * 64; i += NTHREADS) { const int k = i >> 6, p = i & 63; Pw[i] = pw[(size_t)(g * 64 + p) * PWN + d0 + k]; }
    __syncthreads();
    const int half = C.tid >> 8, t = C.tid & 255, cp = t >> 4, c = t & 15;
#pragma unroll 1
    for (int k = half; k < per; k += 2) {
        float s = 0.f;
#pragma unroll 4
        for (int p = 0; p < NP; ++p) { const float cr = Cr[cp * 64 + p], ci = Ci[cp * 64 + p]; const f32x2 w = Pw[k * 64 + p], b = Bb[p * 16 + c];
            const float xr = cr * w.x - ci * w.y, xi = cr * w.y + ci * w.x; s += xr * b.x - xi * b.y; }
        ktab[(size_t)(base + k) * 256 + t] = s;
    }
    __syncthreads();
}
__device__ __forceinline__ void phase_prep2(const Ctx& C, int gt, int NGT) {
    const f32x2* pw = WSP(f32x2, WS_PW); const f32x2* bbar = WSP(f32x2, WS_BBAR); const float* ktab = WSP(float, WS_KTAB);
    bf16_t* bty = WSP(bf16_t, WS_BTY); bf16_t* bts1 = WSP(bf16_t, WS_BTS1);
    for (int q = gt; q < NG * K1 * (KY / 8); q += NGT) {
        const int row = q / (KY / 8), ck = q % (KY / 8), g = row >> 9, t = (row >> 4) & 31, cp = row & 15, k0 = ck * 8; float v[8];
        if (k0 < K1) { const int tau = k0 >> 4, c0 = k0 & 15;
            if (t >= tau) { const f32x4* kp = (const f32x4*)(ktab + ((size_t)((g * TCH + (t - tau)) * 16 + cp) * 16 + c0)); const f32x4 a = kp[0], b = kp[1];
                v[0] = a[0]; v[1] = a[1]; v[2] = a[2]; v[3] = a[3]; v[4] = b[0]; v[5] = b[1]; v[6] = b[2]; v[7] = b[3]; }
            else {
#pragma unroll
                for (int e = 0; e < 8; ++e) v[e] = 0.f; }
        } else { const int p0 = (k0 - K1) >> 1;
#pragma unroll
            for (int e = 0; e < 4; ++e) { const int p = p0 + e; const float cr = C.inp(12)[(g * 16 + cp) * 64 + p], ci = C.inp(13)[(g * 16 + cp) * 64 + p]; const f32x2 w = pw[(size_t)(g * 64 + p) * PWN + t + 1];
                v[2 * e] = cr * w.x - ci * w.y; v[2 * e + 1] = -(cr * w.y + ci * w.x); }
        }
        u32x4 o; o.x = cvt_pk_bf16(v[0], v[1]); o.y = cvt_pk_bf16(v[2], v[3]); o.z = cvt_pk_bf16(v[4], v[5]); o.w = cvt_pk_bf16(v[6], v[7]);
        *(u32x4*)(bty + (size_t)row * KY + k0) = o;
    }
    for (int q = gt; q < NG * 128 * (K1 / 8); q += NGT) {
        const int g = q / (128 * 64), p2 = (q >> 6) & 127, ck = q & 63, k0 = ck * 8, tau = k0 >> 4, c0 = k0 & 15, part = p2 & 1, p = p2 >> 1;
        const f32x2 w = pw[(size_t)(g * 64 + p) * PWN + (TCH - 1 - tau)]; float v[8];
#pragma unroll
        for (int e = 0; e < 8; ++e) { const f32x2 b = bbar[(g * 64 + p) * 16 + c0 + e]; v[e] = part == 0 ? (w.x * b.x - w.y * b.y) : (w.x * b.y + w.y * b.x); }
        u32x4 o; o.x = cvt_pk_bf16(v[0], v[1]); o.y = cvt_pk_bf16(v[2], v[3]); o.z = cvt_pk_bf16(v[4], v[5]); o.w = cvt_pk_bf16(v[6], v[7]);
        *(u32x4*)(bts1 + (size_t)(g * 256 + p2) * K1 + k0) = o;
    }
}
__device__ __forceinline__ void carry_task(const Ctx& C, int b, int g) {
    const f32x2* pw = WSP(f32x2, WS_PW); const float* sloc = WSP(float, WS_SLOC); bf16_t* app = WSP(bf16_t, WS_APP);
    const int p = C.lane; const f32x2 lt = pw[(size_t)(g * 64 + p) * PWN + TCH];
    float sr = 0.f, si = 0.f;
    const size_t row0 = (size_t)g * NBN + b * NCK;
#pragma unroll 1
    for (int c0 = 0; c0 < NCK; c0 += 16) {
        f32x2 l[16];
#pragma unroll
        for (int j = 0; j < 16; ++j) l[j] = *(const f32x2*)(sloc + (row0 + c0 + j) * 128 + 2 * p);
#pragma unroll
        for (int j = 0; j < 16; ++j) {
            const size_t row = row0 + c0 + j;
            *(unsigned*)(app + row * KY + K1 + 2 * p) = cvt_pk_bf16(sr, si);
            const float nr = lt.x * sr - lt.y * si + l[j].x, ni = lt.x * si + lt.y * sr + l[j].y; sr = nr; si = ni;
        }
    }
}
typedef float f32x16 __attribute__((ext_vector_type(16)));
#define MFMA32(a, b, c) __builtin_amdgcn_mfma_f32_32x32x16_bf16((a), (b), (c), 0, 0, 0)
__device__ __forceinline__ bf16x8 pack8_mfma(const f32x16& x, int s) {
    u32x4 p; p[0] = cvt_pk_bf16(x[8 * s], x[8 * s + 1]); p[1] = cvt_pk_bf16(x[8 * s + 2], x[8 * s + 3]); p[2] = cvt_pk_bf16(x[8 * s + 4], x[8 * s + 5]); p[3] = cvt_pk_bf16(x[8 * s + 6], x[8 * s + 7]);
    return __builtin_bit_cast(bf16x8, p);
}
__device__ __forceinline__ void phase_attn(const Ctx& C) {
    constexpr int KROW = 144, KSZ = 256 * KROW, VROW = 528, VSZ = 64 * VROW, V_OFF = 2 * KSZ;
    static_assert(V_OFF + 2 * VSZ <= LDS_BYTES, "attention LDS");
    const bf16_t* qkv = WSP(bf16_t, WS_QKV); bf16_t* ycat = WSP(bf16_t, WS_YCAT); const float* ssq_ssm = WSP(float, WS_SSQ) + 2 * SSQ_STRIDE;
    LAS unsigned char* lds = C.lds; const int tid = C.tid, lane = C.lane, wave = C.wave;
    for (int it0 = C.bx; it0 < BATCH * 32; it0 += C.G) {
        const int item = (C.G == 256) ? (((it0 & 7) << 5) | (it0 >> 3)) : it0;
        const int b = item >> 5, nb = item & 31, tok0 = b * SEQ + nb * 128; const long kbase = (long)tok0 - 128;
        __syncthreads();
#pragma unroll
        for (int i = 0; i < 8; ++i) { const int c = tid + NTHREADS * i, part = c & 7, sk = (c >> 3) & 255, kvh = c >> 11;
            if (nb > 0 || sk >= 128) { const u32x4 v = *(const u32x4*)(qkv + (size_t)(kbase + sk) * 768 + 512 + kvh * 64 + part * 8); *(LAS u32x4*)(lds + kvh * KSZ + sk * KROW + part * 16) = v; } }
#pragma unroll
        for (int i = 0; i < 4; ++i) { const int c = tid + NTHREADS * i, sp = c & 127, part = (c >> 7) & 7, kvh = c >> 10, sk = 2 * sp;
            if (nb > 0 || sk >= 128) { const bf16_t* vp = qkv + (size_t)(kbase + sk) * 768 + 640 + kvh * 64 + part * 8; const u32x4 v0 = *(const u32x4*)vp, v1 = *(const u32x4*)(vp + 768);
                LAS unsigned char* dst = lds + V_OFF + kvh * VSZ + (part * 8) * VROW + sp * 4;
#pragma unroll
                for (int e = 0; e < 4; ++e) { const unsigned a0 = v0[e], a1 = v1[e];
                    *(LAS unsigned*)(dst + (2 * e) * VROW) = (a0 & 0xffffu) | (a1 << 16); *(LAS unsigned*)(dst + (2 * e + 1) * VROW) = (a0 >> 16) | (a1 & 0xffff0000u); } } }
        __syncthreads();
        const int q0 = wave * 16, ql = lane & 15, hl = (lane >> 4) & 1, h = lane >> 5, a = q0 >> 5, qrel = (q0 & 31) + ql, l31 = lane & 31;
        const int tok = tok0 + q0 + ql;
        float ssq_acc = 0.f;
#pragma unroll 1
        for (int hp = 0; hp < 4; ++hp) {
            const int kvh = hp >> 1, head = 2 * hp + hl;
            bf16x8 qf[4];
#pragma unroll
            for (int ks = 0; ks < 4; ++ks) qf[ks] = *(const bf16x8*)(qkv + (size_t)tok * 768 + head * 64 + 16 * ks + 8 * h);
            f32x16 sc[5];
#pragma unroll
            for (int j = 0; j < 5; ++j) {
#pragma unroll
                for (int r = 0; r < 16; ++r) sc[j][r] = 0.f;
                const int st = a + j;
                if (nb > 0 || st >= 4) {
#pragma unroll
                    for (int ks = 0; ks < 4; ++ks) { const bf16x8 kf = *(const LAS bf16x8*)(lds + kvh * KSZ + (32 * st + l31) * KROW + (16 * ks + 8 * h) * 2); sc[j] = MFMA32(kf, qf[ks], sc[j]); }
                }
            }
            const float sink = C.inp(17)[head] * 1.4426950409f; float mx = sink;
#pragma unroll
            for (int j = 0; j < 5; ++j) { const bool tv = (nb > 0) || (a + j >= 4);
#pragma unroll
                for (int r = 0; r < 16; ++r) { const int cr = (r & 3) + 8 * (r >> 2) + 4 * h; bool ok = tv; if (j == 0) ok = ok && (cr > qrel); if (j == 4) ok = ok && (cr <= qrel);
                    const float t = ok ? sc[j][r] * 0.18033688011f : -1e30f; sc[j][r] = t; mx = fmaxf(mx, t); } }
            mx = fmaxf(mx, __shfl_xor(mx, 32));
            float lsum = 0.f;
#pragma unroll
            for (int j = 0; j < 5; ++j)
#pragma unroll
                for (int r = 0; r < 16; ++r) { const float p = __builtin_amdgcn_exp2f(sc[j][r] - mx); sc[j][r] = p; lsum += p; }
            lsum += __shfl_xor(lsum, 32); lsum += __builtin_amdgcn_exp2f(sink - mx);
            f32x16 o[2];
#pragma unroll
            for (int r = 0; r < 16; ++r) { o[0][r] = 0.f; o[1][r] = 0.f; }
#pragma unroll
            for (int j = 0; j < 5; ++j) { const int st = a + j;
                if (nb > 0 || st >= 4) {
#pragma unroll
                    for (int ks = 0; ks < 2; ++ks) { const bf16x8 pb = pack8_mfma(sc[j], ks);
#pragma unroll
                        for (int dt = 0; dt < 2; ++dt) { const LAS unsigned char* vp = lds + V_OFF + kvh * VSZ + (32 * dt + l31) * VROW + (32 * st + 16 * ks + 4 * h) * 2;
                            const u32x2 x0 = *(const LAS u32x2*)vp, x1 = *(const LAS u32x2*)(vp + 16); u32x4 xv; xv.x = x0.x; xv.y = x0.y; xv.z = x1.x; xv.w = x1.y;
                            o[dt] = MFMA32(__builtin_bit_cast(bf16x8, xv), pb, o[dt]); } }
                }
            }
            const float inv = __builtin_amdgcn_rcpf(lsum);
#pragma unroll
            for (int dt = 0; dt < 2; ++dt) {
                u32x2 w[4];
#pragma unroll
                for (int g4 = 0; g4 < 4; ++g4) { const float v0 = o[dt][4 * g4] * inv, v1 = o[dt][4 * g4 + 1] * inv, v2 = o[dt][4 * g4 + 2] * inv, v3 = o[dt][4 * g4 + 3] * inv;
                    ssq_acc += (v0 * v0 + v1 * v1) + (v2 * v2 + v3 * v3);
                    w[g4].x = cvt_pk_bf16(v0, v1); w[g4].y = cvt_pk_bf16(v2, v3); }
#pragma unroll
                for (int k = 0; k < 4; k += 2) {
                    const auto rx = __builtin_amdgcn_permlane32_swap(w[k].x, w[k + 1].x, false, false); const auto ry = __builtin_amdgcn_permlane32_swap(w[k].y, w[k + 1].y, false, false);
                    u32x4 q; q.x = rx[0]; q.y = ry[0]; q.z = rx[1]; q.w = ry[1];
                    *(u32x4*)(ycat + (size_t)tok * DM + 512 + head * 64 + 32 * dt + 8 * k + 8 * h) = q; }
            }
        }
        ssq_acc += __shfl_xor(ssq_acc, 16); ssq_acc += __shfl_xor(ssq_acc, 32);
        const float rs = rsqrtf(ssq_acc * (1.0f / 512.0f) + EPS) * sqrtf((ssq_ssm[(size_t)tok * 4] + ssq_ssm[(size_t)tok * 4 + 1]) * (1.0f / 512.0f) + EPS);
#pragma unroll 1
        for (int hp = 0; hp < 4; ++hp)
#pragma unroll
            for (int dt = 0; dt < 2; ++dt)
#pragma unroll
                for (int k = 0; k < 4; k += 2) { u32x4* p = (u32x4*)(ycat + (size_t)tok * DM + 512 + (2 * hp + hl) * 64 + 32 * dt + 8 * k + 8 * h); const u32x4 w0 = *p;
                    u32x4 w; w.x = cvt_pk_bf16(bf_lo(w0.x) * rs, bf_hi(w0.x) * rs); w.y = cvt_pk_bf16(bf_lo(w0.y) * rs, bf_hi(w0.y) * rs); w.z = cvt_pk_bf16(bf_lo(w0.z) * rs, bf_hi(w0.z) * rs); w.w = cvt_pk_bf16(bf_lo(w0.w) * rs, bf_hi(w0.w) * rs); *p = w; }
    }
    __syncthreads();
}

constexpr int N_PHASES = 12;
__global__ void __launch_bounds__(NTHREADS, 2) mk_fwd(const float* p0, const float* p1, const float* p2, const float* p3, const float* p4, const float* p5, const float* p6, const float* p7, const float* p8, const float* p9, const float* p10, const float* p11, const float* p12, const float* p13, const float* p14, const float* p15, const float* p16, const float* p17, const float* p18, const float* p19, const float* p20, const float* p21, const float* p22, const float* p23, const float* p24, const float* p25, float* out_p, unsigned char* ws_p, int ph_lo, int ph_hi) {
    extern __shared__ __attribute__((aligned(16))) unsigned char lds_raw[];
    Ctx C; C.in[0] = p0; C.in[1] = p1; C.in[2] = p2; C.in[3] = p3; C.in[4] = p4; C.in[5] = p5; C.in[6] = p6; C.in[7] = p7; C.in[8] = p8; C.in[9] = p9; C.in[10] = p10; C.in[11] = p11; C.in[12] = p12; C.in[13] = p13; C.in[14] = p14; C.in[15] = p15; C.in[16] = p16; C.in[17] = p17; C.in[18] = p18; C.in[19] = p19; C.in[20] = p20; C.in[21] = p21; C.in[22] = p22; C.in[23] = p23; C.in[24] = p24; C.in[25] = p25; C.out = out_p; C.ws = ws_p; C.lds = (LAS unsigned char*)lds_raw;
    C.tid = threadIdx.x; C.lane = C.tid & 63; C.wave = __builtin_amdgcn_readfirstlane(C.tid >> 6); C.G = gridDim.x; C.bx = blockIdx.x;
    const int lo = ph_lo, hi = ph_hi;
#define IN(k) (lo <= (k) && (k) < hi)
#define SEAM(k) do { if (IN(k) && IN((k) + 1)) { xcd_barrier(xbar); } } while (0)
    volatile LAS unsigned* xst = (volatile LAS unsigned*)(C.lds + LDS_BYTES - 16);
    if (C.tid == 0) { xst[0] = 0u; xst[1] = 0u; }
    __syncthreads();
    const XcdBarrier xbar = xcd_barrier_post(WSP(unsigned, WS_BAR), xst);
    float* ssq = WSP(float, WS_SSQ); LAS float* red = (LAS float*)(C.lds + RED_OFF);
    if (IN(0)) { phase_prep0(C); __syncthreads(); }
    SEAM(0);
    if (IN(1)) {
        phase_prep1(C);
        pg8::Gemm g{WSP(bf16_t, WS_XB), WSP(bf16_t, WS_WGU1), DM, DM, DM}; pg8::StaticOrder S; S.init(M_TOK, 2 * DFF, C.G, C.bx);
        EpiGateUp E{ssq, WSP(bf16_t, WS_ACT)}; pg8::gemm_phase<EpiGateUp, pg8::StaticOrder, true>(C.lds, g, S, E);
    }
    SEAM(1);
    if (IN(2)) {
        pg8::Gemm g{WSP(bf16_t, WS_ACT), WSP(bf16_t, WS_WD1), DFF, DFF, DFF}; pg8::StaticOrder S; S.init(M_TOK, DM, C.G, C.bx);
        EpiResid E{WSP(bf16_t, WS_XB), ssq + SSQ_STRIDE, 0.5f, nullptr, red}; pg8::gemm_phase<EpiResid, pg8::StaticOrder, true>(C.lds, g, S, E);
    }
    SEAM(2);
    if (IN(3)) {
        pg8::Gemm g{WSP(bf16_t, WS_XB), WSP(bf16_t, WS_WIN), DM, DM, DM}; pg8::StaticOrder S; S.init(M_TOK, DIN, C.G, C.bx);
        EpiWin E{ssq + SSQ_STRIDE, WSP(bf16_t, WS_APP), WSP(bf16_t, WS_QKV), WSP(float, WS_ROPE), WSP(float, WS_ROPE) + SEQ * 8}; pg8::gemm_phase<EpiWin, pg8::StaticOrder, true>(C.lds, g, S, E);
        if (C.G <= 128) phase_prep2(C, C.bx * NTHREADS + C.tid, C.G * NTHREADS);
        else if (C.bx >= 128) phase_prep2(C, (C.bx - 128) * NTHREADS + C.tid, (C.G - 128) * NTHREADS);
    }
    SEAM(3);
    if (IN(4)) {
        { const int it = ((C.bx & 7) << 5) | ((C.bx >> 3) & 31);
            const int pm = it >> 1, g = pm >> 2;
            __syncthreads();
            { pg8::Gemm g1{WSP(bf16_t, WS_APP), WSP(bf16_t, WS_BTS1), KY, K1, K1}; pg8::OneUnit S{pm, g}; EpiS1 E{WSP(float, WS_SLOC)}; pg8::gemm_phase<EpiS1, pg8::OneUnit, true, true>(C.lds, g1, S, E); }
            asm volatile("s_waitcnt vmcnt(0)" ::: "memory"); __syncthreads();
            if (C.wave < 2) carry_task(C, 2 * (pm & 3) + C.wave, g);
            if (C.wave >= 2) {
#pragma unroll 1
                for (int j = C.wave - 2; j < 18; j += 6) weights_late_item(C, it * 19 + j);
            } else if (C.wave == 0) weights_late_item(C, it * 19 + 18);
            asm volatile("s_waitcnt vmcnt(0)" ::: "memory"); __syncthreads();
            { pg8::Gemm gy{WSP(bf16_t, WS_APP), WSP(bf16_t, WS_BTY), KY, KY, KY}; pg8::OneUnit S{pm, 2 * g + (it & 1)}; EpiY E{WSP(bf16_t, WS_APP), C.inp(14), WSP(bf16_t, WS_YGELU)}; pg8::gemm_phase<EpiY, pg8::OneUnit, true>(C.lds, gy, S, E); }
        }
    }
    SEAM(4);
    if (IN(7)) {
        pg8::Gemm g{WSP(bf16_t, WS_YGELU), WSP(bf16_t, WS_WGLU), DSSM, DSSM, DSSM}; pg8::StaticOrder S; S.init(M_TOK, DSSM, C.G, C.bx);
        EpiGlu E{WSP(bf16_t, WS_YGELU), C.inp(16), WSP(bf16_t, WS_YCAT), ssq + 2 * SSQ_STRIDE, red}; pg8::gemm_phase<EpiGlu, pg8::StaticOrder, true>(C.lds, g, S, E);
    }
    SEAM(7);
    if (IN(8)) { phase_attn(C); }
    SEAM(8);
    if (IN(9)) {
        pg8::Gemm g{WSP(bf16_t, WS_YCAT), WSP(bf16_t, WS_WOUT), DM, DM, DM}; pg8::StaticOrder S; S.init(M_TOK, DM, C.G, C.bx);
        EpiResid E{WSP(bf16_t, WS_XB), ssq + 3 * SSQ_STRIDE, 1.0f, ssq + 2 * SSQ_STRIDE, red}; pg8::gemm_phase<EpiResid, pg8::StaticOrder, true>(C.lds, g, S, E);
    }
    SEAM(9);
    if (IN(10)) {
        pg8::Gemm g{WSP(bf16_t, WS_XB), WSP(bf16_t, WS_WGU2), DM, DM, DM}; pg8::StaticOrder S; S.init(M_TOK, 2 * DFF, C.G, C.bx);
        EpiGateUp E{ssq + 3 * SSQ_STRIDE, WSP(bf16_t, WS_ACT)}; pg8::gemm_phase<EpiGateUp, pg8::StaticOrder, true>(C.lds, g, S, E);
    }
    SEAM(10);
    if (IN(11)) {
        pg8::Gemm g{WSP(bf16_t, WS_ACT), WSP(bf16_t, WS_WD2), DFF, DFF, DFF}; pg8::StaticOrder S; S.init(M_TOK, DM, C.G, C.bx);
        EpiFinal E{WSP(bf16_t, WS_XB), ssq + 4 * SSQ_STRIDE, (unsigned*)(ssq + 5 * SSQ_STRIDE), C.inp(25), C.out, red}; pg8::gemm_phase<EpiFinal, pg8::StaticOrder, true>(C.lds, g, S, E);
    }
#undef IN
#undef SEAM
}

extern "C" void kernel_launch(void* const* d_in, const int* in_sizes, int n_in, void* d_out, int out_size, void* d_ws, size_t ws_size, hipStream_t stream) {
    static int grid = 0;
    if (grid == 0) {
        if (n_in != 26 || out_size != M_TOK * DM || ws_size < WS_END) { fprintf(stderr, "kernel_launch: unexpected shapes (n_in %d out %d ws %zu)\n", n_in, out_size, ws_size); grid = -1; return; }
        int dev = 0, cus = 0, per_cu = 0;
        hipGetDevice(&dev); hipDeviceGetAttribute(&cus, hipDeviceAttributeMultiprocessorCount, dev);
        if (hipFuncSetAttribute((const void*)mk_fwd, hipFuncAttributeMaxDynamicSharedMemorySize, LDS_BYTES) != hipSuccess) { fprintf(stderr, "kernel_launch: hipFuncSetAttribute failed\n"); grid = -1; return; }
        hipOccupancyMaxActiveBlocksPerMultiprocessor(&per_cu, (const void*)mk_fwd, NTHREADS, LDS_BYTES);
        if (per_cu < 1) { fprintf(stderr, "kernel_launch: occupancy query says %d blocks/CU\n", per_cu); per_cu = 1; }
        (void)hipGetLastError();
        grid = cus;
    }
    if (grid < 0) return;
    const float* ip[26]; for (int i = 0; i < 26; ++i) ip[i] = (const float*)d_in[i];
    float* outp = (float*)d_out; unsigned char* wsp = (unsigned char*)d_ws; int lo = 0, hi = N_PHASES;
    (void)hipMemsetAsync((unsigned char*)d_ws + WS_BAR, 0, XCD_BAR_WORDS * sizeof(unsigned), stream);
    void* kargs[30]; for (int i = 0; i < 26; ++i) kargs[i] = (void*)&ip[i];
    kargs[26] = (void*)&outp; kargs[27] = (void*)&wsp; kargs[28] = (void*)&lo; kargs[29] = (void*)&hi;
    hipError_t e = hipLaunchCooperativeKernel((const void*)mk_fwd, dim3(grid), dim3(NTHREADS), kargs, LDS_BYTES, stream);
    if (e != hipSuccess) fprintf(stderr, "kernel_launch: cooperative launch failed: %s (grid %d)\n", hipGetErrorString(e), grid);
}
```

```cpp
#include <hip/hip_runtime.h>
#include <hip/hip_cooperative_groups.h>
#include <cstdio>
#include <cstdint>
namespace cg = cooperative_groups;

#define LAS __attribute__((address_space(3)))
#define GAS __attribute__((address_space(1)))
typedef unsigned short bf16_t;
typedef short bf16x8 __attribute__((ext_vector_type(8)));
typedef float f32x4 __attribute__((ext_vector_type(4)));
typedef float f32x2 __attribute__((ext_vector_type(2)));
typedef unsigned u32x4 __attribute__((ext_vector_type(4)));
typedef unsigned u32x2 __attribute__((ext_vector_type(2)));

constexpr int BATCH = 8, SEQ = 4096, M_TOK = BATCH * SEQ, DM = 1024, DFF = 2816, DIN = 1280, DSSM = 512;
constexpr int NG = 32, NP = 64, NCH = 16;
constexpr int TCH = 32, NCK = SEQ / TCH, NBN = BATCH * NCK;
constexpr int K1 = TCH * NCH;
constexpr int KY = K1 + 2 * NP;
constexpr int PWN = TCH + 1;
constexpr float EPS = 1e-6f;
constexpr int NTHREADS = 512, NWAVES = 8;
constexpr int LDS_BYTES = 147456;
constexpr int RED_OFF = 131072;
constexpr size_t SSQ_STRIDE = 4 * (size_t)32768;

constexpr size_t MiB = 1024 * 1024;
constexpr size_t WS_XB = 0;
constexpr size_t WS_ACT = 64 * MiB;
constexpr size_t WS_APP = WS_ACT;
constexpr size_t WS_QKV = WS_ACT + 40 * MiB;
constexpr size_t WS_YGELU = WS_ACT + 88 * MiB;
constexpr size_t WS_SLOC = WS_ACT + 120 * MiB;
constexpr size_t WS_YCAT = 240 * MiB;
constexpr size_t WS_WGU1 = 304 * MiB, WS_WD1 = 315 * MiB, WS_WGU2 = 321 * MiB, WS_WD2 = 332 * MiB;
constexpr size_t WS_WIN = 338 * MiB, WS_WOUT = 341 * MiB, WS_WGLU = 343 * MiB;
constexpr size_t WS_BTY = 344 * MiB;
constexpr size_t WS_BTS1 = 364 * MiB;
constexpr size_t WS_PW = 372 * MiB;
constexpr size_t WS_BBAR = 373 * MiB;
constexpr size_t WS_KTAB = 374 * MiB;
constexpr size_t WS_SSQ = 380 * MiB;
constexpr size_t WS_ROPE = 377 * MiB;
constexpr size_t WS_BAR = 378 * MiB;
constexpr size_t WS_END = 384 * MiB;


typedef __bf16 bf16x2_t __attribute__((ext_vector_type(2)));
__device__ __forceinline__ unsigned cvt_pk_bf16(float lo, float hi) { const f32x2 v = {lo, hi}; return __builtin_bit_cast(unsigned, __builtin_convertvector(v, bf16x2_t)); }
__device__ __forceinline__ float bf_lo(unsigned w) { return __uint_as_float(w << 16); }
__device__ __forceinline__ float bf_hi(unsigned w) { return __uint_as_float(w & 0xffff0000u); }
__device__ __forceinline__ float bf2f(bf16_t b) { return __uint_as_float(((unsigned)b) << 16); }
__device__ __forceinline__ bf16_t f2bf(float f) { return (bf16_t)(cvt_pk_bf16(f, 0.f) & 0xffffu); }
__device__ __forceinline__ float gelu_tanh(float v) { const float z = -2.3022081198f * (v + 0.044715f * v * v * v); return v * __builtin_amdgcn_rcpf(1.0f + __builtin_amdgcn_exp2f(z)); }
__device__ __forceinline__ float sigmoidf_(float v) { return __builtin_amdgcn_rcpf(1.0f + __builtin_amdgcn_exp2f(-1.4426950409f * v)); }
__device__ __forceinline__ f32x4 bf4_lo(const u32x4 x) { return (f32x4){bf_lo(x.x), bf_hi(x.x), bf_lo(x.y), bf_hi(x.y)}; }
__device__ __forceinline__ f32x4 bf4_hi(const u32x4 x) { return (f32x4){bf_lo(x.z), bf_hi(x.z), bf_lo(x.w), bf_hi(x.w)}; }
__device__ __forceinline__ f32x4 exp2_v(const f32x4 t) { return (f32x4){__builtin_amdgcn_exp2f(t[0]), __builtin_amdgcn_exp2f(t[1]), __builtin_amdgcn_exp2f(t[2]), __builtin_amdgcn_exp2f(t[3])}; }
__device__ __forceinline__ f32x4 rcp_v(const f32x4 t) { return (f32x4){__builtin_amdgcn_rcpf(t[0]), __builtin_amdgcn_rcpf(t[1]), __builtin_amdgcn_rcpf(t[2]), __builtin_amdgcn_rcpf(t[3])}; }
__device__ __forceinline__ f32x4 sigmoid_v(const f32x4 a) { return rcp_v(exp2_v(a * -1.4426950409f) + 1.0f); }
__device__ __forceinline__ f32x4 gelu_tanh_v(const f32x4 v) { const f32x4 z = v * ((v * v) * -0.1029432397f + -2.3022081198f); return v * rcp_v(exp2_v(z) + 1.0f); }
__device__ __forceinline__ u32x4 pack8(const f32x4 a, const f32x4 b) { u32x4 w; w.x = cvt_pk_bf16(a[0], a[1]); w.y = cvt_pk_bf16(a[2], a[3]); w.z = cvt_pk_bf16(b[0], b[1]); w.w = cvt_pk_bf16(b[2], b[3]); return w; }
__device__ __forceinline__ float rs_from_ssq(float ssq, float inv_n) { return __builtin_amdgcn_rsqf(ssq * inv_n + EPS); }

namespace pg8 {
constexpr int BM = 256, BK = 64, HALF = 128, HTB = HALF * BK * 2, STAGE_BYTES = 8 * HTB, NXCD = 8, WGM = 8;
__host__ __device__ __forceinline__ int lds_byte(int r, int c) { const int st = (r >> 4) * 2 + (c >> 5), rr = r & 15, cc = c & 31, ob = rr * 64 + cc * 2; return st * 1024 + (ob ^ (((ob >> 9) & 1) << 5)); }
__host__ __device__ __forceinline__ int perm32(int rho) { const int n = rho >> 4, i = rho & 15; return 8 * (i >> 2) + 4 * n + (i & 3); }
__host__ __device__ __forceinline__ void stage_rc(int b, int& R, int& C) { const int st = b / 1024, sb = b % 1024, swz = sb ^ (((sb >> 9) & 1) << 5); R = (st >> 1) * 16 + swz / 64; C = (st & 1) * 32 + (swz % 64) / 2; }

struct Unit { int pm, pn, ka, kb, part; };
struct Gemm { const bf16_t* A; const bf16_t* Bt; int lda, ldb, K; };

struct StaticOrder {
    int nM, nN, nwg, G, c;
    __device__ void init(int M, int N, int G_, int c_) { nM = M / BM; nN = N / BM; nwg = nM * nN; G = G_; c = c_; }
    __device__ bool next(int i, Unit& u) const {
        const long L = (long)i * G + c; if (L >= nwg) return false;
        int wgid = (int)L; { const int q = nwg / NXCD, r = nwg % NXCD, xcd = wgid % NXCD, off = wgid / NXCD; wgid = (xcd < r ? xcd * (q + 1) : r * (q + 1) + (xcd - r) * q) + off; }
        const int nig = WGM * nN, gid = wgid / nig, fm = gid * WGM, gsz = (nM - fm) < WGM ? (nM - fm) : WGM;
        u.pm = fm + ((wgid % nig) % gsz); u.pn = (wgid % nig) / gsz; u.ka = 0; u.kb = 0; u.part = 0; return true;
    }
};
struct OneUnit { int pm, pn;
    __device__ bool next(int i, Unit& u) const { if (i) return false; u.pm = pm; u.pn = pn; u.ka = 0; u.kb = 0; u.part = 0; return true; } };
struct SplitOrder { StaticOrder so;
    __device__ bool next(int i, Unit& u) const { if (!so.next(i >> 1, u)) return false; u.ka = u.kb = (i & 1) * 512; u.part = (i & 1) ? 0 : 1; return true; } };

template <class Epi, class Sched, bool PERM = false, bool HALF_N = false>
__device__ __forceinline__ void gemm_phase(LAS unsigned char* lds, const Gemm g, const Sched& S, const Epi& E) {
    const int tid = threadIdx.x, wid = __builtin_amdgcn_readfirstlane(tid >> 6), lane = tid & 63, wr = wid >> 2, wc = wid & 3, fr = lane & 15, fq = lane >> 4;
    const int nt = g.K / BK;
    unsigned voffA[2], voffB[2];
#pragma unroll
    for (int i = 0; i < 2; ++i) { int R, C; stage_rc(tid * 16 + i * 8192, R, C); const int Rb = PERM ? ((R & ~31) + perm32(R & 31)) : R; voffA[i] = (unsigned)(R * g.lda + C) * 2u; voffB[i] = (unsigned)(Rb * g.ldb + C) * 2u; }
    const size_t kstep = (size_t)(BK * 2);
    const size_t hA = (size_t)HALF * g.lda * 2, hB = (size_t)HALF * g.ldb * 2, tA = 2 * hA, tB = 2 * hB;
    const unsigned ldsw = (unsigned)wid * 1024u;
    const int aoff = lds_byte(wr * 64 + fr, fq * 8), boff = lds_byte(wc * 32 + fr, fq * 8);
#define PG8_SA(b, h) (((b) * 2 + (h)) * HTB)
#define PG8_SB(b, h) ((4 + (b) * 2 + (h)) * HTB)
#define PG8_STAGE(bufoff, gbase, voff) do { _Pragma("unroll") for (int _i = 0; _i < 2; ++_i) \
        __builtin_amdgcn_global_load_lds((const unsigned*)((const char*)(gbase) + (voff)[_i]), (LAS unsigned*)(lds + (bufoff) + ldsw + _i * 8192), 16, 0, 0); } while (0)
#define PG8_LDA(dst, b, h) do { _Pragma("unroll") for (int m = 0; m < 4; ++m) _Pragma("unroll") for (int k = 0; k < 2; ++k) dst[m][k] = *(const LAS bf16x8*)(lds + PG8_SA(b, h) + aoff + m * 2048 + k * 1024); } while (0)
#define PG8_LDB(dst, b, h) do { _Pragma("unroll") for (int n = 0; n < 2; ++n) _Pragma("unroll") for (int k = 0; k < 2; ++k) dst[n][k] = *(const LAS bf16x8*)(lds + PG8_SB(b, h) + boff + n * 2048 + k * 1024); } while (0)
#define PG8_MMA(ai, bj, At, Bt) do { __builtin_amdgcn_s_setprio(1); _Pragma("unroll") for (int m = 0; m < 4; ++m) _Pragma("unroll") for (int n = 0; n < 2; ++n) _Pragma("unroll") for (int k = 0; k < 2; ++k) \
        acc[ai][bj][m][n] = __builtin_amdgcn_mfma_f32_16x16x32_bf16(Bt[n][k], At[m][k], acc[ai][bj][m][n], 0, 0, 0); __builtin_amdgcn_s_setprio(0); } while (0)
#define PG8_WAIT_V(n) asm volatile("s_waitcnt vmcnt(" #n ")" ::: "memory")
#define PG8_WAIT_L(n) asm volatile("s_waitcnt lgkmcnt(" #n ")" ::: "memory")
#define PG8_BAR __builtin_amdgcn_s_barrier()
#define PG8_SCHED __builtin_amdgcn_sched_barrier(0)
    Unit cur, nxt; int ui = 0;
    if (!S.next(0, cur)) return;
    f32x4 acc[2][2][4][2];
#pragma unroll
    for (int a = 0; a < 2; ++a)
#pragma unroll
        for (int b = 0; b < 2; ++b)
#pragma unroll
            for (int m = 0; m < 4; ++m)
#pragma unroll
                for (int n = 0; n < 2; ++n) acc[a][b][m][n] = (f32x4){0.f, 0.f, 0.f, 0.f};
    bf16x8 At[4][2], B0[2][2], B1[2][2];
    const char* cA = (const char*)g.A + (size_t)cur.pm * tA + (size_t)cur.ka * 2; const char* cB = (const char*)g.Bt + (size_t)cur.pn * tB + (size_t)cur.kb * 2;
    PG8_STAGE(PG8_SB(0, 0), cB, voffB); PG8_STAGE(PG8_SB(0, 1), cB + hB, voffB); PG8_STAGE(PG8_SA(0, 0), cA, voffA); PG8_STAGE(PG8_SA(0, 1), cA + hA, voffA);
    if (wr == 1) PG8_BAR;
    PG8_WAIT_V(2); PG8_BAR;
    PG8_STAGE(PG8_SB(1, 0), cB + kstep, voffB); PG8_STAGE(PG8_SA(1, 0), cA + kstep, voffA); PG8_STAGE(PG8_SB(1, 1), cB + hB + kstep, voffB);
    PG8_WAIT_V(6); PG8_BAR;
    for (;;) {
        const bool has_next = S.next(ui + 1, nxt);
        const char* nA = has_next ? (const char*)g.A + (size_t)nxt.pm * tA + (size_t)nxt.ka * 2 : cA; const char* nB = has_next ? (const char*)g.Bt + (size_t)nxt.pn * tB + (size_t)nxt.kb * 2 : cB;
        for (int t = 0; t < nt; t += 2) {
            const bool last = (t == nt - 2);
            const char* a1 = cA + (size_t)(t + 1) * kstep;
            const char* a2 = last ? nA : cA + (size_t)(t + 2) * kstep; const char* b2 = last ? nB : cB + (size_t)(t + 2) * kstep;
            const char* a3 = a2 + kstep; const char* b3 = b2 + kstep;
            PG8_LDB(B0, 0, 0); if constexpr (!HALF_N) PG8_LDB(B1, 0, 1); PG8_SCHED; PG8_LDA(At, 0, 0); PG8_STAGE(PG8_SA(1, 1), a1 + hA, voffA);
            PG8_WAIT_V(8); PG8_WAIT_L(0); PG8_BAR; PG8_MMA(0, 0, At, B0); if constexpr (!HALF_N) PG8_MMA(0, 1, At, B1); PG8_BAR; PG8_SCHED;
            PG8_LDA(At, 0, 1); PG8_STAGE(PG8_SB(0, 0), b2, voffB); PG8_STAGE(PG8_SB(0, 1), b2 + hB, voffB); PG8_STAGE(PG8_SA(0, 0), a2, voffA);
            PG8_WAIT_V(8); PG8_WAIT_L(0); PG8_BAR; PG8_MMA(1, 0, At, B0); if constexpr (!HALF_N) PG8_MMA(1, 1, At, B1); PG8_BAR; PG8_SCHED;
            PG8_LDB(B0, 1, 0); if constexpr (!HALF_N) PG8_LDB(B1, 1, 1); PG8_SCHED; PG8_LDA(At, 1, 0); PG8_STAGE(PG8_SA(0, 1), a2 + hA, voffA);
            PG8_WAIT_V(8); PG8_WAIT_L(0); PG8_BAR; PG8_MMA(0, 0, At, B0); if constexpr (!HALF_N) PG8_MMA(0, 1, At, B1); PG8_BAR; PG8_SCHED;
            PG8_LDA(At, 1, 1); PG8_STAGE(PG8_SB(1, 0), b3, voffB); PG8_STAGE(PG8_SB(1, 1), b3 + hB, voffB); PG8_STAGE(PG8_SA(1, 0), a3, voffA);
            PG8_WAIT_V(8); PG8_WAIT_L(0); PG8_BAR; PG8_MMA(1, 0, At, B0); if constexpr (!HALF_N) PG8_MMA(1, 1, At, B1); PG8_BAR; PG8_SCHED;
        }
        if (wr == 0) PG8_BAR;
        if (cur.part) { E.mid(acc, cur, wr, wc, fr, fq); }
        else {
            E(acc, cur, wr, wc, fr, fq);
            if (has_next) {
#pragma unroll
                for (int a = 0; a < 2; ++a)
#pragma unroll
                    for (int b = 0; b < 2; ++b)
#pragma unroll
                        for (int m = 0; m < 4; ++m)
#pragma unroll
                            for (int n = 0; n < 2; ++n) acc[a][b][m][n] = (f32x4){0.f, 0.f, 0.f, 0.f};
            }
        }
        if (!has_next) break;
        cur = nxt; cA = nA; cB = nB; ++ui;
        if (wr == 1) PG8_BAR;
    }
    PG8_WAIT_V(0);
    PG8_BAR;
#undef PG8_SA
#undef PG8_SB
#undef PG8_STAGE
#undef PG8_LDA
#undef PG8_LDB
#undef PG8_MMA
#undef PG8_WAIT_V
#undef PG8_WAIT_L
#undef PG8_BAR
#undef PG8_SCHED
}
}
using pg8::Unit; using pg8::HALF; using pg8::BM;

typedef f32x4 AccT[2][2][4][2];

__device__ __forceinline__ void red_put(LAS float* red, int ai, int wr, int m, int fr, int wc, int fq, float s) { if (fq == 0) red[(ai * HALF + wr * 64 + m * 16 + fr) * 4 + wc] = s; }
template <bool WT>
__device__ __forceinline__ void red_flush(LAS float* red, float* part, const Unit& u) {
    asm volatile("s_waitcnt lgkmcnt(0)" ::: "memory"); __builtin_amdgcn_s_barrier(); asm volatile("" ::: "memory");
    const int t = threadIdx.x;
    if (t < 256) { const f32x4 v = *(const LAS f32x4*)(red + t * 4); const float sum = (v[0] + v[1]) + (v[2] + v[3]); float* p = part + (size_t)(u.pm * BM + t) * 4 + u.pn;
        if (WT) __hip_atomic_store(p, sum, __ATOMIC_RELAXED, __HIP_MEMORY_SCOPE_AGENT); else *p = sum; }
}
__device__ __forceinline__ float sum4(const f32x4 v) { return (v[0] + v[1]) + (v[2] + v[3]); }
struct EpiGateUp {
    const float* ssq; bf16_t* act;
    __device__ __forceinline__ void mid(AccT&, const Unit&, int, int, int, int) const {}
    __device__ __forceinline__ void operator()(const AccT& acc, const Unit& u, int wr, int wc, int fr, int fq) const {
        const int row0 = u.pm * BM + wr * 64 + fr, col0 = u.pn * 128 + wc * 32 + 8 * fq;
        float rsv[2][4];
#pragma unroll
        for (int ai = 0; ai < 2; ++ai)
#pragma unroll
            for (int m = 0; m < 4; ++m) rsv[ai][m] = sum4(*(const f32x4*)(ssq + (size_t)(row0 + ai * HALF + m * 16) * 4));
#pragma unroll
        for (int ai = 0; ai < 2; ++ai)
#pragma unroll
            for (int m = 0; m < 4; ++m) {
                const int row = row0 + ai * HALF + m * 16; const float rs = rs_from_ssq(rsv[ai][m], 1.0f / DM), rs2 = rs * rs, nl = -1.4426950409f * rs;
                f32x4 a[2];
#pragma unroll
                for (int n = 0; n < 2; ++n) { const f32x4 ga = acc[ai][0][m][n], ua = acc[ai][1][m][n]; const f32x4 pr = (ga * ua) * rs2, tt = ga * nl; f32x4 e;
#pragma unroll
                    for (int j = 0; j < 4; ++j) e[j] = __builtin_amdgcn_exp2f(tt[j]);
                    e = e + 1.0f; f32x4 r;
#pragma unroll
                    for (int j = 0; j < 4; ++j) r[j] = __builtin_amdgcn_rcpf(e[j]);
                    a[n] = pr * r; }
                u32x4 w; w.x = cvt_pk_bf16(a[0][0], a[0][1]); w.y = cvt_pk_bf16(a[0][2], a[0][3]); w.z = cvt_pk_bf16(a[1][0], a[1][1]); w.w = cvt_pk_bf16(a[1][2], a[1][3]);
                *(u32x4*)(act + (size_t)row * DFF + col0) = w;
            }
    }
};
struct EpiResid {
    bf16_t* xb; float* ssq_out; float scale; const float* ssq_row; LAS float* red;
    __device__ __forceinline__ void mid(AccT&, const Unit&, int, int, int, int) const {}
    __device__ __forceinline__ void operator()(const AccT& acc, const Unit& u, int wr, int wc, int fr, int fq) const {
        const int row0 = u.pm * BM + wr * 64 + fr, col0 = u.pn * BM + wc * 32 + 8 * fq;
        float scv[2][4];
#pragma unroll
        for (int ai = 0; ai < 2; ++ai)
#pragma unroll
            for (int m = 0; m < 4; ++m) { f32x2 t = (f32x2){0.f, 0.f}; if (ssq_row) t = *(const f32x2*)(ssq_row + (size_t)(row0 + ai * HALF + m * 16) * 4); scv[ai][m] = t[0] + t[1]; }
#pragma unroll
        for (int ai = 0; ai < 2; ++ai) {
            u32x4 xi[4][2];
#pragma unroll
            for (int m = 0; m < 4; ++m)
#pragma unroll
                for (int bj = 0; bj < 2; ++bj) xi[m][bj] = *(const u32x4*)(xb + (size_t)(row0 + ai * HALF + m * 16) * DM + col0 + bj * HALF);
#pragma unroll
            for (int m = 0; m < 4; ++m) {
                const int row = row0 + ai * HALF + m * 16; const size_t off = (size_t)row * DM + col0; float s = 0.f;
                const float sc = ssq_row ? scale * rs_from_ssq(scv[ai][m], 1.0f / DSSM) : scale;
#pragma unroll
                for (int bj = 0; bj < 2; ++bj) { const u32x4 x = xi[m][bj]; const f32x4 o0 = bf4_lo(x) + acc[ai][bj][m][0] * sc, o1 = bf4_hi(x) + acc[ai][bj][m][1] * sc;
                    const f32x4 q = o0 * o0 + o1 * o1; s += (q[0] + q[1]) + (q[2] + q[3]);
                    *(u32x4*)(xb + off + bj * HALF) = pack8(o0, o1); }
                s += __shfl_xor(s, 16); s += __shfl_xor(s, 32);
                red_put(red, ai, wr, m, fr, wc, fq, s);
            }
        }
        red_flush<false>(red, ssq_out, u);
    }
};
struct EpiFinal {
    const bf16_t* xb; float* ssq_out; unsigned* cnt; const float* gn; float* out; LAS float* red;
    __device__ __forceinline__ void mid(AccT&, const Unit&, int, int, int, int) const {}
    __device__ __forceinline__ void operator()(const AccT& acc, const Unit& u, int wr, int wc, int fr, int fq) const {
        const int row0 = u.pm * BM + wr * 64 + fr, col0 = u.pn * BM + wc * 32 + 8 * fq;
#pragma unroll
        for (int ai = 0; ai < 2; ++ai) {
            u32x4 xi[4][2];
#pragma unroll
            for (int m = 0; m < 4; ++m)
#pragma unroll
                for (int bj = 0; bj < 2; ++bj) xi[m][bj] = *(const u32x4*)(xb + (size_t)(row0 + ai * HALF + m * 16) * DM + col0 + bj * HALF);
#pragma unroll
            for (int m = 0; m < 4; ++m) { float s = 0.f;
#pragma unroll
                for (int bj = 0; bj < 2; ++bj) { const u32x4 x = xi[m][bj]; const f32x4 o0 = bf4_lo(x) + acc[ai][bj][m][0] * 0.5f, o1 = bf4_hi(x) + acc[ai][bj][m][1] * 0.5f;
                    const f32x4 q = o0 * o0 + o1 * o1; s += (q[0] + q[1]) + (q[2] + q[3]); }
                s += __shfl_xor(s, 16); s += __shfl_xor(s, 32);
                red_put(red, ai, wr, m, fr, wc, fq, s);
            }
        }
        red_flush<true>(red, ssq_out, u);
        asm volatile("s_waitcnt vmcnt(0)" ::: "memory");
        unsigned* cw = cnt + 64 * u.pm;
        if ((threadIdx.x & 63) == 0 && threadIdx.x < 256) __hip_atomic_fetch_add(cw, 1u, __ATOMIC_RELAXED, __HIP_MEMORY_SCOPE_AGENT);
        { unsigned sp = 0;
          while ((unsigned)__builtin_amdgcn_readfirstlane(__hip_atomic_load(cw, __ATOMIC_RELAXED, __HIP_MEMORY_SCOPE_AGENT)) < 16u) { __builtin_amdgcn_s_sleep(2); if (++sp > (1u << 20)) break; } }
        __builtin_amdgcn_fence(__ATOMIC_ACQUIRE, "agent");
        f32x4 gv[2][2];
#pragma unroll
        for (int bj = 0; bj < 2; ++bj)
#pragma unroll
            for (int n = 0; n < 2; ++n) gv[bj][n] = *(const f32x4*)(gn + col0 + bj * HALF + n * 4);
#pragma unroll
        for (int ai = 0; ai < 2; ++ai) {
            u32x4 xi[4][2]; float sq[4];
#pragma unroll
            for (int m = 0; m < 4; ++m) { const float* pp = ssq_out + (size_t)(row0 + ai * HALF + m * 16) * 4;
                sq[m] = (__hip_atomic_load(pp, __ATOMIC_RELAXED, __HIP_MEMORY_SCOPE_AGENT) + __hip_atomic_load(pp + 1, __ATOMIC_RELAXED, __HIP_MEMORY_SCOPE_AGENT)) + (__hip_atomic_load(pp + 2, __ATOMIC_RELAXED, __HIP_MEMORY_SCOPE_AGENT) + __hip_atomic_load(pp + 3, __ATOMIC_RELAXED, __HIP_MEMORY_SCOPE_AGENT));
#pragma unroll
                for (int bj = 0; bj < 2; ++bj) xi[m][bj] = *(const u32x4*)(xb + (size_t)(row0 + ai * HALF + m * 16) * DM + col0 + bj * HALF); }
#pragma unroll
            for (int m = 0; m < 4; ++m) { const float rs = rs_from_ssq(sq[m], 1.0f / DM); float* orow = out + (size_t)(row0 + ai * HALF + m * 16) * DM + col0;
#pragma unroll
                for (int bj = 0; bj < 2; ++bj) { const u32x4 x = xi[m][bj];
                    *(f32x4*)(orow + bj * HALF) = (bf4_lo(x) + acc[ai][bj][m][0] * 0.5f) * (gv[bj][0] * rs); *(f32x4*)(orow + bj * HALF + 4) = (bf4_hi(x) + acc[ai][bj][m][1] * 0.5f) * (gv[bj][1] * rs); }
            }
        }
    }
};
struct EpiWin {
    const float* ssq; bf16_t* app; bf16_t* qkv; const float* ropec; const float* ropes;
    __device__ __forceinline__ void mid(AccT&, const Unit&, int, int, int, int) const {}
    __device__ __forceinline__ void operator()(const AccT& acc, const Unit& u, int wr, int wc, int fr, int fq) const {
        const int row0 = u.pm * BM + wr * 64 + fr;
        const bool rope_w = (u.pn >= 2) && ((wc & 1) == 0);
        float rsv[2][4];
#pragma unroll
        for (int ai = 0; ai < 2; ++ai)
#pragma unroll
            for (int m = 0; m < 4; ++m) rsv[ai][m] = sum4(*(const f32x4*)(ssq + (size_t)(row0 + ai * HALF + m * 16) * 4));
#pragma unroll
        for (int ai = 0; ai < 2; ++ai)
#pragma unroll
            for (int mh = 0; mh < 2; ++mh) {
                f32x4 csv[2][2], snv[2][2];
                if (rope_w) {
#pragma unroll
                    for (int mm = 0; mm < 2; ++mm) { const int pos = (row0 + ai * HALF + (2 * mh + mm) * 16) & (SEQ - 1);
#pragma unroll
                        for (int n = 0; n < 2; ++n) { csv[mm][n] = *(const f32x4*)(ropec + pos * 8 + 4 * n); snv[mm][n] = *(const f32x4*)(ropes + pos * 8 + 4 * n); } }
                } else {
#pragma unroll
                    for (int mm = 0; mm < 2; ++mm)
#pragma unroll
                        for (int n = 0; n < 2; ++n) { csv[mm][n] = (f32x4){1.f, 1.f, 1.f, 1.f}; snv[mm][n] = (f32x4){0.f, 0.f, 0.f, 0.f}; }
                }
#pragma unroll
                for (int mm = 0; mm < 2; ++mm) {
                    const int m = 2 * mh + mm, row = row0 + ai * HALF + m * 16; const float rs = rs_from_ssq(rsv[ai][m], 1.0f / DM);
#pragma unroll
                    for (int bj = 0; bj < 2; ++bj) {
                        const int col = u.pn * BM + bj * HALF + wc * 32 + 8 * fq; f32x4 v0 = acc[ai][bj][m][0] * rs, v1 = acc[ai][bj][m][1] * rs;
                        bf16_t* p;
                        if (u.pn < 2) { const int g = col >> 4, c = col & 15; p = app + ((size_t)(g * NBN + (row >> 5)) * KY + (row & 31) * NCH + c); }
                        else {
                            const bool is_v = (u.pn == 4 && bj == 1);
                            if (!is_v && rope_w) {
                                f32x4 p0, p1;
#pragma unroll
                                for (int j = 0; j < 4; ++j) { p0[j] = __shfl_xor(v0[j], 16); p1[j] = __shfl_xor(v1[j], 16); }
                                if (fq == 0) { v0 = v0 * csv[mm][0] - p0 * snv[mm][0]; v1 = v1 * csv[mm][1] - p1 * snv[mm][1]; }
                                else if (fq == 1) { v0 = v0 * csv[mm][0] + p0 * snv[mm][0]; v1 = v1 * csv[mm][1] + p1 * snv[mm][1]; }
                            }
                            p = qkv + (size_t)row * 768 + (col - 512);
                        }
                        u32x4 w; w.x = cvt_pk_bf16(v0[0], v0[1]); w.y = cvt_pk_bf16(v0[2], v0[3]); w.z = cvt_pk_bf16(v1[0], v1[1]); w.w = cvt_pk_bf16(v1[2], v1[3]); *(u32x4*)p = w;
                    }
                }
            }
    }
};
struct EpiS1 {
    float* sloc;
    __device__ __forceinline__ void mid(AccT&, const Unit&, int, int, int, int) const {}
    __device__ __forceinline__ void operator()(const AccT& acc, const Unit& u, int wr, int wc, int fr, int fq) const {
        const int row0 = u.pm * BM + wr * 64 + fr, col0 = wc * 32 + 8 * fq;
#pragma unroll
        for (int ai = 0; ai < 2; ++ai)
#pragma unroll
            for (int m = 0; m < 4; ++m) { float* rowp = sloc + (size_t)(row0 + ai * HALF + m * 16) * 128 + col0;
#pragma unroll
                for (int n = 0; n < 2; ++n) *(f32x4*)(rowp + n * 4) = acc[ai][0][m][n]; }
    }
};
struct EpiY {
    const bf16_t* app; const float* Dv; bf16_t* ygelu;
    __device__ __forceinline__ void mid(AccT&, const Unit&, int, int, int, int) const {}
    __device__ __forceinline__ void operator()(const AccT& acc, const Unit& u, int wr, int wc, int fr, int fq) const {
        const int row0 = u.pm * BM + wr * 64 + fr, g = u.pm >> 2, colb = (u.pn & 1) * BM + wc * 32 + 8 * fq, c0 = 8 * (fq & 1);
        const f32x4 d0 = *(const f32x4*)(Dv + g * NCH + c0), d1 = *(const f32x4*)(Dv + g * NCH + c0 + 4);
#pragma unroll
        for (int ai = 0; ai < 2; ++ai) {
            u32x4 uw[4][2];
#pragma unroll
            for (int m = 0; m < 4; ++m)
#pragma unroll
                for (int bj = 0; bj < 2; ++bj) uw[m][bj] = *(const u32x4*)(app + (size_t)(row0 + ai * HALF + m * 16) * KY + colb + bj * HALF);
#pragma unroll
            for (int m = 0; m < 4; ++m) {
                const int row = row0 + ai * HALF + m * 16, nidx = row & (NBN - 1);
#pragma unroll
                for (int bj = 0; bj < 2; ++bj) {
                    const int colg = colb + bj * HALF, t = colg >> 4; const u32x4 w0 = uw[m][bj];
                    const f32x4 y0 = gelu_tanh_v(acc[ai][bj][m][0] + d0 * bf4_lo(w0)), y1 = gelu_tanh_v(acc[ai][bj][m][1] + d1 * bf4_hi(w0));
                    *(u32x4*)(ygelu + (size_t)(nidx * TCH + t) * DSSM + g * NCH + c0) = pack8(y0, y1);
                }
            }
        }
    }
};
struct EpiGlu {
    const bf16_t* ygelu; const float* bias; bf16_t* ycat; float* ssq_out; LAS float* red; unsigned* cnt;
    __device__ __forceinline__ void mid(AccT&, const Unit&, int, int, int, int) const {}
    __device__ __forceinline__ void operator()(const AccT& acc, const Unit& u, int wr, int wc, int fr, int fq) const {
        const int row0 = u.pm * BM + wr * 64 + fr, col0 = u.pn * BM + wc * 32 + 8 * fq;
        f32x4 bv[2][2];
#pragma unroll
        for (int bj = 0; bj < 2; ++bj)
#pragma unroll
            for (int n = 0; n < 2; ++n) bv[bj][n] = *(const f32x4*)(bias + col0 + bj * HALF + n * 4);
#pragma unroll
        for (int ai = 0; ai < 2; ++ai) {
            u32x4 yv[4][2];
#pragma unroll
            for (int m = 0; m < 4; ++m)
#pragma unroll
                for (int bj = 0; bj < 2; ++bj) yv[m][bj] = *(const u32x4*)(ygelu + (size_t)(row0 + ai * HALF + m * 16) * DSSM + col0 + bj * HALF);
#pragma unroll
            for (int m = 0; m < 4; ++m) {
                const int row = row0 + ai * HALF + m * 16; float s = 0.f;
#pragma unroll
                for (int bj = 0; bj < 2; ++bj) { const u32x4 yw = yv[m][bj];
                    const f32x4 z0 = bf4_lo(yw) * sigmoid_v(acc[ai][bj][m][0] + bv[bj][0]), z1 = bf4_hi(yw) * sigmoid_v(acc[ai][bj][m][1] + bv[bj][1]);
                    const f32x4 q = z0 * z0 + z1 * z1; s += (q[0] + q[1]) + (q[2] + q[3]);
                    *(u32x4*)(ycat + (size_t)row * DM + col0 + bj * HALF) = pack8(z0, z1); }
                s += __shfl_xor(s, 16); s += __shfl_xor(s, 32);
                red_put(red, ai, wr, m, fr, wc, fq, s);
            }
        }
        red_flush<true>(red, ssq_out, u);
        asm volatile("s_waitcnt vmcnt(0)" ::: "memory");
        if ((threadIdx.x & 63) == 0 && threadIdx.x < 256) __hip_atomic_fetch_add(cnt + 64 * u.pm, 1u, __ATOMIC_RELAXED, __HIP_MEMORY_SCOPE_AGENT);
    }
};

#define XB_TMO      128
#define XB_XCNT(j)  (256  + 64 * (j))
#define XB_XSUB(j)  (1280 + 64 * (j))
#define XB_XGEN(j)  (2304 + 64 * (j))
#define XB_TOP      3328
#define XB_TOPGEN   3392
#define XCD_BAR_WORDS 3456
#define XB_SPIN_CAP (1u << 18)
__device__ __forceinline__ unsigned xb_ld(unsigned* p)              { return __hip_atomic_load(p, __ATOMIC_RELAXED, __HIP_MEMORY_SCOPE_AGENT); }
__device__ __forceinline__ unsigned xb_add(unsigned* p, unsigned v) { return __hip_atomic_fetch_add(p, v, __ATOMIC_RELAXED, __HIP_MEMORY_SCOPE_AGENT); }
__device__ __forceinline__ unsigned xb_xcc_id() { return (unsigned)__builtin_amdgcn_s_getreg((3 << 11) | 20) & 0xFu; }
#define XB_SPIN(cond, bar) do { unsigned _sp = 0; while (cond) { __builtin_amdgcn_s_sleep(1); \
    if ((++_sp & 255u) == 0u) { if (xb_ld(&(bar)[XB_TMO])) break; if (_sp > XB_SPIN_CAP) { atomicAdd(&(bar)[XB_TMO], 1u); break; } } } } while (0)
struct XcdBarrier { unsigned* bar; unsigned x; volatile LAS unsigned* st; };
__device__ __forceinline__ XcdBarrier xcd_barrier_post(unsigned* bar, volatile LAS unsigned* st) {
    XcdBarrier b; b.bar = bar; b.x = xb_xcc_id(); b.st = st;
    if (threadIdx.x == 0) (void)xb_add(&bar[XB_XCNT(b.x)], 1u);
    return b;
}
__device__ __forceinline__ void xcd_barrier_complete(unsigned* bar, unsigned x, unsigned& nloc, unsigned& nx) {
    const unsigned G = gridDim.x * gridDim.y * gridDim.z;
    unsigned sum, cnt, mine, sp = 0u;
    for (;;) {
        sum = 0u; cnt = 0u; mine = 0u;
#pragma unroll
        for (unsigned j = 0; j < 16; ++j) { const unsigned c = xb_ld(&bar[XB_XCNT(j)]); sum += c; cnt += (c > 0u) ? 1u : 0u; mine = (j == x) ? c : mine; }
        if (sum == G) break;
        __builtin_amdgcn_s_sleep(1);
        if ((++sp & 255u) == 0u) { if (xb_ld(&bar[XB_TMO])) break; if (sp > XB_SPIN_CAP) { atomicAdd(&bar[XB_TMO], 1u); break; } }
    }
    nloc = mine > 0u ? mine : 1u; nx = cnt > 0u ? cnt : 1u;
}
__device__ __forceinline__ void xcd_barrier(const XcdBarrier& b) {
    asm volatile("s_waitcnt vmcnt(0)" ::: "memory");
    __syncthreads();
    if (threadIdx.x == 0) {
        unsigned* bar = b.bar;
        __builtin_amdgcn_s_waitcnt(0);
        unsigned nloc = b.st[0], nx = b.st[1];
        if (nloc == 0u) { xcd_barrier_complete(bar, b.x, nloc, nx); b.st[0] = nloc; b.st[1] = nx; }
        const unsigned old = xb_add(&bar[XB_XSUB(b.x)], 1u);
        const unsigned gen = old / nloc;
        if (old + 1u == (gen + 1u) * nloc) {
            __builtin_amdgcn_fence(__ATOMIC_RELEASE, "agent");
            asm volatile("s_waitcnt vmcnt(0)" ::: "memory");
            const unsigned og = xb_add(&bar[XB_TOP], 1u);
            const unsigned tg = og / nx;
            if (og + 1u == (tg + 1u) * nx) xb_add(&bar[XB_TOPGEN], 1u);
            else XB_SPIN(xb_ld(&bar[XB_TOPGEN]) == tg, bar);
            __builtin_amdgcn_fence(__ATOMIC_ACQUIRE, "agent");
            xb_add(&bar[XB_XGEN(b.x)], 1u);
            asm volatile("s_waitcnt vmcnt(0)" ::: "memory");
        } else {
            XB_SPIN(xb_ld(&bar[XB_XGEN(b.x)]) == gen, bar);
            __builtin_amdgcn_fence(__ATOMIC_ACQUIRE, "agent");
            asm volatile("s_waitcnt vmcnt(0)" ::: "memory");
        }
    }
    __syncthreads();
}

struct Ctx {
    const float* in[26]; float* out; unsigned char* ws; LAS unsigned char* lds; int tid, lane, wave, G, bx;
    __device__ __forceinline__ const float* inp(int i) const { return in[i]; }
};
#define WSP(T, off) ((T*)(C.ws + (off)))

__device__ __forceinline__ void transpose_item(const float* W, int K, int N, bf16_t* WT, const float* g0, const float* g1, int ksplit, int mode, LAS float* scr, int item, int lane) {
    const int nblk = N / 32, kb = item / nblk, nb = item % nblk, k0 = 64 * kb, n0 = 32 * nb;
#pragma unroll
    for (int i = 0; i < 8; ++i) { const int kk = 8 * i + (lane >> 3), k = k0 + kk, n4 = (lane & 7) * 4; const float gs = g0 ? (k < ksplit ? g0[k] : g1[k - ksplit]) : 1.0f;
        const f32x4 v = __builtin_nontemporal_load((const f32x4*)(W + (size_t)k * N + n0 + n4)); LAS float* d = scr + kk * 33 + n4; d[0] = v[0] * gs; d[1] = v[1] * gs; d[2] = v[2] * gs; d[3] = v[3] * gs; }
    asm volatile("s_waitcnt lgkmcnt(0)" ::: "memory");
    const int c = lane & 7;
#pragma unroll
    for (int j = 0; j < 4; ++j) { const int n = (lane >> 3) + 8 * j, ncol = n0 + n; const LAS float* s = scr + (8 * c) * 33 + n;
        const int drow = (mode == 0) ? ncol : (((ncol >> 7) << 8) + (ncol & 127) + (mode == 2 ? 128 : 0));
        u32x4 o; o.x = cvt_pk_bf16(s[0 * 33], s[1 * 33]); o.y = cvt_pk_bf16(s[2 * 33], s[3 * 33]); o.z = cvt_pk_bf16(s[4 * 33], s[5 * 33]); o.w = cvt_pk_bf16(s[6 * 33], s[7 * 33]);
        *(u32x4*)(WT + (size_t)drow * K + k0 + 8 * c) = o; }
    asm volatile("s_waitcnt lgkmcnt(0)" ::: "memory");
}

__device__ __forceinline__ float wave_sum(float v) {
#pragma unroll
    for (int o = 1; o < 64; o <<= 1) v += __shfl_xor(v, o);
    return v;
}

__device__ __forceinline__ void phase_prep0(const Ctx& C) {
    const int gw = C.wave * C.G + C.bx, NGW = C.G * NWAVES;
    const int gt = C.bx * NTHREADS + C.tid, NGT = C.G * NTHREADS;
    float* ssq = WSP(float, WS_SSQ);
    {
        const float* x = C.inp(0); bf16_t* xb = WSP(bf16_t, WS_XB);
        for (int row = gw; row < M_TOK; row += NGW) {
            const f32x4* xr = (const f32x4*)(x + (size_t)row * DM) + C.lane; f32x4 v[4]; float s = 0.f;
#pragma unroll
            for (int j = 0; j < 4; ++j) { v[j] = __builtin_nontemporal_load(xr + 64 * j); s += (v[j][0] * v[j][0] + v[j][1] * v[j][1]) + (v[j][2] * v[j][2] + v[j][3] * v[j][3]); }
            s = wave_sum(s);
            u32x2* o8 = (u32x2*)(xb + (size_t)row * DM) + C.lane;
#pragma unroll
            for (int j = 0; j < 4; ++j) { u32x2 w; w.x = cvt_pk_bf16(v[j][0], v[j][1]); w.y = cvt_pk_bf16(v[j][2], v[j][3]); o8[64 * j] = w; }
            if (C.lane == 0) *(f32x4*)(ssq + (size_t)row * 4) = (f32x4){s, 0.f, 0.f, 0.f};
        }
    }
    for (int i = gt; i < 2 * 128 * 64; i += NGT) ssq[5 * SSQ_STRIDE + i] = 0.f;
    {
        LAS float* scr = (LAS float*)(C.lds + C.wave * 16384);
        constexpr int I_GU = (DM / 64) * (DFF / 32), I_DN = (DFF / 64) * (DM / 32), I_IN = (DM / 64) * (DIN / 32), I_OUT = (DM / 64) * (DM / 32), I_GLU = (DSSM / 64) * (DSSM / 32);
        constexpr int NITEMS = 2 * I_GU + I_DN + I_IN;
        for (int it = gw; it < NITEMS; it += NGW) {
            int r = it;
            if (r < I_GU) { transpose_item(C.inp(2), DM, DFF, WSP(bf16_t, WS_WGU1), C.inp(1), C.inp(1), DM, 1, scr, r, C.lane); continue; } r -= I_GU;
            if (r < I_GU) { transpose_item(C.inp(3), DM, DFF, WSP(bf16_t, WS_WGU1), C.inp(1), C.inp(1), DM, 2, scr, r, C.lane); continue; } r -= I_GU;
            if (r < I_DN) { transpose_item(C.inp(4), DFF, DM, WSP(bf16_t, WS_WD1), nullptr, nullptr, 0, 0, scr, r, C.lane); continue; } r -= I_DN;
            transpose_item(C.inp(6), DM, DIN, WSP(bf16_t, WS_WIN), C.inp(5), C.inp(5), DM, 0, scr, r, C.lane);
        }
    }
    {
        float* rc = WSP(float, WS_ROPE); float* rsn = rc + SEQ * 8;
        for (int i = gt; i < SEQ * 8; i += NGT) {
            const int pos = i >> 3, k = i & 7;
            const double f = (k == 0) ? 1.0 : (k == 1) ? 0.19392274474868576 : (k == 2) ? 0.03760603093086393 : (k == 3) ? 0.007292664737217109 : (k == 4) ? 0.001414213562373095 : (k == 5) ? 0.0002742481756762073 : (k == 6) ? 5.318295896944988e-05 : 1.031338537721246e-05;
            const double xx = (double)pos * f; const double kk = __builtin_rint(xx * 0.15915494309189535); const float r = (float)(xx - kk * 6.283185307179586);
            rc[i] = cosf(r); rsn[i] = sinf(r);
        }
    }
    {
        f32x2* pw = WSP(f32x2, WS_PW); f32x2* bbar = WSP(f32x2, WS_BBAR);
        for (int i = gt; i < NG * NP * PWN; i += NGT) {
            const int gp = i / PWN, d = i - gp * PWN, g = gp >> 6; const float are = C.inp(7)[gp], aim = C.inp(8)[gp], dt = expf(C.inp(9)[g]);
            const double xx = (double)aim * (double)dt * (double)d; const double kk = __builtin_rint(xx * 0.15915494309189535); const float r = (float)(xx - kk * 6.283185307179586);
            const float mag = expf(are * dt * (float)d); pw[i] = (f32x2){mag * cosf(r), mag * sinf(r)};
        }
        for (int i = gt; i < NG * NP * NCH; i += NGT) {
            const int gp = i >> 4, g = gp >> 6; const float are = C.inp(7)[gp], aim = C.inp(8)[gp], dt = expf(C.inp(9)[g]);
            const double xx = (double)aim * (double)dt; const double kk = __builtin_rint(xx * 0.15915494309189535); const float r = (float)(xx - kk * 6.283185307179586);
            const float mag = expf(are * dt), l1r = mag * cosf(r), l1i = mag * sinf(r);
            const float nr = l1r - 1.0f, ni = l1i, den = 1.0f / (are * are + aim * aim); const float zr = (nr * are + ni * aim) * den, zi = (ni * are - nr * aim) * den;
            const float br = C.inp(10)[i], bi = C.inp(11)[i]; bbar[i] = (f32x2){zr * br - zi * bi, zr * bi + zi * br};
        }
    }
}
__device__ __forceinline__ void weights_late_item(const Ctx& C, int it) {
    LAS float* scr = (LAS float*)(C.lds + C.wave * 16384);
    constexpr int I_GU = (DM / 64) * (DFF / 32), I_DN = (DFF / 64) * (DM / 32), I_OUT = (DM / 64) * (DM / 32), I_GLU = (DSSM / 64) * (DSSM / 32);
    static_assert(2 * I_GU + I_DN + I_OUT + I_GLU == 256 * 19, "late weight items: 19 per workgroup");
    int r = it;
    if (r < I_GU) { transpose_item(C.inp(22), DM, DFF, WSP(bf16_t, WS_WGU2), C.inp(21), C.inp(21), DM, 1, scr, r, C.lane); return; } r -= I_GU;
    if (r < I_GU) { transpose_item(C.inp(23), DM, DFF, WSP(bf16_t, WS_WGU2), C.inp(21), C.inp(21), DM, 2, scr, r, C.lane); return; } r -= I_GU;
    if (r < I_DN) { transpose_item(C.inp(24), DFF, DM, WSP(bf16_t, WS_WD2), nullptr, nullptr, 0, 0, scr, r, C.lane); return; } r -= I_DN;
    if (r < I_OUT) { transpose_item(C.inp(20), DM, DM, WSP(bf16_t, WS_WOUT), C.inp(18), C.inp(19), DSSM, 0, scr, r, C.lane); return; } r -= I_OUT;
    transpose_item(C.inp(15), DSSM, DSSM, WSP(bf16_t, WS_WGLU), nullptr, nullptr, 0, 0, scr, r, C.lane);
}
__device__ __forceinline__ void phase_prep1(const Ctx& C) {
    LAS float* L = (LAS float*)C.lds;
    LAS float* Cr = L; LAS float* Ci = L + 1024; LAS f32x2* Bb = (LAS f32x2*)(L + 2048); LAS f32x2* Pw = (LAS f32x2*)(L + 4096);
    const f32x2* pw = WSP(f32x2, WS_PW); const f32x2* bbar = WSP(f32x2, WS_BBAR); float* ktab = WSP(float, WS_KTAB);
    constexpr int per = 4;
    const int base = (C.bx & 255) * per, g = base >> 5, d0 = base & 31;
    __syncthreads();
    for (int i = C.tid; i < 1024; i += NTHREADS) { Cr[i] = C.inp(12)[g * 1024 + i]; Ci[i] = C.inp(13)[g * 1024 + i]; Bb[i] = bbar[g * 1024 + i]; }
    for (int i = C.tid; i < per * 64; i += NTHREADS) { const int k = i >> 6, p = i & 63; Pw[i] = pw[(size_t)(g * 64 + p) * PWN + d0 + k]; }
    __syncthreads();
    const int half = C.tid >> 8, t = C.tid & 255, cp = t >> 4, c = t & 15;
#pragma unroll 1
    for (int k = half; k < per; k += 2) {
        float s = 0.f;
#pragma unroll 4
        for (int p = 0; p < NP; ++p) { const float cr = Cr[cp * 64 + p], ci = Ci[cp * 64 + p]; const f32x2 w = Pw[k * 64 + p], b = Bb[p * 16 + c];
            const float xr = cr * w.x - ci * w.y, xi = cr * w.y + ci * w.x; s += xr * b.x - xi * b.y; }
        ktab[(size_t)(base + k) * 256 + t] = s;
    }
    __syncthreads();
}
__device__ __forceinline__ void phase_prep2(const Ctx& C, int gt, int NGT) {
    const f32x2* pw = WSP(f32x2, WS_PW); const f32x2* bbar = WSP(f32x2, WS_BBAR); const float* ktab = WSP(float, WS_KTAB);
    bf16_t* bty = WSP(bf16_t, WS_BTY); bf16_t* bts1 = WSP(bf16_t, WS_BTS1);
    for (int q = gt; q < NG * K1 * (KY / 8); q += NGT) {
        const int row = q / (KY / 8), ck = q % (KY / 8), g = row >> 9, t = (row >> 4) & 31, cp = row & 15, k0 = ck * 8; float v[8];
        if (k0 < K1) { const int tau = k0 >> 4, c0 = k0 & 15;
            if (t >= tau) { const f32x4* kp = (const f32x4*)(ktab + ((size_t)((g * TCH + (t - tau)) * 16 + cp) * 16 + c0)); const f32x4 a = kp[0], b = kp[1];
                v[0] = a[0]; v[1] = a[1]; v[2] = a[2]; v[3] = a[3]; v[4] = b[0]; v[5] = b[1]; v[6] = b[2]; v[7] = b[3]; }
            else {
#pragma unroll
                for (int e = 0; e < 8; ++e) v[e] = 0.f; }
        } else { const int p0 = (k0 - K1) >> 1;
#pragma unroll
            for (int e = 0; e < 4; ++e) { const int p = p0 + e; const float cr = C.inp(12)[(g * 16 + cp) * 64 + p], ci = C.inp(13)[(g * 16 + cp) * 64 + p]; const f32x2 w = pw[(size_t)(g * 64 + p) * PWN + t + 1];
                v[2 * e] = cr * w.x - ci * w.y; v[2 * e + 1] = -(cr * w.y + ci * w.x); }
        }
        u32x4 o; o.x = cvt_pk_bf16(v[0], v[1]); o.y = cvt_pk_bf16(v[2], v[3]); o.z = cvt_pk_bf16(v[4], v[5]); o.w = cvt_pk_bf16(v[6], v[7]);
        *(u32x4*)(bty + (size_t)row * KY + k0) = o;
    }
    for (int q = gt; q < NG * 128 * (K1 / 8); q += NGT) {
        const int g = q / (128 * 64), p2 = (q >> 6) & 127, ck = q & 63, k0 = ck * 8, tau = k0 >> 4, c0 = k0 & 15, part = p2 & 1, p = p2 >> 1;
        const f32x2 w = pw[(size_t)(g * 64 + p) * PWN + (TCH - 1 - tau)]; float v[8];
#pragma unroll
        for (int e = 0; e < 8; ++e) { const f32x2 b = bbar[(g * 64 + p) * 16 + c0 + e]; v[e] = part == 0 ? (w.x * b.x - w.y * b.y) : (w.x * b.y + w.y * b.x); }
        u32x4 o; o.x = cvt_pk_bf16(v[0], v[1]); o.y = cvt_pk_bf16(v[2], v[3]); o.z = cvt_pk_bf16(v[4], v[5]); o.w = cvt_pk_bf16(v[6], v[7]);
        *(u32x4*)(bts1 + (size_t)(g * 256 + p2) * K1 + k0) = o;
    }
}
__device__ __forceinline__ void carry_task(const Ctx& C, int b, int g) {
    const f32x2* pw = WSP(f32x2, WS_PW); const float* sloc = WSP(float, WS_SLOC); bf16_t* app = WSP(bf16_t, WS_APP);
    const int p = C.lane; const f32x2 lt = pw[(size_t)(g * 64 + p) * PWN + TCH];
    float sr = 0.f, si = 0.f;
    const size_t row0 = (size_t)g * NBN + b * NCK;
#pragma unroll 1
    for (int c0 = 0; c0 < NCK; c0 += 16) {
        f32x2 l[16];
#pragma unroll
        for (int j = 0; j < 16; ++j) l[j] = *(const f32x2*)(sloc + (row0 + c0 + j) * 128 + 2 * p);
#pragma unroll
        for (int j = 0; j < 16; ++j) {
            const size_t row = row0 + c0 + j;
            *(unsigned*)(app + row * KY + K1 + 2 * p) = cvt_pk_bf16(sr, si);
            const float nr = lt.x * sr - lt.y * si + l[j].x, ni = lt.x * si + lt.y * sr + l[j].y; sr = nr; si = ni;
        }
    }
}
typedef float f32x16 __attribute__((ext_vector_type(16)));
#define MFMA32(a, b, c) __builtin_amdgcn_mfma_f32_32x32x16_bf16((a), (b), (c), 0, 0, 0)
__device__ __forceinline__ bf16x8 pack8_mfma(const f32x16& x, int s) {
    u32x4 p; p[0] = cvt_pk_bf16(x[8 * s], x[8 * s + 1]); p[1] = cvt_pk_bf16(x[8 * s + 2], x[8 * s + 3]); p[2] = cvt_pk_bf16(x[8 * s + 4], x[8 * s + 5]); p[3] = cvt_pk_bf16(x[8 * s + 6], x[8 * s + 7]);
    return __builtin_bit_cast(bf16x8, p);
}
__device__ __forceinline__ void phase_attn(const Ctx& C) {
    constexpr int KROW = 144, KSZ = 256 * KROW, VROW = 528, VSZ = 64 * VROW, V_OFF = 2 * KSZ;
    static_assert(V_OFF + 2 * VSZ <= LDS_BYTES, "attention LDS");
    const bf16_t* qkv = WSP(bf16_t, WS_QKV); bf16_t* ycat = WSP(bf16_t, WS_YCAT); const float* ssq_ssm = WSP(float, WS_SSQ) + 2 * SSQ_STRIDE; unsigned* glu_cnt = (unsigned*)(WSP(float, WS_SSQ) + 5 * SSQ_STRIDE) + 128 * 64;
    LAS unsigned char* lds = C.lds; const int tid = C.tid, lane = C.lane, wave = C.wave;
    for (int it0 = C.bx; it0 < BATCH * 32; it0 += C.G) {
        const int item = (C.G == 256) ? (((it0 & 7) << 5) | (it0 >> 3)) : it0;
        const int b = item >> 5, nb = item & 31, tok0 = b * SEQ + nb * 128; const long kbase = (long)tok0 - 128;
        __syncthreads();
#pragma unroll
        for (int i = 0; i < 8; ++i) { const int c = tid + NTHREADS * i, part = c & 7, sk = (c >> 3) & 255, kvh = c >> 11;
            if (nb > 0 || sk >= 128) { const u32x4 v = *(const u32x4*)(qkv + (size_t)(kbase + sk) * 768 + 512 + kvh * 64 + part * 8); *(LAS u32x4*)(lds + kvh * KSZ + sk * KROW + part * 16) = v; } }
#pragma unroll
        for (int i = 0; i < 4; ++i) { const int c = tid + NTHREADS * i, sp = c & 127, part = (c >> 7) & 7, kvh = c >> 10, sk = 2 * sp;
            if (nb > 0 || sk >= 128) { const bf16_t* vp = qkv + (size_t)(kbase + sk) * 768 + 640 + kvh * 64 + part * 8; const u32x4 v0 = *(const u32x4*)vp, v1 = *(const u32x4*)(vp + 768);
                LAS unsigned char* dst = lds + V_OFF + kvh * VSZ + (part * 8) * VROW + sp * 4;
#pragma unroll
                for (int e = 0; e < 4; ++e) { const unsigned a0 = v0[e], a1 = v1[e];
                    *(LAS unsigned*)(dst + (2 * e) * VROW) = (a0 & 0xffffu) | (a1 << 16); *(LAS unsigned*)(dst + (2 * e + 1) * VROW) = (a0 >> 16) | (a1 & 0xffff0000u); } } }
        __syncthreads();
        const int q0 = wave * 16, ql = lane & 15, hl = (lane >> 4) & 1, h = lane >> 5, a = q0 >> 5, qrel = (q0 & 31) + ql, l31 = lane & 31;
        const int tok = tok0 + q0 + ql;
        float ssq_acc = 0.f;
#pragma unroll 1
        for (int hp = 0; hp < 4; ++hp) {
            const int kvh = hp >> 1, head = 2 * hp + hl;
            bf16x8 qf[4];
#pragma unroll
            for (int ks = 0; ks < 4; ++ks) qf[ks] = *(const bf16x8*)(qkv + (size_t)tok * 768 + head * 64 + 16 * ks + 8 * h);
            f32x16 sc[5];
#pragma unroll
            for (int j = 0; j < 5; ++j) {
#pragma unroll
                for (int r = 0; r < 16; ++r) sc[j][r] = 0.f;
                const int st = a + j;
                if (nb > 0 || st >= 4) {
#pragma unroll
                    for (int ks = 0; ks < 4; ++ks) { const bf16x8 kf = *(const LAS bf16x8*)(lds + kvh * KSZ + (32 * st + l31) * KROW + (16 * ks + 8 * h) * 2); sc[j] = MFMA32(kf, qf[ks], sc[j]); }
                }
            }
            const float sink = C.inp(17)[head] * 1.4426950409f; float mx = sink;
#pragma unroll
            for (int j = 0; j < 5; ++j) { const bool tv = (nb > 0) || (a + j >= 4);
#pragma unroll
                for (int r = 0; r < 16; ++r) { const int cr = (r & 3) + 8 * (r >> 2) + 4 * h; bool ok = tv; if (j == 0) ok = ok && (cr > qrel); if (j == 4) ok = ok && (cr <= qrel);
                    const float t = ok ? sc[j][r] * 0.18033688011f : -1e30f; sc[j][r] = t; mx = fmaxf(mx, t); } }
            mx = fmaxf(mx, __shfl_xor(mx, 32));
            float lsum = 0.f;
#pragma unroll
            for (int j = 0; j < 5; ++j)
#pragma unroll
                for (int r = 0; r < 16; ++r) { const float p = __builtin_amdgcn_exp2f(sc[j][r] - mx); sc[j][r] = p; lsum += p; }
            lsum += __shfl_xor(lsum, 32); lsum += __builtin_amdgcn_exp2f(sink - mx);
            f32x16 o[2];
#pragma unroll
            for (int r = 0; r < 16; ++r) { o[0][r] = 0.f; o[1][r] = 0.f; }
#pragma unroll
            for (int j = 0; j < 5; ++j) { const int st = a + j;
                if (nb > 0 || st >= 4) {
#pragma unroll
                    for (int ks = 0; ks < 2; ++ks) { const bf16x8 pb = pack8_mfma(sc[j], ks);
#pragma unroll
                        for (int dt = 0; dt < 2; ++dt) { const LAS unsigned char* vp = lds + V_OFF + kvh * VSZ + (32 * dt + l31) * VROW + (32 * st + 16 * ks + 4 * h) * 2;
                            const u32x2 x0 = *(const LAS u32x2*)vp, x1 = *(const LAS u32x2*)(vp + 16); u32x4 xv; xv.x = x0.x; xv.y = x0.y; xv.z = x1.x; xv.w = x1.y;
                            o[dt] = MFMA32(__builtin_bit_cast(bf16x8, xv), pb, o[dt]); } }
                }
            }
            const float inv = __builtin_amdgcn_rcpf(lsum);
#pragma unroll
            for (int dt = 0; dt < 2; ++dt) {
                u32x2 w[4];
#pragma unroll
                for (int g4 = 0; g4 < 4; ++g4) { const float v0 = o[dt][4 * g4] * inv, v1 = o[dt][4 * g4 + 1] * inv, v2 = o[dt][4 * g4 + 2] * inv, v3 = o[dt][4 * g4 + 3] * inv;
                    ssq_acc += (v0 * v0 + v1 * v1) + (v2 * v2 + v3 * v3);
                    w[g4].x = cvt_pk_bf16(v0, v1); w[g4].y = cvt_pk_bf16(v2, v3); }
#pragma unroll
                for (int k = 0; k < 4; k += 2) {
                    const auto rx = __builtin_amdgcn_permlane32_swap(w[k].x, w[k + 1].x, false, false); const auto ry = __builtin_amdgcn_permlane32_swap(w[k].y, w[k + 1].y, false, false);
                    u32x4 q; q.x = rx[0]; q.y = ry[0]; q.z = rx[1]; q.w = ry[1];
                    *(u32x4*)(ycat + (size_t)tok * DM + 512 + head * 64 + 32 * dt + 8 * k + 8 * h) = q; }
            }
        }
        ssq_acc += __shfl_xor(ssq_acc, 16); ssq_acc += __shfl_xor(ssq_acc, 32);
        { unsigned* cw = glu_cnt + 64 * (item >> 1); unsigned sp = 0;
          while ((unsigned)__builtin_amdgcn_readfirstlane(__hip_atomic_load(cw, __ATOMIC_RELAXED, __HIP_MEMORY_SCOPE_AGENT)) < 8u) { __builtin_amdgcn_s_sleep(2); if (++sp > (1u << 20)) break; }
          __builtin_amdgcn_fence(__ATOMIC_ACQUIRE, "agent"); }
        const float ssm_sq = __hip_atomic_load(ssq_ssm + (size_t)tok * 4, __ATOMIC_RELAXED, __HIP_MEMORY_SCOPE_AGENT) + __hip_atomic_load(ssq_ssm + (size_t)tok * 4 + 1, __ATOMIC_RELAXED, __HIP_MEMORY_SCOPE_AGENT);
        const float rs = rsqrtf(ssq_acc * (1.0f / 512.0f) + EPS) * sqrtf(ssm_sq * (1.0f / 512.0f) + EPS);
#pragma unroll 1
        for (int hp = 0; hp < 4; ++hp)
#pragma unroll
            for (int dt = 0; dt < 2; ++dt)
#pragma unroll
                for (int k = 0; k < 4; k += 2) { u32x4* p = (u32x4*)(ycat + (size_t)tok * DM + 512 + (2 * hp + hl) * 64 + 32 * dt + 8 * k + 8 * h); const u32x4 w0 = *p;
                    u32x4 w; w.x = cvt_pk_bf16(bf_lo(w0.x) * rs, bf_hi(w0.x) * rs); w.y = cvt_pk_bf16(bf_lo(w0.y) * rs, bf_hi(w0.y) * rs); w.z = cvt_pk_bf16(bf_lo(w0.z) * rs, bf_hi(w0.z) * rs); w.w = cvt_pk_bf16(bf_lo(w0.w) * rs, bf_hi(w0.w) * rs); *p = w; }
    }
    __syncthreads();
}

constexpr int N_PHASES = 12;
__global__ void __launch_bounds__(NTHREADS, 2) mk_fwd(const float* p0, const float* p1, const float* p2, const float* p3, const float* p4, const float* p5, const float* p6, const float* p7, const float* p8, const float* p9, const float* p10, const float* p11, const float* p12, const float* p13, const float* p14, const float* p15, const float* p16, const float* p17, const float* p18, const float* p19, const float* p20, const float* p21, const float* p22, const float* p23, const float* p24, const float* p25, float* out_p, unsigned char* ws_p, int ph_lo, int ph_hi) {
    extern __shared__ __attribute__((aligned(16))) unsigned char lds_raw[];
    Ctx C; C.in[0] = p0; C.in[1] = p1; C.in[2] = p2; C.in[3] = p3; C.in[4] = p4; C.in[5] = p5; C.in[6] = p6; C.in[7] = p7; C.in[8] = p8; C.in[9] = p9; C.in[10] = p10; C.in[11] = p11; C.in[12] = p12; C.in[13] = p13; C.in[14] = p14; C.in[15] = p15; C.in[16] = p16; C.in[17] = p17; C.in[18] = p18; C.in[19] = p19; C.in[20] = p20; C.in[21] = p21; C.in[22] = p22; C.in[23] = p23; C.in[24] = p24; C.in[25] = p25; C.out = out_p; C.ws = ws_p; C.lds = (LAS unsigned char*)lds_raw;
    C.tid = threadIdx.x; C.lane = C.tid & 63; C.wave = __builtin_amdgcn_readfirstlane(C.tid >> 6); C.G = gridDim.x; C.bx = blockIdx.x;
    const int lo = ph_lo, hi = ph_hi;
#define IN(k) (lo <= (k) && (k) < hi)
#define SEAM(k) do { if (IN(k) && IN((k) + 1)) { xcd_barrier(xbar); } } while (0)
    volatile LAS unsigned* xst = (volatile LAS unsigned*)(C.lds + LDS_BYTES - 16);
    if (C.tid == 0) { xst[0] = 0u; xst[1] = 0u; }
    __syncthreads();
    const XcdBarrier xbar = xcd_barrier_post(WSP(unsigned, WS_BAR), xst);
    float* ssq = WSP(float, WS_SSQ); LAS float* red = (LAS float*)(C.lds + RED_OFF);
    if (IN(0)) { phase_prep0(C); __syncthreads(); }
    SEAM(0);
    if (IN(1)) {
        phase_prep1(C);
        pg8::Gemm g{WSP(bf16_t, WS_XB), WSP(bf16_t, WS_WGU1), DM, DM, DM}; pg8::StaticOrder S; S.init(M_TOK, 2 * DFF, C.G, C.bx);
        EpiGateUp E{ssq, WSP(bf16_t, WS_ACT)}; pg8::gemm_phase<EpiGateUp, pg8::StaticOrder, true>(C.lds, g, S, E);
    }
    SEAM(1);
    if (IN(2)) {
        pg8::Gemm g{WSP(bf16_t, WS_ACT), WSP(bf16_t, WS_WD1), DFF, DFF, DFF}; pg8::StaticOrder S; S.init(M_TOK, DM, C.G, C.bx);
        EpiResid E{WSP(bf16_t, WS_XB), ssq + SSQ_STRIDE, 0.5f, nullptr, red}; pg8::gemm_phase<EpiResid, pg8::StaticOrder, true>(C.lds, g, S, E);
    }
    SEAM(2);
    if (IN(3)) {
        pg8::Gemm g{WSP(bf16_t, WS_XB), WSP(bf16_t, WS_WIN), DM, DM, DM}; pg8::StaticOrder S; S.init(M_TOK, DIN, C.G, C.bx);
        EpiWin E{ssq + SSQ_STRIDE, WSP(bf16_t, WS_APP), WSP(bf16_t, WS_QKV), WSP(float, WS_ROPE), WSP(float, WS_ROPE) + SEQ * 8}; pg8::gemm_phase<EpiWin, pg8::StaticOrder, true>(C.lds, g, S, E);
        if (C.G <= 128) phase_prep2(C, C.bx * NTHREADS + C.tid, C.G * NTHREADS);
        else if (C.bx >= 128) phase_prep2(C, (C.bx - 128) * NTHREADS + C.tid, (C.G - 128) * NTHREADS);
    }
    SEAM(3);
    if (IN(4)) {
        { const int it = ((C.bx & 7) << 5) | ((C.bx >> 3) & 31);
            const int pm = it >> 1, g = pm >> 2;
            __syncthreads();
            { pg8::Gemm g1{WSP(bf16_t, WS_APP), WSP(bf16_t, WS_BTS1), KY, K1, K1}; pg8::OneUnit S{pm, g}; EpiS1 E{WSP(float, WS_SLOC)}; pg8::gemm_phase<EpiS1, pg8::OneUnit, true, true>(C.lds, g1, S, E); }
            asm volatile("s_waitcnt vmcnt(0)" ::: "memory"); __syncthreads();
            if (C.wave < 2) carry_task(C, 2 * (pm & 3) + C.wave, g);
            if (C.wave >= 2) {
#pragma unroll 1
                for (int j = C.wave - 2; j < 18; j += 6) weights_late_item(C, it * 19 + j);
            } else if (C.wave == 0) weights_late_item(C, it * 19 + 18);
            asm volatile("s_waitcnt vmcnt(0)" ::: "memory"); __syncthreads();
            { pg8::Gemm gy{WSP(bf16_t, WS_APP), WSP(bf16_t, WS_BTY), KY, KY, KY}; pg8::OneUnit S{pm, 2 * g + (it & 1)}; EpiY E{WSP(bf16_t, WS_APP), C.inp(14), WSP(bf16_t, WS_YGELU)}; pg8::gemm_phase<EpiY, pg8::OneUnit, true>(C.lds, gy, S, E); }
        }
    }
    SEAM(4);
    if (IN(7)) {
        pg8::Gemm g{WSP(bf16_t, WS_YGELU), WSP(bf16_t, WS_WGLU), DSSM, DSSM, DSSM}; pg8::StaticOrder S; S.init(M_TOK, DSSM, C.G, C.bx);
        EpiGlu E{WSP(bf16_t, WS_YGELU), C.inp(16), WSP(bf16_t, WS_YCAT), ssq + 2 * SSQ_STRIDE, red, (unsigned*)(ssq + 5 * SSQ_STRIDE) + 128 * 64}; pg8::gemm_phase<EpiGlu, pg8::StaticOrder, true>(C.lds, g, S, E);
        phase_attn(C);
    }
    SEAM(8);
    if (IN(9)) {
        pg8::Gemm g{WSP(bf16_t, WS_YCAT), WSP(bf16_t, WS_WOUT), DM, DM, DM}; pg8::StaticOrder S; S.init(M_TOK, DM, C.G, C.bx);
        EpiResid E{WSP(bf16_t, WS_XB), ssq + 3 * SSQ_STRIDE, 1.0f, ssq + 2 * SSQ_STRIDE, red}; pg8::gemm_phase<EpiResid, pg8::StaticOrder, true>(C.lds, g, S, E);
    }
    SEAM(9);
    if (IN(10)) {
        pg8::Gemm g{WSP(bf16_t, WS_XB), WSP(bf16_t, WS_WGU2), DM, DM, DM}; pg8::StaticOrder S; S.init(M_TOK, 2 * DFF, C.G, C.bx);
        EpiGateUp E{ssq + 3 * SSQ_STRIDE, WSP(bf16_t, WS_ACT)}; pg8::gemm_phase<EpiGateUp, pg8::StaticOrder, true>(C.lds, g, S, E);
    }
    SEAM(10);
    if (IN(11)) {
        pg8::Gemm g{WSP(bf16_t, WS_ACT), WSP(bf16_t, WS_WD2), DFF, DFF, DFF}; pg8::StaticOrder S; S.init(M_TOK, DM, C.G, C.bx);
        EpiFinal E{WSP(bf16_t, WS_XB), ssq + 4 * SSQ_STRIDE, (unsigned*)(ssq + 5 * SSQ_STRIDE), C.inp(25), C.out, red}; pg8::gemm_phase<EpiFinal, pg8::StaticOrder, true>(C.lds, g, S, E);
    }
#undef IN
#undef SEAM
}

extern "C" void kernel_launch(void* const* d_in, const int* in_sizes, int n_in, void* d_out, int out_size, void* d_ws, size_t ws_size, hipStream_t stream) {
    static int grid = 0;
    if (grid == 0) {
        if (n_in != 26 || out_size != M_TOK * DM || ws_size < WS_END) { fprintf(stderr, "kernel_launch: unexpected shapes (n_in %d out %d ws %zu)\n", n_in, out_size, ws_size); grid = -1; return; }
        int dev = 0, cus = 0, per_cu = 0;
        hipGetDevice(&dev); hipDeviceGetAttribute(&cus, hipDeviceAttributeMultiprocessorCount, dev);
        if (hipFuncSetAttribute((const void*)mk_fwd, hipFuncAttributeMaxDynamicSharedMemorySize, LDS_BYTES) != hipSuccess) { fprintf(stderr, "kernel_launch: hipFuncSetAttribute failed\n"); grid = -1; return; }
        hipOccupancyMaxActiveBlocksPerMultiprocessor(&per_cu, (const void*)mk_fwd, NTHREADS, LDS_BYTES);
        if (per_cu < 1) { fprintf(stderr, "kernel_launch: occupancy query says %d blocks/CU\n", per_cu); per_cu = 1; }
        (void)hipGetLastError();
        grid = cus;
    }
    if (grid < 0) return;
    const float* ip[26]; for (int i = 0; i < 26; ++i) ip[i] = (const float*)d_in[i];
    float* outp = (float*)d_out; unsigned char* wsp = (unsigned char*)d_ws; int lo = 0, hi = N_PHASES;
    (void)hipMemsetAsync((unsigned char*)d_ws + WS_BAR, 0, XCD_BAR_WORDS * sizeof(unsigned), stream);
    void* kargs[30]; for (int i = 0; i < 26; ++i) kargs[i] = (void*)&ip[i];
    kargs[26] = (void*)&outp; kargs[27] = (void*)&wsp; kargs[28] = (void*)&lo; kargs[29] = (void*)&hi;
    hipError_t e = hipLaunchCooperativeKernel((const void*)mk_fwd, dim3(grid), dim3(NTHREADS), kargs, LDS_BYTES, stream);
    if (e != hipSuccess) fprintf(stderr, "kernel_launch: cooperative launch failed: %s (grid %d)\n", hipGetErrorString(e), grid);
}
```

```cpp
#include <hip/hip_runtime.h>
#include <hip/hip_cooperative_groups.h>
#include <cstdio>
#include <cstdint>
namespace cg = cooperative_groups;

#define LAS __attribute__((address_space(3)))
#define GAS __attribute__((address_space(1)))
typedef unsigned short bf16_t;
typedef short bf16x8 __attribute__((ext_vector_type(8)));
typedef float f32x4 __attribute__((ext_vector_type(4)));
typedef float f32x2 __attribute__((ext_vector_type(2)));
typedef unsigned u32x4 __attribute__((ext_vector_type(4)));
typedef unsigned u32x2 __attribute__((ext_vector_type(2)));

constexpr int BATCH = 8, SEQ = 4096, M_TOK = BATCH * SEQ, DM = 1024, DFF = 2816, DIN = 1280, DSSM = 512;
constexpr int NG = 32, NP = 64, NCH = 16;
constexpr int TCH = 32, NCK = SEQ / TCH, NBN = BATCH * NCK;
constexpr int K1 = TCH * NCH;
constexpr int KY = K1 + 2 * NP;
constexpr int PWN = TCH + 1;
constexpr float EPS = 1e-6f;
constexpr int NTHREADS = 512, NWAVES = 8;
constexpr int LDS_BYTES = 147456;
constexpr int RED_OFF = 131072;
constexpr size_t SSQ_STRIDE = 4 * (size_t)32768;

constexpr size_t MiB = 1024 * 1024;
constexpr size_t WS_XB = 0;
constexpr size_t WS_ACT = 64 * MiB;
constexpr size_t WS_APP = WS_ACT;
constexpr size_t WS_QKV = WS_ACT + 40 * MiB;
constexpr size_t WS_YGELU = WS_ACT + 88 * MiB;
constexpr size_t WS_SLOC = WS_ACT + 120 * MiB;
constexpr size_t WS_YCAT = 240 * MiB;
constexpr size_t WS_WGU1 = 304 * MiB, WS_WD1 = 315 * MiB, WS_WGU2 = 321 * MiB, WS_WD2 = 332 * MiB;
constexpr size_t WS_WIN = 338 * MiB, WS_WOUT = 341 * MiB, WS_WGLU = 343 * MiB;
constexpr size_t WS_BTY = 344 * MiB;
constexpr size_t WS_BTS1 = 364 * MiB;
constexpr size_t WS_PW = 372 * MiB;
constexpr size_t WS_BBAR = 373 * MiB;
constexpr size_t WS_KTAB = 374 * MiB;
constexpr size_t WS_SSQ = 380 * MiB;
constexpr size_t WS_ROPE = 377 * MiB;
constexpr size_t WS_BAR = 378 * MiB;
constexpr size_t WS_END = 384 * MiB;


typedef __bf16 bf16x2_t __attribute__((ext_vector_type(2)));
__device__ __forceinline__ unsigned cvt_pk_bf16(float lo, float hi) { const f32x2 v = {lo, hi}; return __builtin_bit_cast(unsigned, __builtin_convertvector(v, bf16x2_t)); }
__device__ __forceinline__ float bf_lo(unsigned w) { return __uint_as_float(w << 16); }
__device__ __forceinline__ float bf_hi(unsigned w) { return __uint_as_float(w & 0xffff0000u); }
__device__ __forceinline__ float bf2f(bf16_t b) { return __uint_as_float(((unsigned)b) << 16); }
__device__ __forceinline__ bf16_t f2bf(float f) { return (bf16_t)(cvt_pk_bf16(f, 0.f) & 0xffffu); }
__device__ __forceinline__ float gelu_tanh(float v) { const float z = -2.3022081198f * (v + 0.044715f * v * v * v); return v * __builtin_amdgcn_rcpf(1.0f + __builtin_amdgcn_exp2f(z)); }
__device__ __forceinline__ float sigmoidf_(float v) { return __builtin_amdgcn_rcpf(1.0f + __builtin_amdgcn_exp2f(-1.4426950409f * v)); }
__device__ __forceinline__ f32x4 bf4_lo(const u32x4 x) { return (f32x4){bf_lo(x.x), bf_hi(x.x), bf_lo(x.y), bf_hi(x.y)}; }
__device__ __forceinline__ f32x4 bf4_hi(const u32x4 x) { return (f32x4){bf_lo(x.z), bf_hi(x.z), bf_lo(x.w), bf_hi(x.w)}; }
__device__ __forceinline__ f32x4 exp2_v(const f32x4 t) { return (f32x4){__builtin_amdgcn_exp2f(t[0]), __builtin_amdgcn_exp2f(t[1]), __builtin_amdgcn_exp2f(t[2]), __builtin_amdgcn_exp2f(t[3])}; }
__device__ __forceinline__ f32x4 rcp_v(const f32x4 t) { return (f32x4){__builtin_amdgcn_rcpf(t[0]), __builtin_amdgcn_rcpf(t[1]), __builtin_amdgcn_rcpf(t[2]), __builtin_amdgcn_rcpf(t[3])}; }
__device__ __forceinline__ f32x4 sigmoid_v(const f32x4 a) { return rcp_v(exp2_v(a * -1.4426950409f) + 1.0f); }
__device__ __forceinline__ f32x4 gelu_tanh_v(const f32x4 v) { const f32x4 z = v * ((v * v) * -0.1029432397f + -2.3022081198f); return v * rcp_v(exp2_v(z) + 1.0f); }
__device__ __forceinline__ u32x4 pack8(const f32x4 a, const f32x4 b) { u32x4 w; w.x = cvt_pk_bf16(a[0], a[1]); w.y = cvt_pk_bf16(a[2], a[3]); w.z = cvt_pk_bf16(b[0], b[1]); w.w = cvt_pk_bf16(b[2], b[3]); return w; }
__device__ __forceinline__ float rs_from_ssq(float ssq, float inv_n) { return __builtin_amdgcn_rsqf(ssq * inv_n + EPS); }

namespace pg8 {
constexpr int BM = 256, BK = 64, HALF = 128, HTB = HALF * BK * 2, STAGE_BYTES = 8 * HTB, NXCD = 8, WGM = 8;
__host__ __device__ __forceinline__ int lds_byte(int r, int c) { const int st = (r >> 4) * 2 + (c >> 5), rr = r & 15, cc = c & 31, ob = rr * 64 + cc * 2; return st * 1024 + (ob ^ (((ob >> 9) & 1) << 5)); }
__host__ __device__ __forceinline__ int perm32(int rho) { const int n = rho >> 4, i = rho & 15; return 8 * (i >> 2) + 4 * n + (i & 3); }
__host__ __device__ __forceinline__ void stage_rc(int b, int& R, int& C) { const int st = b / 1024, sb = b % 1024, swz = sb ^ (((sb >> 9) & 1) << 5); R = (st >> 1) * 16 + swz / 64; C = (st & 1) * 32 + (swz % 64) / 2; }

struct Unit { int pm, pn, ka, kb, part; };
struct Gemm { const bf16_t* A; const bf16_t* Bt; int lda, ldb, K; };

struct StaticOrder {
    int nM, nN, nwg, G, c;
    __device__ void init(int M, int N, int G_, int c_) { nM = M / BM; nN = N / BM; nwg = nM * nN; G = G_; c = c_; }
    __device__ bool next(int i, Unit& u) const {
        const long L = (long)i * G + c; if (L >= nwg) return false;
        int wgid = (int)L; { const int q = nwg / NXCD, r = nwg % NXCD, xcd = wgid % NXCD, off = wgid / NXCD; wgid = (xcd < r ? xcd * (q + 1) : r * (q + 1) + (xcd - r) * q) + off; }
        const int nig = WGM * nN, gid = wgid / nig, fm = gid * WGM, gsz = (nM - fm) < WGM ? (nM - fm) : WGM;
        u.pm = fm + ((wgid % nig) % gsz); u.pn = (wgid % nig) / gsz; u.ka = 0; u.kb = 0; u.part = 0; return true;
    }
};
struct OneUnit { int pm, pn;
    __device__ bool next(int i, Unit& u) const { if (i) return false; u.pm = pm; u.pn = pn; u.ka = 0; u.kb = 0; u.part = 0; return true; } };
struct SplitOrder { StaticOrder so;
    __device__ bool next(int i, Unit& u) const { if (!so.next(i >> 1, u)) return false; u.ka = u.kb = (i & 1) * 512; u.part = (i & 1) ? 0 : 1; return true; } };

template <class Epi, class Sched, bool PERM = false, bool HALF_N = false>
__device__ __forceinline__ void gemm_phase(LAS unsigned char* lds, const Gemm g, const Sched& S, const Epi& E) {
    const int tid = threadIdx.x, wid = __builtin_amdgcn_readfirstlane(tid >> 6), lane = tid & 63, wr = wid >> 2, wc = wid & 3, fr = lane & 15, fq = lane >> 4;
    const int nt = g.K / BK;
    unsigned voffA[2], voffB[2];
#pragma unroll
    for (int i = 0; i < 2; ++i) { int R, C; stage_rc(tid * 16 + i * 8192, R, C); const int Rb = PERM ? ((R & ~31) + perm32(R & 31)) : R; voffA[i] = (unsigned)(R * g.lda + C) * 2u; voffB[i] = (unsigned)(Rb * g.ldb + C) * 2u; }
    const size_t kstep = (size_t)(BK * 2);
    const size_t hA = (size_t)HALF * g.lda * 2, hB = (size_t)HALF * g.ldb * 2, tA = 2 * hA, tB = 2 * hB;
    const unsigned ldsw = (unsigned)wid * 1024u;
    const int aoff = lds_byte(wr * 64 + fr, fq * 8), boff = lds_byte(wc * 32 + fr, fq * 8);
#define PG8_SA(b, h) (((b) * 2 + (h)) * HTB)
#define PG8_SB(b, h) ((4 + (b) * 2 + (h)) * HTB)
#define PG8_STAGE(bufoff, gbase, voff) do { _Pragma("unroll") for (int _i = 0; _i < 2; ++_i) \
        __builtin_amdgcn_global_load_lds((const unsigned*)((const char*)(gbase) + (voff)[_i]), (LAS unsigned*)(lds + (bufoff) + ldsw + _i * 8192), 16, 0, 0); } while (0)
#define PG8_LDA(dst, b, h) do { _Pragma("unroll") for (int m = 0; m < 4; ++m) _Pragma("unroll") for (int k = 0; k < 2; ++k) dst[m][k] = *(const LAS bf16x8*)(lds + PG8_SA(b, h) + aoff + m * 2048 + k * 1024); } while (0)
#define PG8_LDB(dst, b, h) do { _Pragma("unroll") for (int n = 0; n < 2; ++n) _Pragma("unroll") for (int k = 0; k < 2; ++k) dst[n][k] = *(const LAS bf16x8*)(lds + PG8_SB(b, h) + boff + n * 2048 + k * 1024); } while (0)
#define PG8_MMA(ai, bj, At, Bt) do { __builtin_amdgcn_s_setprio(1); _Pragma("unroll") for (int m = 0; m < 4; ++m) _Pragma("unroll") for (int n = 0; n < 2; ++n) _Pragma("unroll") for (int k = 0; k < 2; ++k) \
        acc[ai][bj][m][n] = __builtin_amdgcn_mfma_f32_16x16x32_bf16(Bt[n][k], At[m][k], acc[ai][bj][m][n], 0, 0, 0); __builtin_amdgcn_s_setprio(0); } while (0)
#define PG8_WAIT_V(n) asm volatile("s_waitcnt vmcnt(" #n ")" ::: "memory")
#define PG8_WAIT_L(n) asm volatile("s_waitcnt lgkmcnt(" #n ")" ::: "memory")
#define PG8_BAR __builtin_amdgcn_s_barrier()
#define PG8_SCHED __builtin_amdgcn_sched_barrier(0)
    Unit cur, nxt; int ui = 0;
    if (!S.next(0, cur)) return;
    f32x4 acc[2][2][4][2];
#pragma unroll
    for (int a = 0; a < 2; ++a)
#pragma unroll
        for (int b = 0; b < 2; ++b)
#pragma unroll
            for (int m = 0; m < 4; ++m)
#pragma unroll
                for (int n = 0; n < 2; ++n) acc[a][b][m][n] = (f32x4){0.f, 0.f, 0.f, 0.f};
    bf16x8 At[4][2], B0[2][2], B1[2][2];
    const char* cA = (const char*)g.A + (size_t)cur.pm * tA + (size_t)cur.ka * 2; const char* cB = (const char*)g.Bt + (size_t)cur.pn * tB + (size_t)cur.kb * 2;
    PG8_STAGE(PG8_SB(0, 0), cB, voffB); PG8_STAGE(PG8_SB(0, 1), cB + hB, voffB); PG8_STAGE(PG8_SA(0, 0), cA, voffA); PG8_STAGE(PG8_SA(0, 1), cA + hA, voffA);
    if (wr == 1) PG8_BAR;
    PG8_WAIT_V(2); PG8_BAR;
    PG8_STAGE(PG8_SB(1, 0), cB + kstep, voffB); PG8_STAGE(PG8_SA(1, 0), cA + kstep, voffA); PG8_STAGE(PG8_SB(1, 1), cB + hB + kstep, voffB);
    PG8_WAIT_V(6); PG8_BAR;
    for (;;) {
        const bool has_next = S.next(ui + 1, nxt);
        const char* nA = has_next ? (const char*)g.A + (size_t)nxt.pm * tA + (size_t)nxt.ka * 2 : cA; const char* nB = has_next ? (const char*)g.Bt + (size_t)nxt.pn * tB + (size_t)nxt.kb * 2 : cB;
        for (int t = 0; t < nt; t += 2) {
            const bool last = (t == nt - 2);
            const char* a1 = cA + (size_t)(t + 1) * kstep;
            const char* a2 = last ? nA : cA + (size_t)(t + 2) * kstep; const char* b2 = last ? nB : cB + (size_t)(t + 2) * kstep;
            const char* a3 = a2 + kstep; const char* b3 = b2 + kstep;
            PG8_LDB(B0, 0, 0); if constexpr (!HALF_N) PG8_LDB(B1, 0, 1); PG8_SCHED; PG8_LDA(At, 0, 0); PG8_STAGE(PG8_SA(1, 1), a1 + hA, voffA);
            PG8_WAIT_V(8); PG8_WAIT_L(0); PG8_BAR; PG8_MMA(0, 0, At, B0); if constexpr (!HALF_N) PG8_MMA(0, 1, At, B1); PG8_BAR; PG8_SCHED;
            PG8_LDA(At, 0, 1); PG8_STAGE(PG8_SB(0, 0), b2, voffB); PG8_STAGE(PG8_SB(0, 1), b2 + hB, voffB); PG8_STAGE(PG8_SA(0, 0), a2, voffA);
            PG8_WAIT_V(8); PG8_WAIT_L(0); PG8_BAR; PG8_MMA(1, 0, At, B0); if constexpr (!HALF_N) PG8_MMA(1, 1, At, B1); PG8_BAR; PG8_SCHED;
            PG8_LDB(B0, 1, 0); if constexpr (!HALF_N) PG8_LDB(B1, 1, 1); PG8_SCHED; PG8_LDA(At, 1, 0); PG8_STAGE(PG8_SA(0, 1), a2 + hA, voffA);
            PG8_WAIT_V(8); PG8_WAIT_L(0); PG8_BAR; PG8_MMA(0, 0, At, B0); if constexpr (!HALF_N) PG8_MMA(0, 1, At, B1); PG8_BAR; PG8_SCHED;
            PG8_LDA(At, 1, 1); PG8_STAGE(PG8_SB(1, 0), b3, voffB); PG8_STAGE(PG8_SB(1, 1), b3 + hB, voffB); PG8_STAGE(PG8_SA(1, 0), a3, voffA);
            PG8_WAIT_V(8); PG8_WAIT_L(0); PG8_BAR; PG8_MMA(1, 0, At, B0); if constexpr (!HALF_N) PG8_MMA(1, 1, At, B1); PG8_BAR; PG8_SCHED;
        }
        if (wr == 0) PG8_BAR;
        if (cur.part) { E.mid(acc, cur, wr, wc, fr, fq); }
        else {
            E(acc, cur, wr, wc, fr, fq);
            if (has_next) {
#pragma unroll
                for (int a = 0; a < 2; ++a)
#pragma unroll
                    for (int b = 0; b < 2; ++b)
#pragma unroll
                        for (int m = 0; m < 4; ++m)
#pragma unroll
                            for (int n = 0; n < 2; ++n) acc[a][b][m][n] = (f32x4){0.f, 0.f, 0.f, 0.f};
            }
        }
        if (!has_next) break;
        cur = nxt; cA = nA; cB = nB; ++ui;
        if (wr == 1) PG8_BAR;
    }
    PG8_WAIT_V(0);
    PG8_BAR;
#undef PG8_SA
#undef PG8_SB
#undef PG8_STAGE
#undef PG8_LDA
#undef PG8_LDB
#undef PG8_MMA
#undef PG8_WAIT_V
#undef PG8_WAIT_L
#undef PG8_BAR
#undef PG8_SCHED
}
}
using pg8::Unit; using pg8::HALF; using pg8::BM;

typedef f32x4 AccT[2][2][4][2];

__device__ __forceinline__ void red_put(LAS float* red, int ai, int wr, int m, int fr, int wc, int fq, float s) { if (fq == 0) red[(ai * HALF + wr * 64 + m * 16 + fr) * 4 + wc] = s; }
template <bool WT>
__device__ __forceinline__ void red_flush(LAS float* red, float* part, const Unit& u) {
    asm volatile("s_waitcnt lgkmcnt(0)" ::: "memory"); __builtin_amdgcn_s_barrier(); asm volatile("" ::: "memory");
    const int t = threadIdx.x;
    if (t < 256) { const f32x4 v = *(const LAS f32x4*)(red + t * 4); const float sum = (v[0] + v[1]) + (v[2] + v[3]); float* p = part + (size_t)(u.pm * BM + t) * 4 + u.pn;
        if (WT) __hip_atomic_store(p, sum, __ATOMIC_RELAXED, __HIP_MEMORY_SCOPE_AGENT); else *p = sum; }
}
__device__ __forceinline__ float sum4(const f32x4 v) { return (v[0] + v[1]) + (v[2] + v[3]); }
struct EpiGateUp {
    const float* ssq; bf16_t* act;
    __device__ __forceinline__ void mid(AccT&, const Unit&, int, int, int, int) const {}
    __device__ __forceinline__ void operator()(const AccT& acc, const Unit& u, int wr, int wc, int fr, int fq) const {
        const int row0 = u.pm * BM + wr * 64 + fr, col0 = u.pn * 128 + wc * 32 + 8 * fq;
        float rsv[2][4];
#pragma unroll
        for (int ai = 0; ai < 2; ++ai)
#pragma unroll
            for (int m = 0; m < 4; ++m) rsv[ai][m] = sum4(*(const f32x4*)(ssq + (size_t)(row0 + ai * HALF + m * 16) * 4));
#pragma unroll
        for (int ai = 0; ai < 2; ++ai)
#pragma unroll
            for (int m = 0; m < 4; ++m) {
                const int row = row0 + ai * HALF + m * 16; const float rs = rs_from_ssq(rsv[ai][m], 1.0f / DM), rs2 = rs * rs, nl = -1.4426950409f * rs;
                f32x4 a[2];
#pragma unroll
                for (int n = 0; n < 2; ++n) { const f32x4 ga = acc[ai][0][m][n], ua = acc[ai][1][m][n]; const f32x4 pr = (ga * ua) * rs2, tt = ga * nl; f32x4 e;
#pragma unroll
                    for (int j = 0; j < 4; ++j) e[j] = __builtin_amdgcn_exp2f(tt[j]);
                    e = e + 1.0f; f32x4 r;
#pragma unroll
                    for (int j = 0; j < 4; ++j) r[j] = __builtin_amdgcn_rcpf(e[j]);
                    a[n] = pr * r; }
                u32x4 w; w.x = cvt_pk_bf16(a[0][0], a[0][1]); w.y = cvt_pk_bf16(a[0][2], a[0][3]); w.z = cvt_pk_bf16(a[1][0], a[1][1]); w.w = cvt_pk_bf16(a[1][2], a[1][3]);
                *(u32x4*)(act + (size_t)row * DFF + col0) = w;
            }
    }
};
struct EpiResid {
    bf16_t* xb; float* ssq_out; float scale; const float* ssq_row; LAS float* red;
    __device__ __forceinline__ void mid(AccT&, const Unit&, int, int, int, int) const {}
    __device__ __forceinline__ void operator()(const AccT& acc, const Unit& u, int wr, int wc, int fr, int fq) const {
        const int row0 = u.pm * BM + wr * 64 + fr, col0 = u.pn * BM + wc * 32 + 8 * fq;
        float scv[2][4];
#pragma unroll
        for (int ai = 0; ai < 2; ++ai)
#pragma unroll
            for (int m = 0; m < 4; ++m) { f32x2 t = (f32x2){0.f, 0.f}; if (ssq_row) t = *(const f32x2*)(ssq_row + (size_t)(row0 + ai * HALF + m * 16) * 4); scv[ai][m] = t[0] + t[1]; }
#pragma unroll
        for (int ai = 0; ai < 2; ++ai) {
            u32x4 xi[4][2];
#pragma unroll
            for (int m = 0; m < 4; ++m)
#pragma unroll
                for (int bj = 0; bj < 2; ++bj) xi[m][bj] = *(const u32x4*)(xb + (size_t)(row0 + ai * HALF + m * 16) * DM + col0 + bj * HALF);
#pragma unroll
            for (int m = 0; m < 4; ++m) {
                const int row = row0 + ai * HALF + m * 16; const size_t off = (size_t)row * DM + col0; float s = 0.f;
                const float sc = ssq_row ? scale * rs_from_ssq(scv[ai][m], 1.0f / DSSM) : scale;
#pragma unroll
                for (int bj = 0; bj < 2; ++bj) { const u32x4 x = xi[m][bj]; const f32x4 o0 = bf4_lo(x) + acc[ai][bj][m][0] * sc, o1 = bf4_hi(x) + acc[ai][bj][m][1] * sc;
                    const f32x4 q = o0 * o0 + o1 * o1; s += (q[0] + q[1]) + (q[2] + q[3]);
                    *(u32x4*)(xb + off + bj * HALF) = pack8(o0, o1); }
                s += __shfl_xor(s, 16); s += __shfl_xor(s, 32);
                red_put(red, ai, wr, m, fr, wc, fq, s);
            }
        }
        red_flush<false>(red, ssq_out, u);
    }
};
struct EpiFinal {
    const bf16_t* xb; float* ssq_out; unsigned* cnt; const float* gn; float* out; LAS float* red;
    __device__ __forceinline__ void mid(AccT&, const Unit&, int, int, int, int) const {}
    __device__ __forceinline__ void operator()(const AccT& acc, const Unit& u, int wr, int wc, int fr, int fq) const {
        const int row0 = u.pm * BM + wr * 64 + fr, col0 = u.pn * BM + wc * 32 + 8 * fq;
#pragma unroll
        for (int ai = 0; ai < 2; ++ai) {
            u32x4 xi[4][2];
#pragma unroll
            for (int m = 0; m < 4; ++m)
#pragma unroll
                for (int bj = 0; bj < 2; ++bj) xi[m][bj] = *(const u32x4*)(xb + (size_t)(row0 + ai * HALF + m * 16) * DM + col0 + bj * HALF);
#pragma unroll
            for (int m = 0; m < 4; ++m) { float s = 0.f;
#pragma unroll
                for (int bj = 0; bj < 2; ++bj) { const u32x4 x = xi[m][bj]; const f32x4 o0 = bf4_lo(x) + acc[ai][bj][m][0] * 0.5f, o1 = bf4_hi(x) + acc[ai][bj][m][1] * 0.5f;
                    const f32x4 q = o0 * o0 + o1 * o1; s += (q[0] + q[1]) + (q[2] + q[3]); }
                s += __shfl_xor(s, 16); s += __shfl_xor(s, 32);
                red_put(red, ai, wr, m, fr, wc, fq, s);
            }
        }
        red_flush<true>(red, ssq_out, u);
        asm volatile("s_waitcnt vmcnt(0)" ::: "memory");
        unsigned* cw = cnt + 64 * u.pm;
        if ((threadIdx.x & 63) == 0 && threadIdx.x < 256) __hip_atomic_fetch_add(cw, 1u, __ATOMIC_RELAXED, __HIP_MEMORY_SCOPE_AGENT);
        { unsigned sp = 0;
          while ((unsigned)__builtin_amdgcn_readfirstlane(__hip_atomic_load(cw, __ATOMIC_RELAXED, __HIP_MEMORY_SCOPE_AGENT)) < 16u) { __builtin_amdgcn_s_sleep(2); if (++sp > (1u << 20)) break; } }
        __builtin_amdgcn_fence(__ATOMIC_ACQUIRE, "agent");
        f32x4 gv[2][2];
#pragma unroll
        for (int bj = 0; bj < 2; ++bj)
#pragma unroll
            for (int n = 0; n < 2; ++n) gv[bj][n] = *(const f32x4*)(gn + col0 + bj * HALF + n * 4);
#pragma unroll
        for (int ai = 0; ai < 2; ++ai) {
            u32x4 xi[4][2]; float sq[4];
#pragma unroll
            for (int m = 0; m < 4; ++m) { const float* pp = ssq_out + (size_t)(row0 + ai * HALF + m * 16) * 4;
                sq[m] = (__hip_atomic_load(pp, __ATOMIC_RELAXED, __HIP_MEMORY_SCOPE_AGENT) + __hip_atomic_load(pp + 1, __ATOMIC_RELAXED, __HIP_MEMORY_SCOPE_AGENT)) + (__hip_atomic_load(pp + 2, __ATOMIC_RELAXED, __HIP_MEMORY_SCOPE_AGENT) + __hip_atomic_load(pp + 3, __ATOMIC_RELAXED, __HIP_MEMORY_SCOPE_AGENT));
#pragma unroll
                for (int bj = 0; bj < 2; ++bj) xi[m][bj] = *(const u32x4*)(xb + (size_t)(row0 + ai * HALF + m * 16) * DM + col0 + bj * HALF); }
#pragma unroll
            for (int m = 0; m < 4; ++m) { const float rs = rs_from_ssq(sq[m], 1.0f / DM); float* orow = out + (size_t)(row0 + ai * HALF + m * 16) * DM + col0;
#pragma unroll
                for (int bj = 0; bj < 2; ++bj) { const u32x4 x = xi[m][bj];
                    *(f32x4*)(orow + bj * HALF) = (bf4_lo(x) + acc[ai][bj][m][0] * 0.5f) * (gv[bj][0] * rs); *(f32x4*)(orow + bj * HALF + 4) = (bf4_hi(x) + acc[ai][bj][m][1] * 0.5f) * (gv[bj][1] * rs); }
            }
        }
    }
};
struct EpiWin {
    const float* ssq; bf16_t* app; bf16_t* qkv; const float* ropec; const float* ropes;
    __device__ __forceinline__ void mid(AccT&, const Unit&, int, int, int, int) const {}
    __device__ __forceinline__ void operator()(const AccT& acc, const Unit& u, int wr, int wc, int fr, int fq) const {
        const int row0 = u.pm * BM + wr * 64 + fr;
        const bool rope_w = (u.pn >= 2) && ((wc & 1) == 0);
        float rsv[2][4];
#pragma unroll
        for (int ai = 0; ai < 2; ++ai)
#pragma unroll
            for (int m = 0; m < 4; ++m) rsv[ai][m] = sum4(*(const f32x4*)(ssq + (size_t)(row0 + ai * HALF + m * 16) * 4));
#pragma unroll
        for (int ai = 0; ai < 2; ++ai)
#pragma unroll
            for (int mh = 0; mh < 2; ++mh) {
                f32x4 csv[2][2], snv[2][2];
                if (rope_w) {
#pragma unroll
                    for (int mm = 0; mm < 2; ++mm) { const int pos = (row0 + ai * HALF + (2 * mh + mm) * 16) & (SEQ - 1);
#pragma unroll
                        for (int n = 0; n < 2; ++n) { csv[mm][n] = *(const f32x4*)(ropec + pos * 8 + 4 * n); snv[mm][n] = *(const f32x4*)(ropes + pos * 8 + 4 * n); } }
                } else {
#pragma unroll
                    for (int mm = 0; mm < 2; ++mm)
#pragma unroll
                        for (int n = 0; n < 2; ++n) { csv[mm][n] = (f32x4){1.f, 1.f, 1.f, 1.f}; snv[mm][n] = (f32x4){0.f, 0.f, 0.f, 0.f}; }
                }
#pragma unroll
                for (int mm = 0; mm < 2; ++mm) {
                    const int m = 2 * mh + mm, row = row0 + ai * HALF + m * 16; const float rs = rs_from_ssq(rsv[ai][m], 1.0f / DM);
#pragma unroll
                    for (int bj = 0; bj < 2; ++bj) {
                        const int col = u.pn * BM + bj * HALF + wc * 32 + 8 * fq; f32x4 v0 = acc[ai][bj][m][0] * rs, v1 = acc[ai][bj][m][1] * rs;
                        bf16_t* p;
                        if (u.pn < 2) { const int g = col >> 4, c = col & 15; p = app + ((size_t)(g * NBN + (row >> 5)) * KY + (row & 31) * NCH + c); }
                        else {
                            const bool is_v = (u.pn == 4 && bj == 1);
                            if (!is_v && rope_w) {
                                f32x4 p0, p1;
#pragma unroll
                                for (int j = 0; j < 4; ++j) { p0[j] = __shfl_xor(v0[j], 16); p1[j] = __shfl_xor(v1[j], 16); }
                                if (fq == 0) { v0 = v0 * csv[mm][0] - p0 * snv[mm][0]; v1 = v1 * csv[mm][1] - p1 * snv[mm][1]; }
                                else if (fq == 1) { v0 = v0 * csv[mm][0] + p0 * snv[mm][0]; v1 = v1 * csv[mm][1] + p1 * snv[mm][1]; }
                            }
                            p = qkv + (size_t)row * 768 + (col - 512);
                        }
                        u32x4 w; w.x = cvt_pk_bf16(v0[0], v0[1]); w.y = cvt_pk_bf16(v0[2], v0[3]); w.z = cvt_pk_bf16(v1[0], v1[1]); w.w = cvt_pk_bf16(v1[2], v1[3]); *(u32x4*)p = w;
                    }
                }
            }
    }
};
struct EpiS1 {
    float* sloc;
    __device__ __forceinline__ void mid(AccT&, const Unit&, int, int, int, int) const {}
    __device__ __forceinline__ void operator()(const AccT& acc, const Unit& u, int wr, int wc, int fr, int fq) const {
        const int row0 = u.pm * BM + wr * 64 + fr, col0 = wc * 32 + 8 * fq;
#pragma unroll
        for (int ai = 0; ai < 2; ++ai)
#pragma unroll
            for (int m = 0; m < 4; ++m) { float* rowp = sloc + (size_t)(row0 + ai * HALF + m * 16) * 128 + col0;
#pragma unroll
                for (int n = 0; n < 2; ++n) *(f32x4*)(rowp + n * 4) = acc[ai][0][m][n]; }
    }
};
struct EpiY {
    const bf16_t* app; const float* Dv; bf16_t* ygelu;
    __device__ __forceinline__ void mid(AccT&, const Unit&, int, int, int, int) const {}
    __device__ __forceinline__ void operator()(const AccT& acc, const Unit& u, int wr, int wc, int fr, int fq) const {
        const int row0 = u.pm * BM + wr * 64 + fr, g = u.pm >> 2, colb = (u.pn & 1) * BM + wc * 32 + 8 * fq, c0 = 8 * (fq & 1);
        const f32x4 d0 = *(const f32x4*)(Dv + g * NCH + c0), d1 = *(const f32x4*)(Dv + g * NCH + c0 + 4);
#pragma unroll
        for (int ai = 0; ai < 2; ++ai) {
            u32x4 uw[4][2];
#pragma unroll
            for (int m = 0; m < 4; ++m)
#pragma unroll
                for (int bj = 0; bj < 2; ++bj) uw[m][bj] = *(const u32x4*)(app + (size_t)(row0 + ai * HALF + m * 16) * KY + colb + bj * HALF);
#pragma unroll
            for (int m = 0; m < 4; ++m) {
                const int row = row0 + ai * HALF + m * 16, nidx = row & (NBN - 1);
#pragma unroll
                for (int bj = 0; bj < 2; ++bj) {
                    const int colg = colb + bj * HALF, t = colg >> 4; const u32x4 w0 = uw[m][bj];
                    const f32x4 y0 = gelu_tanh_v(acc[ai][bj][m][0] + d0 * bf4_lo(w0)), y1 = gelu_tanh_v(acc[ai][bj][m][1] + d1 * bf4_hi(w0));
                    *(u32x4*)(ygelu + (size_t)(nidx * TCH + t) * DSSM + g * NCH + c0) = pack8(y0, y1);
                }
            }
        }
    }
};
struct EpiGlu {
    const bf16_t* ygelu; const float* bias; bf16_t* ycat; float* ssq_out; LAS float* red; unsigned* cnt;
    __device__ __forceinline__ void mid(AccT&, const Unit&, int, int, int, int) const {}
    __device__ __forceinline__ void operator()(const AccT& acc, const Unit& u, int wr, int wc, int fr, int fq) const {
        const int row0 = u.pm * BM + wr * 64 + fr, col0 = u.pn * BM + wc * 32 + 8 * fq;
        f32x4 bv[2][2];
#pragma unroll
        for (int bj = 0; bj < 2; ++bj)
#pragma unroll
            for (int n = 0; n < 2; ++n) bv[bj][n] = *(const f32x4*)(bias + col0 + bj * HALF + n * 4);
#pragma unroll
        for (int ai = 0; ai < 2; ++ai) {
            u32x4 yv[4][2];
#pragma unroll
            for (int m = 0; m < 4; ++m)
#pragma unroll
                for (int bj = 0; bj < 2; ++bj) yv[m][bj] = *(const u32x4*)(ygelu + (size_t)(row0 + ai * HALF + m * 16) * DSSM + col0 + bj * HALF);
#pragma unroll
            for (int m = 0; m < 4; ++m) {
                const int row = row0 + ai * HALF + m * 16; float s = 0.f;
#pragma unroll
                for (int bj = 0; bj < 2; ++bj) { const u32x4 yw = yv[m][bj];
                    const f32x4 z0 = bf4_lo(yw) * sigmoid_v(acc[ai][bj][m][0] + bv[bj][0]), z1 = bf4_hi(yw) * sigmoid_v(acc[ai][bj][m][1] + bv[bj][1]);
                    const f32x4 q = z0 * z0 + z1 * z1; s += (q[0] + q[1]) + (q[2] + q[3]);
                    *(u32x4*)(ycat + (size_t)row * DM + col0 + bj * HALF) = pack8(z0, z1); }
                s += __shfl_xor(s, 16); s += __shfl_xor(s, 32);
                red_put(red, ai, wr, m, fr, wc, fq, s);
            }
        }
        red_flush<true>(red, ssq_out, u);
        asm volatile("s_waitcnt vmcnt(0)" ::: "memory");
        if ((threadIdx.x & 63) == 0 && threadIdx.x < 256) __hip_atomic_fetch_add(cnt + 64 * u.pm, 1u, __ATOMIC_RELAXED, __HIP_MEMORY_SCOPE_AGENT);
    }
};

#define XB_TMO      128
#define XB_XCNT(j)  (256  + 64 * (j))
#define XB_XSUB(j)  (1280 + 64 * (j))
#define XB_XGEN(j)  (2304 + 64 * (j))
#define XB_TOP      3328
#define XB_TOPGEN   3392
#define XCD_BAR_WORDS 3456
#define XB_SPIN_CAP (1u << 18)
__device__ __forceinline__ unsigned xb_ld(unsigned* p)              { return __hip_atomic_load(p, __ATOMIC_RELAXED, __HIP_MEMORY_SCOPE_AGENT); }
__device__ __forceinline__ unsigned xb_add(unsigned* p, unsigned v) { return __hip_atomic_fetch_add(p, v, __ATOMIC_RELAXED, __HIP_MEMORY_SCOPE_AGENT); }
__device__ __forceinline__ unsigned xb_xcc_id() { return (unsigned)__builtin_amdgcn_s_getreg((3 << 11) | 20) & 0xFu; }
#define XB_SPIN(cond, bar) do { unsigned _sp = 0; while (cond) { __builtin_amdgcn_s_sleep(1); \
    if ((++_sp & 255u) == 0u) { if (xb_ld(&(bar)[XB_TMO])) break; if (_sp > XB_SPIN_CAP) { atomicAdd(&(bar)[XB_TMO], 1u); break; } } } } while (0)
struct XcdBarrier { unsigned* bar; unsigned x; volatile LAS unsigned* st; };
__device__ __forceinline__ XcdBarrier xcd_barrier_post(unsigned* bar, volatile LAS unsigned* st) {
    XcdBarrier b; b.bar = bar; b.x = xb_xcc_id(); b.st = st;
    if (threadIdx.x == 0) (void)xb_add(&bar[XB_XCNT(b.x)], 1u);
    return b;
}
__device__ __forceinline__ void xcd_barrier_complete(unsigned* bar, unsigned x, unsigned& nloc, unsigned& nx) {
    const unsigned G = gridDim.x * gridDim.y * gridDim.z;
    unsigned sum, cnt, mine, sp = 0u;
    for (;;) {
        sum = 0u; cnt = 0u; mine = 0u;
#pragma unroll
        for (unsigned j = 0; j < 16; ++j) { const unsigned c = xb_ld(&bar[XB_XCNT(j)]); sum += c; cnt += (c > 0u) ? 1u : 0u; mine = (j == x) ? c : mine; }
        if (sum == G) break;
        __builtin_amdgcn_s_sleep(1);
        if ((++sp & 255u) == 0u) { if (xb_ld(&bar[XB_TMO])) break; if (sp > XB_SPIN_CAP) { atomicAdd(&bar[XB_TMO], 1u); break; } }
    }
    nloc = mine > 0u ? mine : 1u; nx = cnt > 0u ? cnt : 1u;
}
__device__ __forceinline__ void xcd_barrier(const XcdBarrier& b) {
    asm volatile("s_waitcnt vmcnt(0)" ::: "memory");
    __syncthreads();
    if (threadIdx.x == 0) {
        unsigned* bar = b.bar;
        __builtin_amdgcn_s_waitcnt(0);
        unsigned nloc = b.st[0], nx = b.st[1];
        if (nloc == 0u) { xcd_barrier_complete(bar, b.x, nloc, nx); b.st[0] = nloc; b.st[1] = nx; }
        const unsigned old = xb_add(&bar[XB_XSUB(b.x)], 1u);
        const unsigned gen = old / nloc;
        if (old + 1u == (gen + 1u) * nloc) {
            __builtin_amdgcn_fence(__ATOMIC_RELEASE, "agent");
            asm volatile("s_waitcnt vmcnt(0)" ::: "memory");
            const unsigned og = xb_add(&bar[XB_TOP], 1u);
            const unsigned tg = og / nx;
            if (og + 1u == (tg + 1u) * nx) xb_add(&bar[XB_TOPGEN], 1u);
            else XB_SPIN(xb_ld(&bar[XB_TOPGEN]) == tg, bar);
            __builtin_amdgcn_fence(__ATOMIC_ACQUIRE, "agent");
            xb_add(&bar[XB_XGEN(b.x)], 1u);
            asm volatile("s_waitcnt vmcnt(0)" ::: "memory");
        } else {
            XB_SPIN(xb_ld(&bar[XB_XGEN(b.x)]) == gen, bar);
            __builtin_amdgcn_fence(__ATOMIC_ACQUIRE, "agent");
            asm volatile("s_waitcnt vmcnt(0)" ::: "memory");
        }
    }
    __syncthreads();
}

struct Ctx {
    const float* in[26]; float* out; unsigned char* ws; LAS unsigned char* lds; int tid, lane, wave, G, bx;
    __device__ __forceinline__ const float* inp(int i) const { return in[i]; }
};
#define WSP(T, off) ((T*)(C.ws + (off)))

__device__ __forceinline__ void transpose_item(const float* W, int K, int N, bf16_t* WT, const float* g0, const float* g1, int ksplit, int mode, LAS float* scr, int item, int lane) {
    const int nblk = N / 32, kb = item / nblk, nb = item % nblk, k0 = 64 * kb, n0 = 32 * nb;
#pragma unroll
    for (int i = 0; i < 8; ++i) { const int kk = 8 * i + (lane >> 3), k = k0 + kk, n4 = (lane & 7) * 4; const float gs = g0 ? (k < ksplit ? g0[k] : g1[k - ksplit]) : 1.0f;
        const f32x4 v = __builtin_nontemporal_load((const f32x4*)(W + (size_t)k * N + n0 + n4)); LAS float* d = scr + kk * 33 + n4; d[0] = v[0] * gs; d[1] = v[1] * gs; d[2] = v[2] * gs; d[3] = v[3] * gs; }
    asm volatile("s_waitcnt lgkmcnt(0)" ::: "memory");
    const int c = lane & 7;
#pragma unroll
    for (int j = 0; j < 4; ++j) { const int n = (lane >> 3) + 8 * j, ncol = n0 + n; const LAS float* s = scr + (8 * c) * 33 + n;
        const int drow = (mode == 0) ? ncol : (((ncol >> 7) << 8) + (ncol & 127) + (mode == 2 ? 128 : 0));
        u32x4 o; o.x = cvt_pk_bf16(s[0 * 33], s[1 * 33]); o.y = cvt_pk_bf16(s[2 * 33], s[3 * 33]); o.z = cvt_pk_bf16(s[4 * 33], s[5 * 33]); o.w = cvt_pk_bf16(s[6 * 33], s[7 * 33]);
        *(u32x4*)(WT + (size_t)drow * K + k0 + 8 * c) = o; }
    asm volatile("s_waitcnt lgkmcnt(0)" ::: "memory");
}

__device__ __forceinline__ float wave_sum(float v) {
#pragma unroll
    for (int o = 1; o < 64; o <<= 1) v += __shfl_xor(v, o);
    return v;
}

__device__ __forceinline__ void phase_prep0(const Ctx& C) {
    const int gw = C.wave * C.G + C.bx, NGW = C.G * NWAVES;
    const int gt = C.bx * NTHREADS + C.tid, NGT = C.G * NTHREADS;
    float* ssq = WSP(float, WS_SSQ);
    {
        const float* x = C.inp(0); bf16_t* xb = WSP(bf16_t, WS_XB);
        for (int row = gw; row < M_TOK; row += NGW) {
            const f32x4* xr = (const f32x4*)(x + (size_t)row * DM) + C.lane; f32x4 v[4]; float s = 0.f;
#pragma unroll
            for (int j = 0; j < 4; ++j) { v[j] = __builtin_nontemporal_load(xr + 64 * j); s += (v[j][0] * v[j][0] + v[j][1] * v[j][1]) + (v[j][2] * v[j][2] + v[j][3] * v[j][3]); }
            s = wave_sum(s);
            u32x2* o8 = (u32x2*)(xb + (size_t)row * DM) + C.lane;
#pragma unroll
            for (int j = 0; j < 4; ++j) { u32x2 w; w.x = cvt_pk_bf16(v[j][0], v[j][1]); w.y = cvt_pk_bf16(v[j][2], v[j][3]); o8[64 * j] = w; }
            if (C.lane == 0) *(f32x4*)(ssq + (size_t)row * 4) = (f32x4){s, 0.f, 0.f, 0.f};
        }
    }
    for (int i = gt; i < 2 * 128 * 64; i += NGT) ssq[5 * SSQ_STRIDE + i] = 0.f;
    {
        LAS float* scr = (LAS float*)(C.lds + C.wave * 16384);
        constexpr int I_GU = (DM / 64) * (DFF / 32), I_DN = (DFF / 64) * (DM / 32), I_IN = (DM / 64) * (DIN / 32), I_OUT = (DM / 64) * (DM / 32), I_GLU = (DSSM / 64) * (DSSM / 32);
        constexpr int NITEMS = 2 * I_GU + I_DN + I_IN;
        for (int it = gw; it < NITEMS; it += NGW) {
            int r = it;
            if (r < I_GU) { transpose_item(C.inp(2), DM, DFF, WSP(bf16_t, WS_WGU1), C.inp(1), C.inp(1), DM, 1, scr, r, C.lane); continue; } r -= I_GU;
            if (r < I_GU) { transpose_item(C.inp(3), DM, DFF, WSP(bf16_t, WS_WGU1), C.inp(1), C.inp(1), DM, 2, scr, r, C.lane); continue; } r -= I_GU;
            if (r < I_DN) { transpose_item(C.inp(4), DFF, DM, WSP(bf16_t, WS_WD1), nullptr, nullptr, 0, 0, scr, r, C.lane); continue; } r -= I_DN;
            transpose_item(C.inp(6), DM, DIN, WSP(bf16_t, WS_WIN), C.inp(5), C.inp(5), DM, 0, scr, r, C.lane);
        }
    }
    {
        float* rc = WSP(float, WS_ROPE); float* rsn = rc + SEQ * 8;
        for (int i = gt; i < SEQ * 8; i += NGT) {
            const int pos = i >> 3, k = i & 7;
            const double f = (k == 0) ? 1.0 : (k == 1) ? 0.19392274474868576 : (k == 2) ? 0.03760603093086393 : (k == 3) ? 0.007292664737217109 : (k == 4) ? 0.001414213562373095 : (k == 5) ? 0.0002742481756762073 : (k == 6) ? 5.318295896944988e-05 : 1.031338537721246e-05;
            const double xx = (double)pos * f; const double kk = __builtin_rint(xx * 0.15915494309189535); const float r = (float)(xx - kk * 6.283185307179586);
            rc[i] = cosf(r); rsn[i] = sinf(r);
        }
    }
    {
        f32x2* pw = WSP(f32x2, WS_PW); f32x2* bbar = WSP(f32x2, WS_BBAR);
        for (int i = gt; i < NG * NP * PWN; i += NGT) {
            const int gp = i / PWN, d = i - gp * PWN, g = gp >> 6; const float are = C.inp(7)[gp], aim = C.inp(8)[gp], dt = expf(C.inp(9)[g]);
            const double xx = (double)aim * (double)dt * (double)d; const double kk = __builtin_rint(xx * 0.15915494309189535); const float r = (float)(xx - kk * 6.283185307179586);
            const float mag = expf(are * dt * (float)d); pw[i] = (f32x2){mag * cosf(r), mag * sinf(r)};
        }
        for (int i = gt; i < NG * NP * NCH; i += NGT) {
            const int gp = i >> 4, g = gp >> 6; const float are = C.inp(7)[gp], aim = C.inp(8)[gp], dt = expf(C.inp(9)[g]);
            const double xx = (double)aim * (double)dt; const double kk = __builtin_rint(xx * 0.15915494309189535); const float r = (float)(xx - kk * 6.283185307179586);
            const float mag = expf(are * dt), l1r = mag * cosf(r), l1i = mag * sinf(r);
            const float nr = l1r - 1.0f, ni = l1i, den = 1.0f / (are * are + aim * aim); const float zr = (nr * are + ni * aim) * den, zi = (ni * are - nr * aim) * den;
            const float br = C.inp(10)[i], bi = C.inp(11)[i]; bbar[i] = (f32x2){zr * br - zi * bi, zr * bi + zi * br};
        }
    }
}
__device__ __forceinline__ void weights_late_item(const Ctx& C, int it) {
    LAS float* scr = (LAS float*)(C.lds + C.wave * 16384);
    constexpr int I_GU = (DM / 64) * (DFF / 32), I_DN = (DFF / 64) * (DM / 32), I_OUT = (DM / 64) * (DM / 32), I_GLU = (DSSM / 64) * (DSSM / 32);
    static_assert(2 * I_GU + I_DN + I_OUT + I_GLU == 256 * 19, "late weight items: 19 per workgroup");
    int r = it;
    if (r < I_GU) { transpose_item(C.inp(22), DM, DFF, WSP(bf16_t, WS_WGU2), C.inp(21), C.inp(21), DM, 1, scr, r, C.lane); return; } r -= I_GU;
    if (r < I_GU) { transpose_item(C.inp(23), DM, DFF, WSP(bf16_t, WS_WGU2), C.inp(21), C.inp(21), DM, 2, scr, r, C.lane); return; } r -= I_GU;
    if (r < I_DN) { transpose_item(C.inp(24), DFF, DM, WSP(bf16_t, WS_WD2), nullptr, nullptr, 0, 0, scr, r, C.lane); return; } r -= I_DN;
    if (r < I_OUT) { transpose_item(C.inp(20), DM, DM, WSP(bf16_t, WS_WOUT), C.inp(18), C.inp(19), DSSM, 0, scr, r, C.lane); return; } r -= I_OUT;
    transpose_item(C.inp(15), DSSM, DSSM, WSP(bf16_t, WS_WGLU), nullptr, nullptr, 0, 0, scr, r, C.lane);
}
__device__ __forceinline__ void phase_prep1(const Ctx& C) {
    LAS float* L = (LAS float*)C.lds;
    LAS float* Cr = L; LAS float* Ci = L + 1024; LAS f32x2* Bb = (LAS f32x2*)(L + 2048); LAS f32x2* Pw = (LAS f32x2*)(L + 4096);
    const f32x2* pw = WSP(f32x2, WS_PW); const f32x2* bbar = WSP(f32x2, WS_BBAR); float* ktab = WSP(float, WS_KTAB);
    constexpr int per = 4;
    const int base = (C.bx & 255) * per, g = base >> 5, d0 = base & 31;
    __syncthreads();
    for (int i = C.tid; i < 1024; i += NTHREADS) { Cr[i] = C.inp(12)[g * 1024 + i]; Ci[i] = C.inp(13)[g * 1024 + i]; Bb[i] = bbar[g * 1024 + i]; }
    for (int i = C.tid; i < per * 64; i += NTHREADS) { const int k = i >> 6, p = i & 63; Pw[i] = pw[(size_t)(g * 64 + p) * PWN + d0 + k]; }
    __syncthreads();
    const int half = C.tid >> 8, t = C.tid & 255, cp = t >> 4, c = t & 15;
#pragma unroll 1
    for (int k = half; k < per; k += 2) {
        float s = 0.f;
#pragma unroll 4
        for (int p = 0; p < NP; ++p) { const float cr = Cr[cp * 64 + p], ci = Ci[cp * 64 + p]; const f32x2 w = Pw[k * 64 + p], b = Bb[p * 16 + c];
            const float xr = cr * w.x - ci * w.y, xi = cr * w.y + ci * w.x; s += xr * b.x - xi * b.y; }
        ktab[(size_t)(base + k) * 256 + t] = s;
    }
    __syncthreads();
}
__device__ __forceinline__ void phase_prep2(const Ctx& C, int gt, int NGT, int slice, int nslices) {
    const f32x2* pw = WSP(f32x2, WS_PW); const f32x2* bbar = WSP(f32x2, WS_BBAR); const float* ktab = WSP(float, WS_KTAB);
    bf16_t* bty = WSP(bf16_t, WS_BTY); bf16_t* bts1 = WSP(bf16_t, WS_BTS1);
    for (int q = slice * (NG * K1 * (KY / 8) / nslices) + gt; q < (slice + 1) * (NG * K1 * (KY / 8) / nslices); q += NGT) {
        const int row = q / (KY / 8), ck = q % (KY / 8), g = row >> 9, t = (row >> 4) & 31, cp = row & 15, k0 = ck * 8; float v[8];
        if (k0 < K1) { const int tau = k0 >> 4, c0 = k0 & 15;
            if (t >= tau) { const f32x4* kp = (const f32x4*)(ktab + ((size_t)((g * TCH + (t - tau)) * 16 + cp) * 16 + c0)); const f32x4 a = kp[0], b = kp[1];
                v[0] = a[0]; v[1] = a[1]; v[2] = a[2]; v[3] = a[3]; v[4] = b[0]; v[5] = b[1]; v[6] = b[2]; v[7] = b[3]; }
            else {
#pragma unroll
                for (int e = 0; e < 8; ++e) v[e] = 0.f; }
        } else { const int p0 = (k0 - K1) >> 1;
#pragma unroll
            for (int e = 0; e < 4; ++e) { const int p = p0 + e; const float cr = C.inp(12)[(g * 16 + cp) * 64 + p], ci = C.inp(13)[(g * 16 + cp) * 64 + p]; const f32x2 w = pw[(size_t)(g * 64 + p) * PWN + t + 1];
                v[2 * e] = cr * w.x - ci * w.y; v[2 * e + 1] = -(cr * w.y + ci * w.x); }
        }
        u32x4 o; o.x = cvt_pk_bf16(v[0], v[1]); o.y = cvt_pk_bf16(v[2], v[3]); o.z = cvt_pk_bf16(v[4], v[5]); o.w = cvt_pk_bf16(v[6], v[7]);
        *(u32x4*)(bty + (size_t)row * KY + k0) = o;
    }
    for (int q = slice * (NG * 128 * (K1 / 8) / nslices) + gt; q < (slice + 1) * (NG * 128 * (K1 / 8) / nslices); q += NGT) {
        const int g = q / (128 * 64), p2 = (q >> 6) & 127, ck = q & 63, k0 = ck * 8, tau = k0 >> 4, c0 = k0 & 15, part = p2 & 1, p = p2 >> 1;
        const f32x2 w = pw[(size_t)(g * 64 + p) * PWN + (TCH - 1 - tau)]; float v[8];
#pragma unroll
        for (int e = 0; e < 8; ++e) { const f32x2 b = bbar[(g * 64 + p) * 16 + c0 + e]; v[e] = part == 0 ? (w.x * b.x - w.y * b.y) : (w.x * b.y + w.y * b.x); }
        u32x4 o; o.x = cvt_pk_bf16(v[0], v[1]); o.y = cvt_pk_bf16(v[2], v[3]); o.z = cvt_pk_bf16(v[4], v[5]); o.w = cvt_pk_bf16(v[6], v[7]);
        *(u32x4*)(bts1 + (size_t)(g * 256 + p2) * K1 + k0) = o;
    }
}
__device__ __forceinline__ void carry_task(const Ctx& C, int b, int g) {
    const f32x2* pw = WSP(f32x2, WS_PW); const float* sloc = WSP(float, WS_SLOC); bf16_t* app = WSP(bf16_t, WS_APP);
    const int p = C.lane; const f32x2 lt = pw[(size_t)(g * 64 + p) * PWN + TCH];
    float sr = 0.f, si = 0.f;
    const size_t row0 = (size_t)g * NBN + b * NCK;
#pragma unroll 1
    for (int c0 = 0; c0 < NCK; c0 += 16) {
        f32x2 l[16];
#pragma unroll
        for (int j = 0; j < 16; ++j) l[j] = *(const f32x2*)(sloc + (row0 + c0 + j) * 128 + 2 * p);
#pragma unroll
        for (int j = 0; j < 16; ++j) {
            const size_t row = row0 + c0 + j;
            *(unsigned*)(app + row * KY + K1 + 2 * p) = cvt_pk_bf16(sr, si);
            const float nr = lt.x * sr - lt.y * si + l[j].x, ni = lt.x * si + lt.y * sr + l[j].y; sr = nr; si = ni;
        }
    }
}
typedef float f32x16 __attribute__((ext_vector_type(16)));
#define MFMA32(a, b, c) __builtin_amdgcn_mfma_f32_32x32x16_bf16((a), (b), (c), 0, 0, 0)
__device__ __forceinline__ bf16x8 pack8_mfma(const f32x16& x, int s) {
    u32x4 p; p[0] = cvt_pk_bf16(x[8 * s], x[8 * s + 1]); p[1] = cvt_pk_bf16(x[8 * s + 2], x[8 * s + 3]); p[2] = cvt_pk_bf16(x[8 * s + 4], x[8 * s + 5]); p[3] = cvt_pk_bf16(x[8 * s + 6], x[8 * s + 7]);
    return __builtin_bit_cast(bf16x8, p);
}
__device__ __forceinline__ void phase_attn(const Ctx& C) {
    constexpr int KROW = 144, KSZ = 256 * KROW, VROW = 528, VSZ = 64 * VROW, V_OFF = 2 * KSZ;
    static_assert(V_OFF + 2 * VSZ <= LDS_BYTES, "attention LDS");
    const bf16_t* qkv = WSP(bf16_t, WS_QKV); bf16_t* ycat = WSP(bf16_t, WS_YCAT); const float* ssq_ssm = WSP(float, WS_SSQ) + 2 * SSQ_STRIDE; unsigned* glu_cnt = (unsigned*)(WSP(float, WS_SSQ) + 5 * SSQ_STRIDE) + 128 * 64;
    LAS unsigned char* lds = C.lds; const int tid = C.tid, lane = C.lane, wave = C.wave;
    for (int it0 = C.bx; it0 < BATCH * 32; it0 += C.G) {
        const int item = (C.G == 256) ? (((it0 & 7) << 5) | (it0 >> 3)) : it0;
        const int b = item >> 5, nb = item & 31, tok0 = b * SEQ + nb * 128; const long kbase = (long)tok0 - 128;
        __syncthreads();
#pragma unroll
        for (int i = 0; i < 8; ++i) { const int c = tid + NTHREADS * i, part = c & 7, sk = (c >> 3) & 255, kvh = c >> 11;
            if (nb > 0 || sk >= 128) { const u32x4 v = *(const u32x4*)(qkv + (size_t)(kbase + sk) * 768 + 512 + kvh * 64 + part * 8); *(LAS u32x4*)(lds + kvh * KSZ + sk * KROW + part * 16) = v; } }
#pragma unroll
        for (int i = 0; i < 4; ++i) { const int c = tid + NTHREADS * i, sp = c & 127, part = (c >> 7) & 7, kvh = c >> 10, sk = 2 * sp;
            if (nb > 0 || sk >= 128) { const bf16_t* vp = qkv + (size_t)(kbase + sk) * 768 + 640 + kvh * 64 + part * 8; const u32x4 v0 = *(const u32x4*)vp, v1 = *(const u32x4*)(vp + 768);
                LAS unsigned char* dst = lds + V_OFF + kvh * VSZ + (part * 8) * VROW + sp * 4;
#pragma unroll
                for (int e = 0; e < 4; ++e) { const unsigned a0 = v0[e], a1 = v1[e];
                    *(LAS unsigned*)(dst + (2 * e) * VROW) = (a0 & 0xffffu) | (a1 << 16); *(LAS unsigned*)(dst + (2 * e + 1) * VROW) = (a0 >> 16) | (a1 & 0xffff0000u); } } }
        __syncthreads();
        const int q0 = wave * 16, ql = lane & 15, hl = (lane >> 4) & 1, h = lane >> 5, a = q0 >> 5, qrel = (q0 & 31) + ql, l31 = lane & 31;
        const int tok = tok0 + q0 + ql;
        float ssq_acc = 0.f;
#pragma unroll 1
        for (int hp = 0; hp < 4; ++hp) {
            const int kvh = hp >> 1, head = 2 * hp + hl;
            bf16x8 qf[4];
#pragma unroll
            for (int ks = 0; ks < 4; ++ks) qf[ks] = *(const bf16x8*)(qkv + (size_t)tok * 768 + head * 64 + 16 * ks + 8 * h);
            f32x16 sc[5];
#pragma unroll
            for (int j = 0; j < 5; ++j) {
#pragma unroll
                for (int r = 0; r < 16; ++r) sc[j][r] = 0.f;
                const int st = a + j;
                if (nb > 0 || st >= 4) {
#pragma unroll
                    for (int ks = 0; ks < 4; ++ks) { const bf16x8 kf = *(const LAS bf16x8*)(lds + kvh * KSZ + (32 * st + l31) * KROW + (16 * ks + 8 * h) * 2); sc[j] = MFMA32(kf, qf[ks], sc[j]); }
                }
            }
            const float sink = C.inp(17)[head] * 1.4426950409f; float mx = sink;
#pragma unroll
            for (int j = 0; j < 5; ++j) { const bool tv = (nb > 0) || (a + j >= 4);
#pragma unroll
                for (int r = 0; r < 16; ++r) { const int cr = (r & 3) + 8 * (r >> 2) + 4 * h; bool ok = tv; if (j == 0) ok = ok && (cr > qrel); if (j == 4) ok = ok && (cr <= qrel);
                    const float t = ok ? sc[j][r] * 0.18033688011f : -1e30f; sc[j][r] = t; mx = fmaxf(mx, t); } }
            mx = fmaxf(mx, __shfl_xor(mx, 32));
            float lsum = 0.f;
#pragma unroll
            for (int j = 0; j < 5; ++j)
#pragma unroll
                for (int r = 0; r < 16; ++r) { const float p = __builtin_amdgcn_exp2f(sc[j][r] - mx); sc[j][r] = p; lsum += p; }
            lsum += __shfl_xor(lsum, 32); lsum += __builtin_amdgcn_exp2f(sink - mx);
            f32x16 o[2];
#pragma unroll
            for (int r = 0; r < 16; ++r) { o[0][r] = 0.f; o[1][r] = 0.f; }
#pragma unroll
            for (int j = 0; j < 5; ++j) { const int st = a + j;
                if (nb > 0 || st >= 4) {
#pragma unroll
                    for (int ks = 0; ks < 2; ++ks) { const bf16x8 pb = pack8_mfma(sc[j], ks);
#pragma unroll
                        for (int dt = 0; dt < 2; ++dt) { const LAS unsigned char* vp = lds + V_OFF + kvh * VSZ + (32 * dt + l31) * VROW + (32 * st + 16 * ks + 4 * h) * 2;
                            const u32x2 x0 = *(const LAS u32x2*)vp, x1 = *(const LAS u32x2*)(vp + 16); u32x4 xv; xv.x = x0.x; xv.y = x0.y; xv.z = x1.x; xv.w = x1.y;
                            o[dt] = MFMA32(__builtin_bit_cast(bf16x8, xv), pb, o[dt]); } }
                }
            }
            const float inv = __builtin_amdgcn_rcpf(lsum);
#pragma unroll
            for (int dt = 0; dt < 2; ++dt) {
                u32x2 w[4];
#pragma unroll
                for (int g4 = 0; g4 < 4; ++g4) { const float v0 = o[dt][4 * g4] * inv, v1 = o[dt][4 * g4 + 1] * inv, v2 = o[dt][4 * g4 + 2] * inv, v3 = o[dt][4 * g4 + 3] * inv;
                    ssq_acc += (v0 * v0 + v1 * v1) + (v2 * v2 + v3 * v3);
                    w[g4].x = cvt_pk_bf16(v0, v1); w[g4].y = cvt_pk_bf16(v2, v3); }
#pragma unroll
                for (int k = 0; k < 4; k += 2) {
                    const auto rx = __builtin_amdgcn_permlane32_swap(w[k].x, w[k + 1].x, false, false); const auto ry = __builtin_amdgcn_permlane32_swap(w[k].y, w[k + 1].y, false, false);
                    u32x4 q; q.x = rx[0]; q.y = ry[0]; q.z = rx[1]; q.w = ry[1];
                    *(u32x4*)(ycat + (size_t)tok * DM + 512 + head * 64 + 32 * dt + 8 * k + 8 * h) = q; }
            }
        }
        ssq_acc += __shfl_xor(ssq_acc, 16); ssq_acc += __shfl_xor(ssq_acc, 32);
        { unsigned* cw = glu_cnt + 64 * (item >> 1); unsigned sp = 0;
          while ((unsigned)__builtin_amdgcn_readfirstlane(__hip_atomic_load(cw, __ATOMIC_RELAXED, __HIP_MEMORY_SCOPE_AGENT)) < 8u) { __builtin_amdgcn_s_sleep(2); if (++sp > (1u << 20)) break; }
          __builtin_amdgcn_fence(__ATOMIC_ACQUIRE, "agent"); }
        const float ssm_sq = __hip_atomic_load(ssq_ssm + (size_t)tok * 4, __ATOMIC_RELAXED, __HIP_MEMORY_SCOPE_AGENT) + __hip_atomic_load(ssq_ssm + (size_t)tok * 4 + 1, __ATOMIC_RELAXED, __HIP_MEMORY_SCOPE_AGENT);
        const float rs = rsqrtf(ssq_acc * (1.0f / 512.0f) + EPS) * sqrtf(ssm_sq * (1.0f / 512.0f) + EPS);
#pragma unroll 1
        for (int hp = 0; hp < 4; ++hp)
#pragma unroll
            for (int dt = 0; dt < 2; ++dt)
#pragma unroll
                for (int k = 0; k < 4; k += 2) { u32x4* p = (u32x4*)(ycat + (size_t)tok * DM + 512 + (2 * hp + hl) * 64 + 32 * dt + 8 * k + 8 * h); const u32x4 w0 = *p;
                    u32x4 w; w.x = cvt_pk_bf16(bf_lo(w0.x) * rs, bf_hi(w0.x) * rs); w.y = cvt_pk_bf16(bf_lo(w0.y) * rs, bf_hi(w0.y) * rs); w.z = cvt_pk_bf16(bf_lo(w0.z) * rs, bf_hi(w0.z) * rs); w.w = cvt_pk_bf16(bf_lo(w0.w) * rs, bf_hi(w0.w) * rs); *p = w; }
    }
    __syncthreads();
}

constexpr int N_PHASES = 12;
__global__ void __launch_bounds__(NTHREADS, 2) mk_fwd(const float* p0, const float* p1, const float* p2, const float* p3, const float* p4, const float* p5, const float* p6, const float* p7, const float* p8, const float* p9, const float* p10, const float* p11, const float* p12, const float* p13, const float* p14, const float* p15, const float* p16, const float* p17, const float* p18, const float* p19, const float* p20, const float* p21, const float* p22, const float* p23, const float* p24, const float* p25, float* out_p, unsigned char* ws_p, int ph_lo, int ph_hi) {
    extern __shared__ __attribute__((aligned(16))) unsigned char lds_raw[];
    Ctx C; C.in[0] = p0; C.in[1] = p1; C.in[2] = p2; C.in[3] = p3; C.in[4] = p4; C.in[5] = p5; C.in[6] = p6; C.in[7] = p7; C.in[8] = p8; C.in[9] = p9; C.in[10] = p10; C.in[11] = p11; C.in[12] = p12; C.in[13] = p13; C.in[14] = p14; C.in[15] = p15; C.in[16] = p16; C.in[17] = p17; C.in[18] = p18; C.in[19] = p19; C.in[20] = p20; C.in[21] = p21; C.in[22] = p22; C.in[23] = p23; C.in[24] = p24; C.in[25] = p25; C.out = out_p; C.ws = ws_p; C.lds = (LAS unsigned char*)lds_raw;
    C.tid = threadIdx.x; C.lane = C.tid & 63; C.wave = __builtin_amdgcn_readfirstlane(C.tid >> 6); C.G = gridDim.x; C.bx = blockIdx.x;
    const int lo = ph_lo, hi = ph_hi;
#define IN(k) (lo <= (k) && (k) < hi)
#define SEAM(k) do { if (IN(k) && IN((k) + 1)) { xcd_barrier(xbar); } } while (0)
    volatile LAS unsigned* xst = (volatile LAS unsigned*)(C.lds + LDS_BYTES - 16);
    if (C.tid == 0) { xst[0] = 0u; xst[1] = 0u; }
    __syncthreads();
    const XcdBarrier xbar = xcd_barrier_post(WSP(unsigned, WS_BAR), xst);
    float* ssq = WSP(float, WS_SSQ); LAS float* red = (LAS float*)(C.lds + RED_OFF);
    if (IN(0)) { phase_prep0(C); __syncthreads(); }
    SEAM(0);
    if (IN(1)) {
        phase_prep1(C);
        pg8::Gemm g{WSP(bf16_t, WS_XB), WSP(bf16_t, WS_WGU1), DM, DM, DM}; pg8::StaticOrder S; S.init(M_TOK, 2 * DFF, C.G, C.bx);
        EpiGateUp E{ssq, WSP(bf16_t, WS_ACT)}; pg8::gemm_phase<EpiGateUp, pg8::StaticOrder, true>(C.lds, g, S, E);
    }
    SEAM(1);
    if (IN(2)) {
        pg8::Gemm g{WSP(bf16_t, WS_ACT), WSP(bf16_t, WS_WD1), DFF, DFF, DFF}; pg8::StaticOrder S; S.init(M_TOK, DM, C.G, C.bx);
        EpiResid E{WSP(bf16_t, WS_XB), ssq + SSQ_STRIDE, 0.5f, nullptr, red}; pg8::gemm_phase<EpiResid, pg8::StaticOrder, true>(C.lds, g, S, E);
    }
    SEAM(2);
    if (IN(3)) {
        pg8::Gemm g{WSP(bf16_t, WS_XB), WSP(bf16_t, WS_WIN), DM, DM, DM}; pg8::StaticOrder S; S.init(M_TOK, DIN, C.G, C.bx);
        EpiWin E{ssq + SSQ_STRIDE, WSP(bf16_t, WS_APP), WSP(bf16_t, WS_QKV), WSP(float, WS_ROPE), WSP(float, WS_ROPE) + SEQ * 8}; pg8::gemm_phase<EpiWin, pg8::StaticOrder, true>(C.lds, g, S, E);
        if (C.G != 256) { if (C.G <= 128 || C.bx >= 128) phase_prep2(C, (C.G <= 128 ? C.bx : C.bx - 128) * NTHREADS + C.tid, (C.G <= 128 ? C.G : C.G - 128) * NTHREADS, 0, 1); }
        else if (C.bx >= 128) phase_prep2(C, ((C.bx - 128) >> 3) * NTHREADS + C.tid, 16 * NTHREADS, C.bx & 7, 8);
    }
    SEAM(3);
    if (IN(4)) {
        { const int it = ((C.bx & 7) << 5) | ((C.bx >> 3) & 31);
            const int pm = it >> 1, g = pm >> 2;
            __syncthreads();
            { pg8::Gemm g1{WSP(bf16_t, WS_APP), WSP(bf16_t, WS_BTS1), KY, K1, K1}; pg8::OneUnit S{pm, g}; EpiS1 E{WSP(float, WS_SLOC)}; pg8::gemm_phase<EpiS1, pg8::OneUnit, true, true>(C.lds, g1, S, E); }
            asm volatile("s_waitcnt vmcnt(0)" ::: "memory"); __syncthreads();
            if (C.wave < 2) carry_task(C, 2 * (pm & 3) + C.wave, g);
            if (C.wave >= 2) {
#pragma unroll 1
                for (int j = C.wave - 2; j < 18; j += 6) weights_late_item(C, it * 19 + j);
            } else if (C.wave == 0) weights_late_item(C, it * 19 + 18);
            asm volatile("s_waitcnt vmcnt(0)" ::: "memory"); __syncthreads();
            { pg8::Gemm gy{WSP(bf16_t, WS_APP), WSP(bf16_t, WS_BTY), KY, KY, KY}; pg8::OneUnit S{pm, 2 * g + (it & 1)}; EpiY E{WSP(bf16_t, WS_APP), C.inp(14), WSP(bf16_t, WS_YGELU)}; pg8::gemm_phase<EpiY, pg8::OneUnit, true>(C.lds, gy, S, E); }
        }
    }
    SEAM(4);
    if (IN(7)) {
        pg8::Gemm g{WSP(bf16_t, WS_YGELU), WSP(bf16_t, WS_WGLU), DSSM, DSSM, DSSM}; pg8::StaticOrder S; S.init(M_TOK, DSSM, C.G, C.bx);
        EpiGlu E{WSP(bf16_t, WS_YGELU), C.inp(16), WSP(bf16_t, WS_YCAT), ssq + 2 * SSQ_STRIDE, red, (unsigned*)(ssq + 5 * SSQ_STRIDE) + 128 * 64}; pg8::gemm_phase<EpiGlu, pg8::StaticOrder, true>(C.lds, g, S, E);
        phase_attn(C);
    }
    SEAM(8);
    if (IN(9)) {
        pg8::Gemm g{WSP(bf16_t, WS_YCAT), WSP(bf16_t, WS_WOUT), DM, DM, DM}; pg8::StaticOrder S; S.init(M_TOK, DM, C.G, C.bx);
        EpiResid E{WSP(bf16_t, WS_XB), ssq + 3 * SSQ_STRIDE, 1.0f, ssq + 2 * SSQ_STRIDE, red}; pg8::gemm_phase<EpiResid, pg8::StaticOrder, true>(C.lds, g, S, E);
    }
    SEAM(9);
    if (IN(10)) {
        pg8::Gemm g{WSP(bf16_t, WS_XB), WSP(bf16_t, WS_WGU2), DM, DM, DM}; pg8::StaticOrder S; S.init(M_TOK, 2 * DFF, C.G, C.bx);
        EpiGateUp E{ssq + 3 * SSQ_STRIDE, WSP(bf16_t, WS_ACT)}; pg8::gemm_phase<EpiGateUp, pg8::StaticOrder, true>(C.lds, g, S, E);
    }
    SEAM(10);
    if (IN(11)) {
        pg8::Gemm g{WSP(bf16_t, WS_ACT), WSP(bf16_t, WS_WD2), DFF, DFF, DFF}; pg8::StaticOrder S; S.init(M_TOK, DM, C.G, C.bx);
        EpiFinal E{WSP(bf16_t, WS_XB), ssq + 4 * SSQ_STRIDE, (unsigned*)(ssq + 5 * SSQ_STRIDE), C.inp(25), C.out, red}; pg8::gemm_phase<EpiFinal, pg8::StaticOrder, true>(C.lds, g, S, E);
    }
#undef IN
#undef SEAM
}

extern "C" void kernel_launch(void* const* d_in, const int* in_sizes, int n_in, void* d_out, int out_size, void* d_ws, size_t ws_size, hipStream_t stream) {
    static int grid = 0;
    if (grid == 0) {
        if (n_in != 26 || out_size != M_TOK * DM || ws_size < WS_END) { fprintf(stderr, "kernel_launch: unexpected shapes (n_in %d out %d ws %zu)\n", n_in, out_size, ws_size); grid = -1; return; }
        int dev = 0, cus = 0, per_cu = 0;
        hipGetDevice(&dev); hipDeviceGetAttribute(&cus, hipDeviceAttributeMultiprocessorCount, dev);
        if (hipFuncSetAttribute((const void*)mk_fwd, hipFuncAttributeMaxDynamicSharedMemorySize, LDS_BYTES) != hipSuccess) { fprintf(stderr, "kernel_launch: hipFuncSetAttribute failed\n"); grid = -1; return; }
        hipOccupancyMaxActiveBlocksPerMultiprocessor(&per_cu, (const void*)mk_fwd, NTHREADS, LDS_BYTES);
        if (per_cu < 1) { fprintf(stderr, "kernel_launch: occupancy query says %d blocks/CU\n", per_cu); per_cu = 1; }
        (void)hipGetLastError();
        grid = cus;
    }
    if (grid < 0) return;
    const float* ip[26]; for (int i = 0; i < 26; ++i) ip[i] = (const float*)d_in[i];
    float* outp = (float*)d_out; unsigned char* wsp = (unsigned char*)d_ws; int lo = 0, hi = N_PHASES;
    (void)hipMemsetAsync((unsigned char*)d_ws + WS_BAR, 0, XCD_BAR_WORDS * sizeof(unsigned), stream);
    void* kargs[30]; for (int i = 0; i < 26; ++i) kargs[i] = (void*)&ip[i];
    kargs[26] = (void*)&outp; kargs[27] = (void*)&wsp; kargs[28] = (void*)&lo; kargs[29] = (void*)&hi;
    hipError_t e = hipLaunchCooperativeKernel((const void*)mk_fwd, dim3(grid), dim3(NTHREADS), kargs, LDS_BYTES, stream);
    if (e != hipSuccess) fprintf(stderr, "kernel_launch: cooperative launch failed: %s (grid %d)\n", hipGetErrorString(e), grid);
}
```
